# Optimizing an MI355X kernel written in HIP

```python
import math
import jax, jax.numpy as jnp
from jax import lax
import numpy as np

D_MODEL = 4096
BATCH = 2
SEQ = 8192
DEPTH = 1

N_ATTN_HEADS = 8
HEAD_DIM = 128
ATTN_QK_WIDTH = N_ATTN_HEADS * 2 * HEAD_DIM
ATTN_V_WIDTH = N_ATTN_HEADS * 2 * HEAD_DIM
Q_BLOCK = 128
CONV_WIDTH = 2048
CONV_GROUPS = 16
CONV_K = 3
D_FF = 11008
FFN_CONV_K = 3
LN_EPS = 1e-5
RMS_EPS = 1e-5
ALPHA = (2.0 * DEPTH) ** 0.25
BETA = (8.0 * DEPTH) ** -0.25
IN_SPLIT_SIZES = (ATTN_QK_WIDTH, ATTN_QK_WIDTH, ATTN_V_WIDTH,
                  CONV_WIDTH, CONV_WIDTH, CONV_WIDTH, D_MODEL, D_MODEL)
IN_WIDTH = sum(IN_SPLIT_SIZES)
IN_OFFSETS = tuple(int(o) for o in np.cumsum(IN_SPLIT_SIZES)[:-1])

kernel_name = "hybrid_diffattn_shortconv_convffn_deepnorm"


def lambda_init(layer_idx):
    return 0.8 - 0.6 * math.exp(-0.3 * layer_idx)


def layer_norm(x, g, b):
    xf = x.astype(jnp.float32)
    mu = jnp.mean(xf, axis=-1, keepdims=True)
    xc = xf - mu
    var = jnp.mean(xc * xc, axis=-1, keepdims=True)
    return (xc * lax.rsqrt(var + LN_EPS) * g.astype(jnp.float32) + b.astype(jnp.float32)).astype(x.dtype)


def rms_norm(x, g):
    xf = x.astype(jnp.float32)
    ms = jnp.mean(xf * xf, axis=-1, keepdims=True)
    return (xf * lax.rsqrt(ms + RMS_EPS) * g.astype(jnp.float32)).astype(x.dtype)


def causal_dwconv(u, w):
    k_width = w.shape[0]
    s = u.shape[1]
    up = jnp.pad(u, ((0, 0), (k_width - 1, 0), (0, 0)))
    y = w[0] * up[:, 0:s]
    for j in range(1, k_width):
        y = y + w[j] * up[:, j:j + s]
    return y


def diff_attention(q, k, v, lam):
    b, s, h, _, d = q.shape
    scale = 1.0 / math.sqrt(d)
    n_blk = s // Q_BLOCK
    qt = jnp.transpose(q, (0, 2, 3, 1, 4))
    kt = jnp.transpose(k, (0, 2, 3, 1, 4))
    vt = jnp.transpose(v, (0, 2, 1, 3))
    qb = qt.reshape(b, h, 2, n_blk, Q_BLOCK, d)
    qb = jnp.moveaxis(qb, 3, 0)
    key_pos = jnp.arange(s)
    neg = jnp.finfo(jnp.float32).min

    def one_block(args):
        q_blk, i = args
        sc = jnp.einsum('bhcqd,bhckd->bhcqk', q_blk, kt).astype(jnp.float32) * scale
        q_pos = i * Q_BLOCK + jnp.arange(Q_BLOCK)
        mask = key_pos[None, :] <= q_pos[:, None]
        sc = jnp.where(mask, sc, neg)
        p = jax.nn.softmax(sc, axis=-1)
        a = p[:, :, 0] - lam.astype(jnp.float32) * p[:, :, 1]
        return jnp.einsum('bhqk,bhkv->bhqv', a.astype(vt.dtype), vt)

    out = lax.map(one_block, (qb, jnp.arange(n_blk)))
    out = jnp.transpose(out, (1, 0, 3, 2, 4))
    return out.reshape(b, s, h, 2 * d)


def setup_inputs(seed: int = 0) -> dict:
    key = jax.random.key(seed)
    ks = jax.random.split(key, 24)
    f32 = jnp.float32
    s_in = D_MODEL ** -0.5

    def nrm(k, shape, scale):
        return jax.random.normal(k, shape, f32) * scale

    x = jax.random.normal(ks[0], (BATCH, SEQ, D_MODEL), f32)
    pieces = [
        nrm(ks[1], (DEPTH, D_MODEL, ATTN_QK_WIDTH), s_in),
        nrm(ks[2], (DEPTH, D_MODEL, ATTN_QK_WIDTH), s_in),
        nrm(ks[3], (DEPTH, D_MODEL, ATTN_V_WIDTH), s_in * BETA),
        nrm(ks[4], (DEPTH, D_MODEL, CONV_WIDTH), s_in * BETA),
        nrm(ks[5], (DEPTH, D_MODEL, CONV_WIDTH), s_in),
        nrm(ks[6], (DEPTH, D_MODEL, CONV_WIDTH), s_in),
        nrm(ks[7], (DEPTH, D_MODEL, D_MODEL), s_in),
        nrm(ks[8], (DEPTH, D_MODEL, D_MODEL), s_in),
    ]
    w_in = jnp.concatenate(pieces, axis=-1)
    return {
        "x": x,
        "w_in": w_in,
        "lambda_q1": nrm(ks[9], (DEPTH, HEAD_DIM), 0.1),
        "lambda_k1": nrm(ks[10], (DEPTH, HEAD_DIM), 0.1),
        "lambda_q2": nrm(ks[11], (DEPTH, HEAD_DIM), 0.1),
        "lambda_k2": nrm(ks[12], (DEPTH, HEAD_DIM), 0.1),
        "subln_g": 1.0 + nrm(ks[13], (DEPTH, 2 * HEAD_DIM), 0.02),
        "conv_mix_w": nrm(ks[14], (DEPTH, CONV_K, CONV_WIDTH), CONV_K ** -0.5),
        "w_attn_out": nrm(ks[15], (DEPTH, ATTN_V_WIDTH, D_MODEL), ATTN_V_WIDTH ** -0.5 * BETA),
        "w_conv_out": nrm(ks[16], (DEPTH, CONV_WIDTH, D_MODEL), CONV_WIDTH ** -0.5 * BETA),
        "w_o": nrm(ks[17], (DEPTH, D_MODEL, D_MODEL), s_in * BETA),
        "ln1_g": 1.0 + nrm(ks[18], (DEPTH, D_MODEL), 0.02),
        "ln1_b": nrm(ks[19], (DEPTH, D_MODEL), 0.02),
        "w_up": nrm(ks[20], (DEPTH, D_MODEL, 2 * D_FF), s_in * BETA),
        "ffn_conv_w": nrm(ks[21], (DEPTH, FFN_CONV_K, 2 * D_FF), FFN_CONV_K ** -0.5),
        "w_down": nrm(ks[22], (DEPTH, D_FF, D_MODEL), D_FF ** -0.5 * BETA),
        "ln2_g": 1.0 + nrm(ks[23], (DEPTH, D_MODEL), 0.02),
        "ln2_b": nrm(jax.random.fold_in(ks[23], 1), (DEPTH, D_MODEL), 0.02),
    }


def reference(x, w_in, lambda_q1, lambda_k1, lambda_q2, lambda_k2, subln_g,
              conv_mix_w, w_attn_out, w_conv_out, w_o, ln1_g, ln1_b,
              w_up, ffn_conv_w, w_down, ln2_g, ln2_b):
    b, s, _ = x.shape
    h = x
    for l in range(DEPTH):
        lam_init = lambda_init(l)
        proj = jnp.einsum('bsd,de->bse', h, w_in[l])
        q, k, v, u, g_b, g_c, gate_a, gate_c = jnp.split(proj, IN_OFFSETS, axis=-1)

        q = q.reshape(b, s, N_ATTN_HEADS, 2, HEAD_DIM)
        k = k.reshape(b, s, N_ATTN_HEADS, 2, HEAD_DIM)
        v = v.reshape(b, s, N_ATTN_HEADS, 2 * HEAD_DIM)
        lam = (jnp.exp(jnp.sum(lambda_q1[l].astype(jnp.float32) * lambda_k1[l].astype(jnp.float32)))
               - jnp.exp(jnp.sum(lambda_q2[l].astype(jnp.float32) * lambda_k2[l].astype(jnp.float32)))
               + lam_init)
        attn = diff_attention(q, k, v, lam)
        attn = rms_norm(attn, subln_g[l]) * (1.0 - lam_init)
        y_a = jnp.einsum('bse,ed->bsd', attn.reshape(b, s, ATTN_V_WIDTH), w_attn_out[l])

        yc = g_b * causal_dwconv(g_c * u, conv_mix_w[l])
        y_c = jnp.einsum('bse,ed->bsd', yc, w_conv_out[l])

        merged = jax.nn.sigmoid(gate_a) * y_a + jax.nn.sigmoid(gate_c) * y_c
        mix = jnp.einsum('bsd,de->bse', merged, w_o[l])
        h = layer_norm(ALPHA * h + mix, ln1_g[l], ln1_b[l])

        z = jnp.einsum('bsd,df->bsf', h, w_up[l])
        z = causal_dwconv(z, ffn_conv_w[l])
        z_gate, z_val = jnp.split(z, 2, axis=-1)
        f = jnp.einsum('bsf,fd->bsd', jax.nn.silu(z_gate) * z_val, w_down[l])
        h = layer_norm(ALPHA * h + f, ln2_g[l], ln2_b[l])
    return h
```

```cpp
#include <hip/hip_runtime.h>
#include <hip/hip_bf16.h>
#include <cstdio>
#include <cstdint>
namespace pg8 {
#define PG8_LAS __attribute__((address_space(3)))
typedef unsigned short bf16_t;
typedef short bf16x8 __attribute__((ext_vector_type(8)));
typedef float f32x4 __attribute__((ext_vector_type(4)));
typedef unsigned u32x4 __attribute__((ext_vector_type(4)));
constexpr int BM = 256, BK = 64, HALF = 128, HTB = HALF * BK * 2  , STAGE_BYTES = 8 * HTB, NXCD = 8, WGM = 8;

__host__ __device__ __forceinline__ int lds_byte(int r, int c) { const int st = (r >> 4) * 2 + (c >> 5), rr = r & 15, cc = c & 31, ob = rr * 64 + cc * 2; return st * 1024 + (ob ^ (((ob >> 9) & 1) << 5)); }
__host__ __device__ __forceinline__ void stage_rc(int b, int& R, int& C) { const int st = b / 1024, sb = b % 1024, swz = sb ^ (((sb >> 9) & 1) << 5); R = (st >> 1) * 16 + swz / 64; C = (st & 1) * 32 + (swz % 64) / 2; }
__host__ __device__ __forceinline__ int perm32(int rho) { const int n = rho >> 4, i = rho & 15; return 8 * (i >> 2) + 4 * n + (i & 3); }

struct Unit { int pm, pn; };
struct Gemm { const bf16_t* A; const bf16_t* Bt; int M, N, K; };

struct StaticOrder {
    int nM, nN, nwg, G, c;
    __host__ __device__ void init(int M, int N, int G_, int c_) { nM = M / BM; nN = N / BM; nwg = nM * nN; G = G_; c = c_; }
    __host__ __device__ bool next(int i, Unit& u) const {
        const long L = (long)i * G + c; if (L >= nwg) return false;
        int wgid = (int)L; { const int q = nwg / NXCD, r = nwg % NXCD, xcd = wgid % NXCD, off = wgid / NXCD; wgid = (xcd < r ? xcd * (q + 1) : r * (q + 1) + (xcd - r) * q) + off; }
        const int nig = WGM * nN, gid = wgid / nig, fm = gid * WGM, gsz = (nM - fm) < WGM ? (nM - fm) : WGM;
        u.pm = fm + ((wgid % nig) % gsz); u.pn = (wgid % nig) / gsz; return true;
    }
    __device__ __forceinline__ void a_ready(const Unit&) const {}
    __device__ __forceinline__ void done(const Unit&) const {}
};

__device__ __forceinline__ unsigned cvt_pk_bf16(float lo, float hi) { unsigned r; asm volatile("v_cvt_pk_bf16_f32 %0, %1, %2" : "=v"(r) : "v"(lo), "v"(hi)); return r; }
typedef float f32x2 __attribute__((ext_vector_type(2)));
typedef unsigned u32x2 __attribute__((ext_vector_type(2)));
__device__ __forceinline__ float sigm(float v) { return __builtin_amdgcn_rcpf(1.0f + __builtin_amdgcn_exp2f(-1.4426950408889634f * v)); }
__device__ __forceinline__ float bflo(unsigned w) { return __uint_as_float(w << 16); }
__device__ __forceinline__ float bfhi(unsigned w) { return __uint_as_float(w & 0xffff0000u); }
struct EpiProj {
    static constexpr bool PERM = true, AFTER_DRAIN = false;
    bf16_t* O; int ldc; int sig_from;
    __device__ __forceinline__ void operator()(const f32x4 (&acc)[2][2][4][2], const Unit& u, int wr, int wc, int fr, int fq) const {
        const int row0 = u.pm * BM + wr * 64 + fr, col0 = u.pn * BM + wc * 32 + 8 * fq; const bool sg = (u.pn * BM) >= sig_from;
#pragma unroll
        for (int ai = 0; ai < 2; ++ai)
#pragma unroll
            for (int m = 0; m < 4; ++m) { bf16_t* rowp = O + (size_t)(row0 + ai * HALF + m * 16) * ldc + col0;
#pragma unroll
                for (int bj = 0; bj < 2; ++bj) { f32x4 v0 = acc[ai][bj][m][0], v1 = acc[ai][bj][m][1];
                    if (sg) { v0 = (f32x4){sigm(v0[0]), sigm(v0[1]), sigm(v0[2]), sigm(v0[3])}; v1 = (f32x4){sigm(v1[0]), sigm(v1[1]), sigm(v1[2]), sigm(v1[3])}; }
                    u32x4 w; w.x = cvt_pk_bf16(v0[0], v0[1]); w.y = cvt_pk_bf16(v0[2], v0[3]); w.z = cvt_pk_bf16(v1[0], v1[1]); w.w = cvt_pk_bf16(v1[2], v1[3]);
                    *(u32x4*)(rowp + bj * HALF) = w; } }
    }
};
struct EpiPlain {
    static constexpr bool PERM = true, AFTER_DRAIN = false;
    bf16_t* O; int ldc;
    __device__ __forceinline__ void operator()(const f32x4 (&acc)[2][2][4][2], const Unit& u, int wr, int wc, int fr, int fq) const {
        const int row0 = u.pm * BM + wr * 64 + fr, col0 = u.pn * BM + wc * 32 + 8 * fq;
#pragma unroll
        for (int ai = 0; ai < 2; ++ai)
#pragma unroll
            for (int m = 0; m < 4; ++m) { bf16_t* rowp = O + (size_t)(row0 + ai * HALF + m * 16) * ldc + col0;
#pragma unroll
                for (int bj = 0; bj < 2; ++bj) { const f32x4 v0 = acc[ai][bj][m][0], v1 = acc[ai][bj][m][1];
                    u32x4 w; w.x = cvt_pk_bf16(v0[0], v0[1]); w.y = cvt_pk_bf16(v0[2], v0[3]); w.z = cvt_pk_bf16(v1[0], v1[1]); w.w = cvt_pk_bf16(v1[2], v1[3]);
                    *(u32x4*)(rowp + bj * HALF) = w; } }
    }
};
struct EpiGateA {
    static constexpr bool PERM = false, AFTER_DRAIN = false;
    float* P; int ldc; const bf16_t* gate; int ldg;
    __device__ __forceinline__ void operator()(const f32x4 (&acc)[2][2][4][2], const Unit& u, int wr, int wc, int fr, int fq) const {
        const int row0 = u.pm * BM + wr * 64 + fr, col0 = u.pn * BM + wc * 32 + 4 * fq;
#pragma unroll
        for (int ai = 0; ai < 2; ++ai)
#pragma unroll
            for (int m = 0; m < 4; ++m) { const size_t row = (size_t)(row0 + ai * HALF + m * 16);
#pragma unroll
                for (int bj = 0; bj < 2; ++bj)
#pragma unroll
                    for (int n = 0; n < 2; ++n) { const int col = col0 + bj * HALF + n * 16;
                        const u32x2 gw = *(const u32x2*)(gate + row * ldg + col); const f32x4 a = acc[ai][bj][m][n];
                        *(f32x4*)(P + row * ldc + col) = (f32x4){a[0] * bflo(gw.x), a[1] * bfhi(gw.x), a[2] * bflo(gw.y), a[3] * bfhi(gw.y)}; }
                if (m & 1) asm volatile("" ::: "memory"); }
    }
};
struct EpiGateC {
    static constexpr bool PERM = true, AFTER_DRAIN = false;
    const float* P; bf16_t* O; int ldc; const bf16_t* gate; int ldg;
    __device__ __forceinline__ void operator()(const f32x4 (&acc)[2][2][4][2], const Unit& u, int wr, int wc, int fr, int fq) const {
        const int row0 = u.pm * BM + wr * 64 + fr, col0 = u.pn * BM + wc * 32 + 8 * fq;
#pragma unroll
        for (int ai = 0; ai < 2; ++ai)
#pragma unroll
            for (int m = 0; m < 4; ++m) { const size_t row = (size_t)(row0 + ai * HALF + m * 16);
#pragma unroll
                for (int bj = 0; bj < 2; ++bj) { const int col = col0 + bj * HALF;
                    const u32x4 gw = *(const u32x4*)(gate + row * ldg + col); const f32x4 p0 = *(const f32x4*)(P + row * ldc + col), p1 = *(const f32x4*)(P + row * ldc + col + 4);
                    const f32x4 a0 = acc[ai][bj][m][0], a1 = acc[ai][bj][m][1];
                    const float r0 = p0[0] + a0[0] * bflo(gw.x), r1 = p0[1] + a0[1] * bfhi(gw.x), r2 = p0[2] + a0[2] * bflo(gw.y), r3 = p0[3] + a0[3] * bfhi(gw.y);
                    const float r4 = p1[0] + a1[0] * bflo(gw.z), r5 = p1[1] + a1[1] * bfhi(gw.z), r6 = p1[2] + a1[2] * bflo(gw.w), r7 = p1[3] + a1[3] * bfhi(gw.w);
                    u32x4 w; w.x = cvt_pk_bf16(r0, r1); w.y = cvt_pk_bf16(r2, r3); w.z = cvt_pk_bf16(r4, r5); w.w = cvt_pk_bf16(r6, r7);
                    *(u32x4*)(O + row * ldc + col) = w; }
                if (m & 1) asm volatile("" ::: "memory"); }
    }
};
struct EpiResid {
    static constexpr bool PERM = false, AFTER_DRAIN = false;
    const float* base; float* out; int ldc; float alpha;
    __device__ __forceinline__ void operator()(const f32x4 (&acc)[2][2][4][2], const Unit& u, int wr, int wc, int fr, int fq) const {
        const int row0 = u.pm * BM + wr * 64 + fr, col0 = u.pn * BM + wc * 32 + 4 * fq;
#pragma unroll
        for (int ai = 0; ai < 2; ++ai)
#pragma unroll
            for (int m = 0; m < 4; ++m) { const size_t off = (size_t)(row0 + ai * HALF + m * 16) * ldc + col0;
#pragma unroll
                for (int bj = 0; bj < 2; ++bj)
#pragma unroll
                    for (int n = 0; n < 2; ++n) { const f32x4 b = *(const f32x4*)(base + off + bj * HALF + n * 16);
                        *(f32x4*)(out + off + bj * HALF + n * 16) = b * alpha + acc[ai][bj][m][n]; }
                if (m & 1) asm volatile("" ::: "memory"); }
    }
};

template <class Epi, class Sched, bool ALIGN_EPI = false, bool SP2 = false>
__device__ __forceinline__ void gemm_phase(PG8_LAS unsigned char* lds, const Gemm g, const Sched& S, const Epi& E) {
    int tid_ = threadIdx.x; asm volatile("" : "+v"(tid_));
    const int tid = tid_, wid = __builtin_amdgcn_readfirstlane(tid >> 6), lane = tid & 63, wr = wid >> 2, wc = wid & 3, fr = lane & 15, fq = lane >> 4;
    const int K = g.K, nt = K / BK;
    unsigned voffA[2], voffB[2];
#pragma unroll
    for (int i = 0; i < 2; ++i) { int R, C; stage_rc(tid * 16 + i * 8192, R, C); const int Rb = Epi::PERM ? ((R & ~31) + perm32(R & 31)) : R;
        voffA[i] = (unsigned)(R * K + C) * 2u; voffB[i] = (unsigned)(Rb * K + C) * 2u; }
    const size_t kstep = (size_t)(BK * 2);
    const size_t hstep = (size_t)HALF * K * 2;
    const size_t tstep = 2 * hstep;
    const unsigned ldsw = (unsigned)wid * 1024u;
    const int aoff = lds_byte(wr * 64 + fr, fq * 8), boff = lds_byte(wc * 32 + fr, fq * 8);
#define PG8_SA(b, h) (((b) * 2 + (h)) * HTB)
#define PG8_SB(b, h) ((4 + (b) * 2 + (h)) * HTB)
#define PG8_STAGE(bufoff, gbase, voff) do { _Pragma("unroll") for (int _i = 0; _i < 2; ++_i) \
        __builtin_amdgcn_global_load_lds((const unsigned*)((const char*)(gbase) + (voff)[_i]), (PG8_LAS unsigned*)(lds + (bufoff) + ldsw + _i * 8192), 16, 0, 0); } while (0)
#define PG8_LDA(dst, b, h) do { _Pragma("unroll") for (int m = 0; m < 4; ++m) _Pragma("unroll") for (int k = 0; k < 2; ++k) dst[m][k] = *(const PG8_LAS bf16x8*)(lds + PG8_SA(b, h) + aoff + m * 2048 + k * 1024); } while (0)
#define PG8_LDB(dst, b, h) do { _Pragma("unroll") for (int n = 0; n < 2; ++n) _Pragma("unroll") for (int k = 0; k < 2; ++k) dst[n][k] = *(const PG8_LAS bf16x8*)(lds + PG8_SB(b, h) + boff + n * 2048 + k * 1024); } while (0)
#define PG8_MMA(ai, bj, At, Bt) do { __builtin_amdgcn_s_setprio(1); _Pragma("unroll") for (int m = 0; m < 4; ++m) _Pragma("unroll") for (int n = 0; n < 2; ++n) _Pragma("unroll") for (int k = 0; k < 2; ++k) \
        acc[ai][bj][m][n] = __builtin_amdgcn_mfma_f32_16x16x32_bf16(Bt[n][k], At[m][k], acc[ai][bj][m][n], 0, 0, 0); __builtin_amdgcn_s_setprio(0); } while (0)
#define PG8_WAIT_V(n) asm volatile("s_waitcnt vmcnt(" #n ")" ::: "memory")
#define PG8_WAIT_L(n) asm volatile("s_waitcnt lgkmcnt(" #n ")" ::: "memory")
#define PG8_BAR __builtin_amdgcn_s_barrier()
#define PG8_SCHED __builtin_amdgcn_sched_barrier(0)
    Unit cur, nxt; int ui = 0;
    if (!S.next(0, cur)) return;
    f32x4 acc[2][2][4][2];
#pragma unroll
    for (int a = 0; a < 2; ++a)
#pragma unroll
        for (int b = 0; b < 2; ++b)
#pragma unroll
            for (int m = 0; m < 4; ++m)
#pragma unroll
                for (int n = 0; n < 2; ++n) acc[a][b][m][n] = (f32x4){0.f, 0.f, 0.f, 0.f};
    bf16x8 At[4][2], B0[2][2], B1[2][2];
    const char* cA = (const char*)g.A + (size_t)cur.pm * tstep; const char* cB = (const char*)g.Bt + (size_t)cur.pn * tstep;
    S.a_ready(cur);
    if constexpr (SP2) {
        PG8_STAGE(PG8_SB(0, 0), cB, voffB); PG8_STAGE(PG8_SB(0, 1), cB + hstep, voffB); PG8_STAGE(PG8_SA(0, 0), cA, voffA); PG8_STAGE(PG8_SA(0, 1), cA + hstep, voffA);
        if (wr == 1) PG8_BAR;
        PG8_WAIT_V(2); PG8_BAR;
        PG8_STAGE(PG8_SB(1, 0), cB + kstep, voffB); PG8_STAGE(PG8_SA(1, 0), cA + kstep, voffA); PG8_STAGE(PG8_SB(1, 1), cB + hstep + kstep, voffB);
        PG8_WAIT_V(6); PG8_BAR;
    } else {
        PG8_STAGE(PG8_SB(0, 0), cB, voffB); PG8_STAGE(PG8_SA(0, 0), cA, voffA); PG8_STAGE(PG8_SB(0, 1), cB + hstep, voffB); PG8_STAGE(PG8_SA(0, 1), cA + hstep, voffA);
        if (wr == 1) PG8_BAR;
        PG8_WAIT_V(4); PG8_BAR;
        PG8_STAGE(PG8_SB(1, 0), cB + kstep, voffB); PG8_STAGE(PG8_SA(1, 0), cA + kstep, voffA); PG8_STAGE(PG8_SB(1, 1), cB + hstep + kstep, voffB);
        PG8_WAIT_V(6); PG8_BAR;
    }
    for (;;) {
        const bool has_next = S.next(ui + 1, nxt);
        const char* nA = has_next ? (const char*)g.A + (size_t)nxt.pm * tstep : cA; const char* nB = has_next ? (const char*)g.Bt + (size_t)nxt.pn * tstep : cB;
        for (int t = 0; t < nt; t += 2) {
            const bool last = (t == nt - 2);
            const char* a1 = cA + (size_t)(t + 1) * kstep;
            const char* a2 = last ? nA : cA + (size_t)(t + 2) * kstep; const char* b2 = last ? nB : cB + (size_t)(t + 2) * kstep;
            const char* a3 = a2 + kstep; const char* b3 = b2 + kstep;
            if (last && has_next) S.a_ready(nxt);
            if constexpr (SP2) {
            PG8_LDB(B0, 0, 0); PG8_LDB(B1, 0, 1); PG8_SCHED; PG8_LDA(At, 0, 0); PG8_STAGE(PG8_SA(1, 1), a1 + hstep, voffA);
            PG8_WAIT_V(8); PG8_WAIT_L(0); PG8_BAR; PG8_MMA(0, 0, At, B0); PG8_MMA(0, 1, At, B1); PG8_BAR; PG8_SCHED;
            PG8_LDA(At, 0, 1); PG8_STAGE(PG8_SB(0, 0), b2, voffB); PG8_STAGE(PG8_SB(0, 1), b2 + hstep, voffB); PG8_STAGE(PG8_SA(0, 0), a2, voffA);
            PG8_WAIT_V(8); PG8_WAIT_L(0); PG8_BAR; PG8_MMA(1, 0, At, B0); PG8_MMA(1, 1, At, B1); PG8_BAR; PG8_SCHED;
            PG8_LDB(B0, 1, 0); PG8_LDB(B1, 1, 1); PG8_SCHED; PG8_LDA(At, 1, 0); PG8_STAGE(PG8_SA(0, 1), a2 + hstep, voffA);
            PG8_WAIT_V(8); PG8_WAIT_L(0); PG8_BAR; PG8_MMA(0, 0, At, B0); PG8_MMA(0, 1, At, B1); PG8_BAR; PG8_SCHED;
            PG8_LDA(At, 1, 1); PG8_STAGE(PG8_SB(1, 0), b3, voffB); PG8_STAGE(PG8_SB(1, 1), b3 + hstep, voffB); PG8_STAGE(PG8_SA(1, 0), a3, voffA);
            PG8_WAIT_V(8); PG8_WAIT_L(0); PG8_BAR; PG8_MMA(1, 0, At, B0); PG8_MMA(1, 1, At, B1); PG8_BAR; PG8_SCHED;
            } else {
            PG8_LDB(B0, 0, 0); PG8_SCHED; PG8_LDA(At, 0, 0); PG8_STAGE(PG8_SA(1, 1), a1 + hstep, voffA);
            PG8_WAIT_L(8); PG8_BAR; PG8_WAIT_L(0); PG8_MMA(0, 0, At, B0); PG8_BAR; PG8_SCHED;
            PG8_LDB(B1, 0, 1); PG8_STAGE(PG8_SB(0, 0), b2, voffB);
            PG8_BAR; PG8_WAIT_L(0); PG8_MMA(0, 1, At, B1); PG8_BAR;
            PG8_LDA(At, 0, 1); PG8_STAGE(PG8_SA(0, 0), a2, voffA);
            PG8_BAR; PG8_WAIT_L(0); PG8_MMA(1, 0, At, B0); PG8_BAR; PG8_SCHED;
            PG8_STAGE(PG8_SB(0, 1), b2 + hstep, voffB);
            PG8_WAIT_V(6); PG8_BAR; PG8_MMA(1, 1, At, B1); PG8_BAR;
            PG8_LDB(B0, 1, 0); PG8_SCHED; PG8_LDA(At, 1, 0); PG8_STAGE(PG8_SA(0, 1), a2 + hstep, voffA);
            PG8_WAIT_L(8); PG8_BAR; PG8_WAIT_L(0); PG8_MMA(0, 0, At, B0); PG8_BAR; PG8_SCHED;
            PG8_LDB(B1, 1, 1); PG8_STAGE(PG8_SB(1, 0), b3, voffB);
            PG8_BAR; PG8_WAIT_L(0); PG8_MMA(0, 1, At, B1); PG8_BAR;
            PG8_LDA(At, 1, 1); PG8_STAGE(PG8_SA(1, 0), a3, voffA);
            PG8_BAR; PG8_WAIT_L(0); PG8_MMA(1, 0, At, B0); PG8_BAR; PG8_SCHED;
            PG8_STAGE(PG8_SB(1, 1), b3 + hstep, voffB);
            PG8_WAIT_V(6); PG8_BAR; PG8_MMA(1, 1, At, B1); PG8_BAR;
            }
        }
        if constexpr (ALIGN_EPI) { if (wr == 0) PG8_BAR; }
        if constexpr (!Epi::AFTER_DRAIN) { E(acc, cur, wr, wc, fr, fq); S.done(cur); }
        if (!has_next) break;
#pragma unroll
        for (int a = 0; a < 2; ++a)
#pragma unroll
            for (int b = 0; b < 2; ++b)
#pragma unroll
                for (int m = 0; m < 4; ++m)
#pragma unroll
                    for (int n = 0; n < 2; ++n) acc[a][b][m][n] = (f32x4){0.f, 0.f, 0.f, 0.f};
        cur = nxt; cA = nA; cB = nB; ++ui;
        if constexpr (ALIGN_EPI) { if (wr == 1) PG8_BAR; }
    }
    PG8_WAIT_V(0);
    if constexpr (!ALIGN_EPI) { if (wr == 0) PG8_BAR; }
    PG8_BAR;
    if constexpr (Epi::AFTER_DRAIN) { E.fused(acc, cur, wr, wc, fr, fq, lds, wid, lane); S.done(cur); }
#undef PG8_SA
#undef PG8_SB
#undef PG8_STAGE
#undef PG8_LDA
#undef PG8_LDB
#undef PG8_MMA
#undef PG8_WAIT_V
#undef PG8_WAIT_L
#undef PG8_BAR
#undef PG8_SCHED
}
}
namespace swa {
constexpr int D = 128;
constexpr int LDP = 20480;
constexpr int LDO = 2048;
constexpr float THR = 8.f;
constexpr bool WSKIP = false;
constexpr float SCALE = 0.08838834764831845f;
constexpr int NW = 8, QBLK = 32, KVBLK = 64, QB = NW * QBLK;
constexpr int SHM_V = KVBLK * D * 2, SHM_K = KVBLK * D * 2;
constexpr int LDS_BYTES = 2 * SHM_V + 2 * SHM_K + NW * 64 * 4;
static_assert(D == 128, "geometry");

using bf16 = __hip_bfloat16;
typedef short bf16x8 __attribute__((ext_vector_type(8)));
typedef short s16x4 __attribute__((ext_vector_type(4)));
typedef float f32x16 __attribute__((ext_vector_type(16)));
typedef float f32x4 __attribute__((ext_vector_type(4)));
typedef unsigned u32x4 __attribute__((ext_vector_type(4)));
template <class A, class Bt> struct same_t { static constexpr bool v = false; };
template <class A> struct same_t<A, A> { static constexpr bool v = true; };

#define KSWZ(row, colB) ((row) * 256 + ((colB) ^ (((row) & 7) << 4)))
#define SBAR() __builtin_amdgcn_sched_barrier(0)
__device__ __forceinline__ int v_st(int k, int c) { const int kk = (k & ~0xC) | ((k & 4) << 1) | ((k & 8) >> 1); return ((kk >> 3) * 4 + (c >> 5)) * 512 + ((kk & 7) * 32 + (c & 31)) * 2; }
__device__ __forceinline__ int v_rd_base(int lane) { return ((lane & 3) << 3) | (((lane >> 2) & 3) << 6) | (((lane >> 4) & 1) << 5) | (((lane >> 5) & 1) << 8); }
constexpr int v_rd_off(int d0, int ks, int half) { return d0 * 512 + ks * 4096 + half * 2048; }
__device__ __forceinline__ int crow(int r, int hi) { return (r & 3) + 8 * (r >> 2) + 4 * hi; }
__device__ __forceinline__ unsigned cvtpk(float lo, float hi) {
    unsigned r; asm volatile("v_cvt_pk_bf16_f32 %0, %1, %2" : "=v"(r) : "v"(lo), "v"(hi)); return r;
}
__device__ __forceinline__ bf16x8 pack8(f32x4 a, f32x4 b) {
    u32x4 w = {cvtpk(a[0], a[1]), cvtpk(a[2], a[3]), cvtpk(b[0], b[1]), cvtpk(b[2], b[3])};
    return *reinterpret_cast<bf16x8*>(&w);
}
template <class T> __device__ __forceinline__ bf16x8 load8(const T* p) {
    if constexpr (same_t<T, float>::v) { return pack8(*(const f32x4*)p, *(const f32x4*)(p + 4)); }
    else { return *reinterpret_cast<const bf16x8*>(p); }
}
__device__ __forceinline__ void mask_tile(f32x16& p0, f32x16& p1, int dq, unsigned W) {
    const float NEG = -__builtin_inff();
#pragma unroll
    for (int r = 0; r < 16; ++r) {
        const int c = (r & 3) + 8 * (r >> 2);
        if ((unsigned)(dq - c) >= W) p0[r] = NEG;
        if ((unsigned)(dq - c - 32) >= W) p1[r] = NEG;
    }
}
__device__ __forceinline__ void partialSM(f32x16& p0, f32x16& p1, float& m_reg, float& mn, float& alpha) {
    float pmax = p0[0]; for (int r = 1; r < 16; ++r) pmax = fmaxf(pmax, p0[r]); for (int r = 0; r < 16; ++r) pmax = fmaxf(pmax, p1[r]);
    { auto rr = __builtin_amdgcn_permlane32_swap(__float_as_uint(pmax), __float_as_uint(pmax), false, false);
      pmax = fmaxf(__uint_as_float(rr[0]), __uint_as_float(rr[1])); }
    constexpr float C2 = 1.4426950408889634f * SCALE;
    if (__builtin_expect(__all((pmax - m_reg) * SCALE <= THR), 1)) { mn = m_reg; alpha = 1.f; }
    else { mn = fmaxf(m_reg, pmax); alpha = __builtin_amdgcn_exp2f((m_reg - mn) * C2); m_reg = mn; }
    const float mnL = -mn * C2;
    for (int r = 0; r < 16; ++r) p0[r] = fmaf(p0[r], C2, mnL); for (int r = 0; r < 16; ++r) p1[r] = fmaf(p1[r], C2, mnL);
    for (int r = 0; r < 16; ++r) p0[r] = __builtin_amdgcn_exp2f(p0[r]);
}
__device__ __forceinline__ void finishSM(f32x16& p0, f32x16& p1, float alpha, float& l_reg, bf16x8& pa0, bf16x8& pa1, bf16x8& pa2, bf16x8& pa3) {
    for (int r = 0; r < 16; ++r) p1[r] = __builtin_amdgcn_exp2f(p1[r]);
    float ps = 0; for (int r = 0; r < 16; ++r) ps += p0[r]; for (int r = 0; r < 16; ++r) ps += p1[r];
    { auto rr = __builtin_amdgcn_permlane32_swap(__float_as_uint(ps), __float_as_uint(ps), false, false);
      ps = __uint_as_float(rr[0]) + __uint_as_float(rr[1]); }
    l_reg = l_reg * alpha + ps;
#define PK4(P, B_, OUT) do { unsigned a0 = cvtpk(P[B_+0], P[B_+1]), a1 = cvtpk(P[B_+2], P[B_+3]);                          \
        unsigned b0 = cvtpk(P[B_+4], P[B_+5]), b1 = cvtpk(P[B_+6], P[B_+7]);                                             \
        auto r0 = __builtin_amdgcn_permlane32_swap(a0, b0, false, false); auto r1 = __builtin_amdgcn_permlane32_swap(a1, b1, false, false); \
        u32x4 w = {r0[0], r1[0], r0[1], r1[1]}; OUT = *reinterpret_cast<bf16x8*>(&w); } while (0)
    PK4(p0, 0, pa0); PK4(p0, 8, pa1); PK4(p1, 0, pa2); PK4(p1, 8, pa3);
#undef PK4
}
template <int KB, bool SK>
__device__ __forceinline__ void qkt(f32x16& p0, f32x16& p1, const char* K_lds, int r32, int hi, const bf16x8* qr, bool act) {
    if (SK && !act) { const float NEG = -__builtin_inff();
#pragma unroll
        for (int r = 0; r < 16; ++r) { p0[r] = NEG; p1[r] = NEG; } return; }
    p0 = f32x16{}; p1 = f32x16{};
    const char* kb[4];
#pragma unroll
    for (int dd = 0; dd < 4; ++dd) kb[dd] = K_lds + KB * SHM_K + KSWZ(r32, (dd * 16 + hi * 8) * 2);
#pragma unroll
    for (int d0 = 0; d0 < 8; ++d0) { const char* a = kb[d0 & 3] + (d0 >> 2) * 128;
        bf16x8 b0 = *reinterpret_cast<const bf16x8*>(a);
        bf16x8 b1 = *reinterpret_cast<const bf16x8*>(a + 32 * 256);
        p0 = __builtin_amdgcn_mfma_f32_32x32x16_bf16(b0, qr[d0], p0, 0, 0, 0);
        p1 = __builtin_amdgcn_mfma_f32_32x32x16_bf16(b1, qr[d0], p1, 0, 0, 0); }
}
template <int VB, bool SK>
__device__ __forceinline__ void pv_tile(f32x16* o, int vb0, bf16x8 pa0, bf16x8 pa1, bf16x8 pa2, bf16x8 pa3, bool act) {
    if (SK && !act) return;
#define TRRD(dst, off) asm volatile("ds_read_b64_tr_b16 %0, %1 offset:%2" : "=&v"(dst) : "v"(vb0), "i"(off) : "memory")
#define PV_D0(d0) do { s16x4 l0, l1, l2, l3, h0, h1, h2, h3; constexpr int b_ = VB * SHM_V + v_rd_off(d0, 0, 0);     \
        TRRD(l0, b_); TRRD(h0, b_ + 2048); TRRD(l1, b_ + 4096); TRRD(h1, b_ + 6144); TRRD(l2, b_ + 8192); TRRD(h2, b_ + 10240); TRRD(l3, b_ + 12288); TRRD(h3, b_ + 14336); \
        asm volatile("s_waitcnt lgkmcnt(0)" ::: "memory"); SBAR();                 \
        o[d0] = __builtin_amdgcn_mfma_f32_32x32x16_bf16(pa0, (bf16x8){l0[0], l0[1], l0[2], l0[3], h0[0], h0[1], h0[2], h0[3]}, o[d0], 0, 0, 0);   \
        o[d0] = __builtin_amdgcn_mfma_f32_32x32x16_bf16(pa1, (bf16x8){l1[0], l1[1], l1[2], l1[3], h1[0], h1[1], h1[2], h1[3]}, o[d0], 0, 0, 0);   \
        o[d0] = __builtin_amdgcn_mfma_f32_32x32x16_bf16(pa2, (bf16x8){l2[0], l2[1], l2[2], l2[3], h2[0], h2[1], h2[2], h2[3]}, o[d0], 0, 0, 0);   \
        o[d0] = __builtin_amdgcn_mfma_f32_32x32x16_bf16(pa3, (bf16x8){l3[0], l3[1], l3[2], l3[3], h3[0], h3[1], h3[2], h3[3]}, o[d0], 0, 0, 0); } while (0)
    PV_D0(0); PV_D0(1); PV_D0(2); PV_D0(3);
#undef PV_D0
#undef TRRD
}

template <class TIn, class TOut> struct BlockRef { const TIn* Q; const TIn* K; const TIn* V; TOut* O; int P0; };
template <class TIn> struct Seam {
    bf16x8 qr[8];
    bf16x8 st_v0, st_v1, st_k0, st_k1; f32x4 sf0, sf1, sf2, sf3;
    f32x4 tq[16];
};
__device__ __forceinline__ int swa_jlo(int P0, int W) { const int lowk = P0 - W + 1; return lowk > 0 ? lowk / KVBLK : 0; }
#define ROW(p, k0, rr) ((p) + (size_t)((k0) + (rr)) * LDP + sc)
#define VMW() asm volatile("s_waitcnt vmcnt(0)" ::: "memory")
#define VMWN(n) asm volatile("s_waitcnt vmcnt(%0)" :: "i"(n) : "memory")
#define SLOAD_H(Kp, Vp, k0) do { S.st_v0 = load8<TIn>(ROW(Vp, k0, sr)); S.st_v1 = load8<TIn>(ROW(Vp, k0, 32 + sr));              \
                         S.st_k0 = load8<TIn>(ROW(Kp, k0, sr)); S.st_k1 = load8<TIn>(ROW(Kp, k0, 32 + sr)); } while (0)
#define SWRITE_HK(bf) do { *(bf16x8*)(K_lds + (bf) * SHM_K + kws) = S.st_k0; *(bf16x8*)(K_lds + (bf) * SHM_K + kws + 32 * 256) = S.st_k1; } while (0)
#define SWRITE_HV(bf) do { *(bf16x8*)(V_lds + (bf) * SHM_V + vst0) = S.st_v0; *(bf16x8*)(V_lds + (bf) * SHM_V + vst1) = S.st_v1; } while (0)
#define SWRITE_H(bf) do { SWRITE_HV(bf); SWRITE_HK(bf); } while (0)
#define SLOAD_F(p, k0) do { S.sf0 = *(const f32x4*)ROW(p, k0, sr); S.sf1 = *(const f32x4*)(ROW(p, k0, sr) + 4);                \
                            S.sf2 = *(const f32x4*)ROW(p, k0, 32 + sr); S.sf3 = *(const f32x4*)(ROW(p, k0, 32 + sr) + 4); } while (0)
#define SWRITE_KF(bf) do { *(bf16x8*)(K_lds + (bf) * SHM_K + kws) = pack8(S.sf0, S.sf1); *(bf16x8*)(K_lds + (bf) * SHM_K + kws + 32 * 256) = pack8(S.sf2, S.sf3); } while (0)
#define SWRITE_VF(bf) do { *(bf16x8*)(V_lds + (bf) * SHM_V + vst0) = pack8(S.sf0, S.sf1); *(bf16x8*)(V_lds + (bf) * SHM_V + vst1) = pack8(S.sf2, S.sf3); } while (0)
template <class TIn, class TOut>
__device__ __forceinline__ void causal_swa_prime(const BlockRef<TIn, TOut>& cur, int W, char* lds, Seam<TIn>& S) {
    constexpr bool F32 = same_t<TIn, float>::v;
    int tid_ = threadIdx.x; asm volatile("" : "+v"(tid_));
    const int tid = tid_, wid = __builtin_amdgcn_readfirstlane(tid >> 6), lane = tid & 63, r32 = lane & 31, hi = lane >> 5;
    const int sr = tid >> 4, sc = (tid & 15) * 8, kws = KSWZ(sr, sc * 2); char* K_lds = lds + 2 * SHM_V;
    const int kb0 = swa_jlo(cur.P0, W) * KVBLK;
    for (int d0 = 0; d0 < 8; ++d0) S.qr[d0] = load8<TIn>(cur.Q + (size_t)(wid * QBLK + r32) * LDP + d0 * 16 + hi * 8);
    if constexpr (F32) { SLOAD_F((const float*)cur.K, kb0); VMW(); SWRITE_KF(0); SBAR(); SLOAD_F((const float*)cur.V, kb0); }
    else { SLOAD_H(cur.K, cur.V, kb0); VMW(); SWRITE_HK(0); }
    __syncthreads();
}
template <class TIn, class TOut>
__device__ __forceinline__ void causal_swa_block(const BlockRef<TIn, TOut>& cur, const BlockRef<TIn, TOut>& nxt, int skv, int W, char* lds, Seam<TIn>& S) {
    constexpr bool F32 = same_t<TIn, float>::v;
    int tid_ = threadIdx.x; asm volatile("" : "+v"(tid_));
    const int tid = tid_, wid = __builtin_amdgcn_readfirstlane(tid >> 6), lane = tid & 63, r32 = lane & 31, hi = lane >> 5;
    const int j_lo = swa_jlo(cur.P0, W);
    int j_hi = (cur.P0 + QB - 1) / KVBLK + 1; if (j_hi > skv / KVBLK) j_hi = skv / KVBLK;
    const int NT = j_hi - j_lo;
    const int kbn = swa_jlo(nxt.P0, W) * KVBLK;
    const int qlo = cur.P0 + wid * QBLK, qm = qlo + r32 - 4 * hi;
    char* V_lds = lds; char* K_lds = lds + 2 * SHM_V;
    float* ws = (float*)(lds + 2 * SHM_V + 2 * SHM_K) + wid * 64; float* li_l = ws, * al_l = ws + 32;
    float m_reg = -1e30f, l_reg = 0; f32x16 o[4] = {};
    const int sr = tid >> 4, sc = (tid & 15) * 8, vst0 = v_st(sr, sc), vst1 = v_st(32 + sr, sc), kws = KSWZ(sr, sc * 2);
    const int vb0 = (int)(uintptr_t)V_lds + v_rd_base(lane);
    const TIn* Kh = cur.K; const TIn* Vh = cur.V;
#define RESC(a) do { if (__any((a) < 1.f)) { if (hi == 0) al_l[r32] = (a); asm volatile("s_waitcnt lgkmcnt(0)" ::: "memory");              \
                     for (int d_ = 0; d_ < 4; ++d_) for (int r = 0; r < 16; ++r) o[d_][r] *= al_l[crow(r, hi)]; } } while (0)
#define KBASE(t) ((j_lo + (t)) * KVBLK)
#define ACT(t) (KBASE(t) <= qlo + QBLK - 1 && KBASE(t) + KVBLK - 1 >= qlo - W + 1)
#define MASKT(P0_, P1_, t) do { const int kb_ = KBASE(t); if ((!SK || ACT(t)) && (kb_ + KVBLK - 1 > qlo || kb_ <= qlo + QBLK - 1 - W)) mask_tile(P0_, P1_, qm - kb_, (unsigned)W); } while (0)
    constexpr int NQL = F32 ? 16 : 8;
    constexpr bool SK = WSKIP && !F32;
#define SEAM_K0() do { VMWN(NQL); if constexpr (F32) { SWRITE_KF(0); SBAR(); SLOAD_F((const float*)nxt.V, kbn); } else { SWRITE_HK(0); } SBAR(); } while (0)
    f32x16 pA0, pA1, pB0, pB1; float mnA, mnB, alA, alB; bf16x8 pa0, pa1, pa2, pa3;
    if constexpr (F32) { VMW(); SWRITE_VF(0); SBAR(); } else { SWRITE_HV(0); SBAR(); }
    if (NT > 1) { if constexpr (F32) SLOAD_F((const float*)Kh, KBASE(1)); else SLOAD_H(Kh, Vh, KBASE(1)); }
    SBAR(); qkt<0, SK>(pA0, pA1, K_lds, r32, hi, S.qr, ACT(0));
    if constexpr (F32) { if (NT > 1) { VMW(); SWRITE_KF(1); SBAR(); SLOAD_F((const float*)Vh, KBASE(1)); } }
    MASKT(pA0, pA1, 0); partialSM(pA0, pA1, m_reg, mnA, alA);
    if (NT > 1) { VMW(); if constexpr (F32) { SWRITE_VF(1); SBAR(); if (NT > 2) SLOAD_F((const float*)Kh, KBASE(2)); } else SWRITE_H(1); }
    __syncthreads();
#define HALF_STEP(PX0, PX1, mnX, alX, PY0, PY1, alY, t, KB, VB, SB) do {                                                      \
        SBAR(); qkt<KB, SK>(PX0, PX1, K_lds, r32, hi, S.qr, ACT(t));                                             \
        finishSM(PY0, PY1, alY, l_reg, pa0, pa1, pa2, pa3); SBAR();                                                           \
        if ((t) + 1 < NT) { if constexpr (F32) { VMW(); SWRITE_KF(SB); SBAR(); SLOAD_F((const float*)Vh, KBASE((t) + 1)); }  \
                            else { SLOAD_H(Kh, Vh, KBASE((t) + 1)); } SBAR(); }                                               \
        pv_tile<VB, SK>(o, vb0, pa0, pa1, pa2, pa3, ACT((t) - 1)); MASKT(PX0, PX1, (t)); partialSM(PX0, PX1, m_reg, mnX, alX);                                        \
        __syncthreads();                                                                                                      \
        if ((t) + 1 < NT) { VMW(); if constexpr (F32) { SWRITE_VF(SB); SBAR(); if ((t) + 2 < NT) SLOAD_F((const float*)Kh, KBASE((t) + 2)); } \
                            else { SWRITE_H(SB); } }                                                                          \
        RESC(alX); __syncthreads(); } while (0)
    for (int t = 1; t + 1 < NT; t += 2) {
        HALF_STEP(pB0, pB1, mnB, alB, pA0, pA1, alA, t, 1, 0, 0);
        HALF_STEP(pA0, pA1, mnA, alA, pB0, pB1, alB, t + 1, 0, 1, 1);
    }
    const bool even = (NT & 1) == 0;
    if (even) { SBAR(); qkt<1, SK>(pB0, pB1, K_lds, r32, hi, S.qr, ACT(NT - 1)); SBAR(); }
#define QROW(e) (nxt.Q + (size_t)(wid * QBLK + r32) * LDP + ((e) >> 1) * 16 + hi * 8 + ((e) & 1) * 4)
    if constexpr (F32) { SLOAD_F((const float*)nxt.K, kbn); SBAR();
#pragma unroll
        for (int e = 0; e < 8; ++e) S.tq[e] = *(const f32x4*)QROW(e); }
    else { SLOAD_H(nxt.K, nxt.V, kbn); SBAR();
#pragma unroll
        for (int d0 = 0; d0 < 8; ++d0) S.qr[d0] = load8<TIn>(nxt.Q + (size_t)(wid * QBLK + r32) * LDP + d0 * 16 + hi * 8); }
    SBAR();
    finishSM(pA0, pA1, alA, l_reg, pa0, pa1, pa2, pa3); SBAR();
    if constexpr (F32) {
#pragma unroll
        for (int e = 8; e < 16; ++e) S.tq[e] = *(const f32x4*)QROW(e); SBAR(); }
#undef QROW
    pv_tile<0, SK>(o, vb0, pa0, pa1, pa2, pa3, ACT(even ? NT - 2 : NT - 1));
    if (even) { MASKT(pB0, pB1, NT - 1); partialSM(pB0, pB1, m_reg, mnB, alB); __syncthreads(); RESC(alB);
        finishSM(pB0, pB1, alB, l_reg, pa0, pa1, pa2, pa3); SBAR(); pv_tile<1, SK>(o, vb0, pa0, pa1, pa2, pa3, ACT(NT - 1)); }
    SBAR(); SEAM_K0();
    if (hi == 0) li_l[r32] = l_reg; asm volatile("s_waitcnt lgkmcnt(0)" ::: "memory");
    float rli[16];
#pragma unroll
    for (int r = 0; r < 16; ++r) rli[r] = __builtin_amdgcn_rcpf(li_l[crow(r, hi)]);
    TOut* Ow = cur.O + (size_t)(wid * QBLK) * LDO;
#pragma unroll
    for (int r = 0; r < 16; ++r) { const int orow = crow(r, hi);
#pragma unroll
        for (int d0 = 0; d0 < 4; ++d0) { const float v = o[d0][r] * rli[r];
            if constexpr (same_t<TOut, float>::v) { Ow[(size_t)orow * LDO + d0 * 32 + r32] = v; }
            else { const float vn = __shfl_xor(v, 1);
                   if ((r32 & 1) == 0) *(unsigned*)(Ow + (size_t)orow * LDO + d0 * 32 + r32) = cvtpk(v, vn); } } }
    if constexpr (F32) {
#pragma unroll
        for (int d0 = 0; d0 < 8; ++d0) S.qr[d0] = pack8(S.tq[2 * d0], S.tq[2 * d0 + 1]); }
    __syncthreads();
#undef RESC
#undef KBASE
#undef ACT
#undef MASKT
#undef SEAM_K0
#undef HALF_STEP
}
#undef ROW
#undef VMW
#undef VMWN
#undef SLOAD_H
#undef SWRITE_HK
#undef SWRITE_HV
#undef SWRITE_H
#undef SLOAD_F
#undef SWRITE_KF
#undef SWRITE_VF

}

constexpr int NWAVES = 8;
#ifndef MK_PER_PHASE
#define MK_PER_PHASE 0
#endif
constexpr int NPH = 12;

constexpr int BATCH = 2, SEQ = 8192, DM = 4096, M = BATCH * SEQ;
constexpr int NHEADS = 8;
constexpr int NIN = 20480, CWID = 2048, DFF = 11008, NUP = 2 * DFF;
constexpr int OFF_Q = 0, OFF_K = 2048, OFF_V = 4096, OFF_U = 6144, OFF_GB = 8192, OFF_GC = 10240, OFF_GA = 12288, OFF_GCV = 16384;
constexpr float LN_EPS = 1e-5f, RMS_EPS = 1e-5f;
constexpr float ALPHA = 1.189207115002721f;
constexpr float LAM_INIT = 0.2f;

constexpr size_t MiB = 1u << 20;
constexpr size_t WS_CTL = 0, CTL_ZERO_BYTES = 1 * MiB;
constexpr size_t WS_WA = 1 * MiB, WS_WC = 17 * MiB, WS_WO = 33 * MiB, WS_WIN = 65 * MiB, WS_XB = 225 * MiB, WS_PROJ = 353 * MiB, WS_ATTN = 993 * MiB, WS_YC = 1057 * MiB;
constexpr size_t WS_O1 = 65 * MiB, WS_O2 = 225 * MiB;
constexpr size_t WS_MERGED = 65 * MiB;
constexpr size_t WS_H1B = 225 * MiB;
constexpr size_t WS_Z = 353 * MiB;
constexpr size_t WS_WUP = 1041 * MiB, WS_WDN = 1213 * MiB;
constexpr size_t WS_G = 1 * MiB;
constexpr size_t WS_END = 1299 * MiB;
static_assert(WS_Z + (size_t)M * NUP * 2 <= WS_WUP && WS_WUP + (size_t)NUP * DM * 2 <= WS_WDN && WS_WDN + (size_t)DM * DFF * 2 <= WS_END, "ws map (ffn)");
static_assert(WS_G + (size_t)M * DFF * 2 <= WS_Z && WS_PROJ + (size_t)M * NIN * 2 <= WS_ATTN && WS_WIN + (size_t)NIN * DM * 2 <= WS_XB, "ws map");
constexpr int CW_BAR = 4096;

constexpr int RING_OFF = 0, RING_BYTES = 131072;
constexpr int LDSCTL_OFF = RING_BYTES, MISC_OFF = LDSCTL_OFF + 320;
constexpr int LDS_BYTES = 147456;
static_assert(MISC_OFF + 128 <= LDS_BYTES, "LDS map");

#define GAS __attribute__((address_space(1)))
#define LAS __attribute__((address_space(3)))
typedef unsigned short bf16;
typedef unsigned v4u __attribute__((ext_vector_type(4)));
typedef float f32x4 __attribute__((ext_vector_type(4)));
typedef short bf16x8 __attribute__((ext_vector_type(8)));
typedef GAS unsigned gu32;
typedef GAS unsigned long long gu64;
#define RLX_AGENT __ATOMIC_RELAXED, __HIP_MEMORY_SCOPE_AGENT
#define LDS_WAIT() asm volatile("s_waitcnt lgkmcnt(0)" ::: "memory")
#define VM_WAIT() asm volatile("s_waitcnt vmcnt(0)" ::: "memory")
__device__ __forceinline__ unsigned long long rt() { return __builtin_amdgcn_s_memrealtime(); }
__device__ __forceinline__ unsigned f2bf(float f) { unsigned u = __builtin_bit_cast(unsigned, f); return (u + 0x7fffu + ((u >> 16) & 1u)) >> 16; }
__device__ __forceinline__ unsigned pk2(float lo, float hi) { return f2bf(lo) | (f2bf(hi) << 16); }

#define XB_TMO      128
#define XB_XCNT(j)  (256  + 64 * (j))
#define XB_XSUB(j)  (1280 + 64 * (j))
#define XB_XGEN(j)  (2304 + 64 * (j))
#define XB_TOP      3328
#define XB_TOPGEN   3392
#define XCD_BAR_WORDS 3456
#define XB_SPIN_CAP (1u << 18)

__device__ __forceinline__ unsigned xb_ld(unsigned* p)              { return __hip_atomic_load(p, __ATOMIC_RELAXED, __HIP_MEMORY_SCOPE_AGENT); }
__device__ __forceinline__ unsigned xb_add(unsigned* p, unsigned v) { return __hip_atomic_fetch_add(p, v, __ATOMIC_RELAXED, __HIP_MEMORY_SCOPE_AGENT); }
__device__ __forceinline__ unsigned xb_xcc_id() { return (unsigned)__builtin_amdgcn_s_getreg((3 << 11) | 20) & 0xFu; }
#define XB_SPIN(cond, bar) do { unsigned _sp = 0; while (cond) { __builtin_amdgcn_s_sleep(1); \
    if ((++_sp & 255u) == 0u) { if (xb_ld(&(bar)[XB_TMO])) break; if (_sp > XB_SPIN_CAP) { atomicAdd(&(bar)[XB_TMO], 1u); break; } } } } while (0)

struct XcdBarrier {
    unsigned* bar; unsigned x;
    volatile LAS unsigned* st;
};

__device__ __forceinline__ XcdBarrier xcd_barrier_post(unsigned* bar, volatile LAS unsigned* st) {
    XcdBarrier b; b.bar = bar; b.x = xb_xcc_id(); b.st = st;
    if (threadIdx.x == 0) (void)xb_add(&bar[XB_XCNT(b.x)], 1u);
    return b;
}
__device__ __forceinline__ void xcd_barrier_complete(unsigned* bar, unsigned x, unsigned& nloc, unsigned& nx) {
    const unsigned G = gridDim.x * gridDim.y * gridDim.z;
    unsigned sum, cnt, mine, sp = 0u;
    for (;;) {
        sum = 0u; cnt = 0u; mine = 0u;
#pragma unroll
        for (unsigned j = 0; j < 16; ++j) { const unsigned c = xb_ld(&bar[XB_XCNT(j)]); sum += c; cnt += (c > 0u) ? 1u : 0u; mine = (j == x) ? c : mine; }
        if (sum == G) break;
        __builtin_amdgcn_s_sleep(1);
        if ((++sp & 255u) == 0u) { if (xb_ld(&bar[XB_TMO])) break; if (sp > XB_SPIN_CAP) { atomicAdd(&bar[XB_TMO], 1u); break; } }
    }
    nloc = mine > 0u ? mine : 1u; nx = cnt > 0u ? cnt : 1u;
}

__device__ __forceinline__ void xcd_barrier(const XcdBarrier& b) {
    asm volatile("s_waitcnt vmcnt(0)" ::: "memory");
    __syncthreads();
    if (threadIdx.x == 0) {
        unsigned* bar = b.bar;
        __builtin_amdgcn_s_waitcnt(0);
        unsigned nloc = b.st[0], nx = b.st[1];
        if (nloc == 0u) { xcd_barrier_complete(bar, b.x, nloc, nx); b.st[0] = nloc; b.st[1] = nx; }
        const unsigned old = xb_add(&bar[XB_XSUB(b.x)], 1u);
        const unsigned gen = old / nloc;
        if (old + 1u == (gen + 1u) * nloc) {
            __builtin_amdgcn_fence(__ATOMIC_RELEASE, "agent");
            asm volatile("s_waitcnt vmcnt(0)" ::: "memory");
            const unsigned og = xb_add(&bar[XB_TOP], 1u);
            const unsigned tg = og / nx;
            if (og + 1u == (tg + 1u) * nx) xb_add(&bar[XB_TOPGEN], 1u);
            else XB_SPIN(xb_ld(&bar[XB_TOPGEN]) == tg, bar);
            __builtin_amdgcn_fence(__ATOMIC_ACQUIRE, "agent");
            xb_add(&bar[XB_XGEN(b.x)], 1u);
            asm volatile("s_waitcnt vmcnt(0)" ::: "memory");
        } else {
            XB_SPIN(xb_ld(&bar[XB_XGEN(b.x)]) == gen, bar);
            __builtin_amdgcn_fence(__ATOMIC_ACQUIRE, "agent");
            asm volatile("s_waitcnt vmcnt(0)" ::: "memory");
        }
    }
    __syncthreads();
}

struct Frame {
    LAS unsigned char* lds;
    volatile LAS unsigned* MISC;
    gu32* ctl;
    int wave;
    int vcu, G;
};
__device__ __forceinline__ unsigned pkbf(float lo, float hi) { return pg8::cvt_pk_bf16(lo, hi); }
__device__ __forceinline__ float wave_sum(float v) {
#pragma unroll
    for (int o = 1; o < 64; o <<= 1) v += __shfl_xor(v, o);
    return v;
}
__device__ __forceinline__ void transpose_item(const float* W, int K, int N, bf16* WT, LAS float* scr, int item, int lane) {
    const int nblk = N / 32, kb = item / nblk, nb = item % nblk, k0 = 64 * kb, n0 = 32 * nb;
#pragma unroll 8
    for (int i = 0; i < 32; ++i) { const int kk = 2 * i + (lane >> 5); scr[kk * 33 + (lane & 31)] = W[(size_t)(k0 + kk) * N + n0 + (lane & 31)]; }
    LDS_WAIT(); asm volatile("" ::: "memory");
    const int c = lane & 7;
#pragma unroll
    for (int j = 0; j < 4; ++j) { const int n = (lane >> 3) + 8 * j; const LAS float* s = scr + (8 * c) * 33 + n;
        v4u o; o.x = pkbf(s[0 * 33], s[1 * 33]); o.y = pkbf(s[2 * 33], s[3 * 33]); o.z = pkbf(s[4 * 33], s[5 * 33]); o.w = pkbf(s[6 * 33], s[7 * 33]);
        *(GAS v4u*)(WT + (size_t)(n0 + n) * K + k0 + 8 * c) = o; }
    LDS_WAIT(); asm volatile("" ::: "memory");
}
template <bool WB> __device__ __forceinline__ void ln_row(float* row, const float* g, const float* b, bf16* orow, int lane, bool poison) {
    GAS f32x4* xr = (GAS f32x4*)row + lane;
    f32x4 v[16]; float s = 0.f;
#pragma unroll
    for (int j = 0; j < 16; ++j) { v[j] = xr[64 * j]; s += (v[j].x + v[j].y) + (v[j].z + v[j].w); }
    const float mean = wave_sum(s) * (1.f / DM); float s2 = 0.f;
#pragma unroll
    for (int j = 0; j < 16; ++j) { v[j] = v[j] - mean; s2 += (v[j].x * v[j].x + v[j].y * v[j].y) + (v[j].z * v[j].z + v[j].w * v[j].w); }
    float rstd = 1.f / sqrtf(wave_sum(s2) * (1.f / DM) + LN_EPS);
    if (poison) rstd = __builtin_nanf("");
    const GAS f32x4* g4 = (const GAS f32x4*)g + lane; const GAS f32x4* b4 = (const GAS f32x4*)b + lane;
    GAS unsigned long long* o8 = (GAS unsigned long long*)orow + lane;
#pragma unroll
    for (int j = 0; j < 16; ++j) { const f32x4 o = v[j] * rstd * g4[64 * j] + b4[64 * j]; xr[64 * j] = o;
        if (WB) o8[64 * j] = (unsigned long long)pkbf(o.x, o.y) | ((unsigned long long)pkbf(o.z, o.w) << 32); }
}
__device__ __forceinline__ void unpack8(const v4u w, float (&f)[8]) {
    f[0] = __uint_as_float(w.x << 16); f[1] = __uint_as_float(w.x & 0xffff0000u); f[2] = __uint_as_float(w.y << 16); f[3] = __uint_as_float(w.y & 0xffff0000u);
    f[4] = __uint_as_float(w.z << 16); f[5] = __uint_as_float(w.z & 0xffff0000u); f[6] = __uint_as_float(w.w << 16); f[7] = __uint_as_float(w.w & 0xffff0000u);
}
__device__ __forceinline__ v4u pack8f(const float (&f)[8]) { v4u o; o.x = pkbf(f[0], f[1]); o.y = pkbf(f[2], f[3]); o.z = pkbf(f[4], f[5]); o.w = pkbf(f[6], f[7]); return o; }

struct AItem { int vh, qb0, qb1; };
__device__ __forceinline__ AItem a_dec(int L) { AItem it; it.vh = L >> 4; const int x = L & 15; it.qb0 = x; it.qb1 = 31 - x; return it; }
__device__ __forceinline__ swa::BlockRef<swa::bf16, float> a_ref(const AItem& it, int pass, const swa::bf16* proj, float* O1, float* O2) {
    const int qb = pass ? it.qb1 : it.qb0; const int vhalf = it.vh & 1, map = (it.vh >> 1) & 1, h = (it.vh >> 2) & 7, b = it.vh >> 5;
    const size_t row0 = (size_t)b * SEQ;
    swa::BlockRef<swa::bf16, float> r;
    r.Q = proj + (row0 + (size_t)qb * 256) * swa::LDP + OFF_Q + h * 256 + map * 128;
    r.K = proj + row0 * swa::LDP + OFF_K + h * 256 + map * 128;
    r.V = proj + row0 * swa::LDP + OFF_V + h * 256 + vhalf * 128;
    r.O = (map ? O2 : O1) + (row0 + (size_t)qb * 256) * swa::LDO + h * 256 + vhalf * 128;
    r.P0 = qb * 256;
    return r;
}


typedef const void __attribute__((address_space(4)))* karg_ptr_t;
template <int OFF> __device__ __forceinline__ unsigned long long karg_u64() {
    unsigned long long v; karg_ptr_t kp = (karg_ptr_t)__builtin_amdgcn_kernarg_segment_ptr();
    asm volatile("s_load_dwordx2 %0, %1, %2\n\ts_waitcnt lgkmcnt(0)" : "=s"(v) : "s"(kp), "i"(OFF)); return v; }
template <int OFF> __device__ __forceinline__ int karg_i32() {
    int v; karg_ptr_t kp = (karg_ptr_t)__builtin_amdgcn_kernarg_segment_ptr();
    asm volatile("s_load_dword %0, %1, %2\n\ts_waitcnt lgkmcnt(0)" : "=s"(v) : "s"(kp), "i"(OFF)); return v; }
#define KARG_F(k) ((const float*)(const GAS float*)karg_u64<8 * (k)>())
#define KARG_OUT() ((float*)(GAS float*)karg_u64<144>())
#define KARG_WS() ((unsigned char*)(GAS unsigned char*)karg_u64<152>())
__device__ __forceinline__ int lane_id() { int l; asm volatile("v_mbcnt_lo_u32_b32 %0, -1, 0\n\tv_mbcnt_hi_u32_b32 %0, -1, %0" : "=v"(l)); return l; }

struct Args { const float* in[18]; float* out; unsigned char* ws; int ph_lo, ph_hi, li, pad; };
__global__ void __launch_bounds__(NWAVES * 64, 2) fwd(Args  ) {
    extern __shared__ __attribute__((aligned(16))) unsigned char lds[];
    Frame F;
    F.lds = (LAS unsigned char*)lds;
    F.MISC = (volatile LAS unsigned*)(F.lds + MISC_OFF);
    F.wave = __builtin_amdgcn_readfirstlane((int)threadIdx.x >> 6);
    F.G = gridDim.x; { const int bx = blockIdx.x; F.vcu = (F.G % 8 == 0) ? (bx % 8) * (F.G / 8) + bx / 8 : bx; }
    F.ctl = (gu32*)(KARG_WS() + WS_CTL);
    for (int u = threadIdx.x; u < (LDS_BYTES - LDSCTL_OFF) / 4; u += NWAVES * 64) ((LAS unsigned*)(F.lds + LDSCTL_OFF))[u] = 0u;
    __syncthreads();
    XcdBarrier bar; bar.bar = (unsigned*)(F.ctl + CW_BAR); bar.x = 0; bar.st = nullptr;
    if (!MK_PER_PHASE) bar = xcd_barrier_post((unsigned*)(F.ctl + CW_BAR), F.MISC + 8);
#define GRID_BAR() do { if (!MK_PER_PHASE) xcd_barrier(bar); } while (0)
#if MK_PER_PHASE
    const int lo = karg_i32<160>(), hi = karg_i32<164>();
#else
    constexpr int lo = 0, hi = NPH;
#endif
#define IN(k) (lo <= (k) && (k) < hi)
#define BOTH(k) (IN(k) && IN((k) + 1))
    const int gw = F.vcu * NWAVES + F.wave, NGW = F.G * NWAVES;
    LAS float* scr = (LAS float*)(F.lds + RING_OFF + F.wave * 16384);

    if (IN(0)) {
        const int lane = lane_id();
        unsigned char* const ws = KARG_WS(); bf16* const Wa_t = (bf16*)(ws + WS_WA); bf16* const Wc_t = (bf16*)(ws + WS_WC); bf16* const Wo_t = (bf16*)(ws + WS_WO); bf16* const Win_t = (bf16*)(ws + WS_WIN); bf16* const XB = (bf16*)(ws + WS_XB);
        constexpr int I_IN = (DM / 64) * (NIN / 32), I_A = (CWID / 64) * (DM / 32), I_O = (DM / 64) * (DM / 32);
        constexpr int NIT = I_IN + 2 * I_A + I_O;
        const float* const w_in = KARG_F(1); const float* const w_ao = KARG_F(8); const float* const w_co = KARG_F(9); const float* const w_o = KARG_F(10); const float* const xin = KARG_F(0);
        for (int it = gw; it < NIT; it += NGW) {
            int r = it;
            if (r < I_IN) { transpose_item(w_in, DM, NIN, Win_t, scr, r, lane); continue; } r -= I_IN;
            if (r < I_A) { transpose_item(w_ao, CWID, DM, Wa_t, scr, r, lane); continue; } r -= I_A;
            if (r < I_A) { transpose_item(w_co, CWID, DM, Wc_t, scr, r, lane); continue; } r -= I_A;
            transpose_item(w_o, DM, DM, Wo_t, scr, r, lane);
        }
        const size_t n8 = (size_t)M * DM / 8;
        for (size_t i = (size_t)blockIdx.x * (NWAVES * 64) + F.wave * 64 + lane; i < n8; i += (size_t)F.G * (NWAVES * 64)) {
            const f32x4 a = ((const GAS f32x4*)xin)[2 * i], b = ((const GAS f32x4*)xin)[2 * i + 1];
            v4u o; o.x = pkbf(a.x, a.y); o.y = pkbf(a.z, a.w); o.z = pkbf(b.x, b.y); o.w = pkbf(b.z, b.w);
            ((GAS v4u*)XB)[i] = o;
        }
        if (BOTH(0)) GRID_BAR();
    }
    if (IN(1)) {
        unsigned char* const ws = KARG_WS(); bf16* const Win_t = (bf16*)(ws + WS_WIN); bf16* const XB = (bf16*)(ws + WS_XB); bf16* const PROJ = (bf16*)(ws + WS_PROJ);
        pg8::Gemm g{XB, Win_t, M, NIN, DM}; pg8::StaticOrder S; S.init(M, NIN, F.G, (int)blockIdx.x);
        pg8::EpiProj E{PROJ, NIN, OFF_GA};
        pg8::gemm_phase<pg8::EpiProj, pg8::StaticOrder, true, true>(F.lds + RING_OFF, g, S, E);
        if (BOTH(1)) GRID_BAR();
    }
    if (IN(2)) {
        unsigned char* const ws = KARG_WS(); bf16* const PROJ = (bf16*)(ws + WS_PROJ); float* const O1 = (float*)(ws + WS_O1); float* const O2 = (float*)(ws + WS_O2);
        using namespace swa;
        const int nitems = 64 * 16, stride = F.G;
        int L = F.vcu;
        if (L < nitems) {
            AItem it = a_dec(L); int pass = 0;
            BlockRef<swa::bf16, float> cur = a_ref(it, 0, (const swa::bf16*)PROJ, O1, O2);
            Seam<swa::bf16> S;
            causal_swa_prime<swa::bf16, float>(cur, SEQ, (char*)lds + RING_OFF, S);
            for (;;) {
                const bool more_pass = pass == 0, more_item = L + stride < nitems, last = !more_pass && !more_item;
                AItem itn = it; int passn = pass + 1, Ln = L;
                if (!more_pass) { passn = 0; Ln = more_item ? L + stride : L; itn = a_dec(Ln); }
                const BlockRef<swa::bf16, float> nxt = last ? cur : a_ref(itn, passn, (const swa::bf16*)PROJ, O1, O2);
                causal_swa_block<swa::bf16, float>(cur, nxt, SEQ, SEQ, (char*)lds + RING_OFF, S);
                if (last) break;
                cur = nxt; it = itn; pass = passn; L = Ln;
            }
        }
        if (BOTH(2)) GRID_BAR();
    }
    if (IN(3)) {
        const int lane = lane_id();
        unsigned char* const ws = KARG_WS(); bf16* const PROJ = (bf16*)(ws + WS_PROJ); float* const O1 = (float*)(ws + WS_O1); float* const O2 = (float*)(ws + WS_O2); bf16* const ATT = (bf16*)(ws + WS_ATTN); bf16* const YC = (bf16*)(ws + WS_YC);
        float s1, s2; { const float* const q1 = KARG_F(2); const float* const k1 = KARG_F(3); const float* const q2 = KARG_F(4); const float* const k2 = KARG_F(5);
          s1 = q1[lane] * k1[lane] + q1[lane + 64] * k1[lane + 64]; s1 = wave_sum(s1); s2 = q2[lane] * k2[lane] + q2[lane + 64] * k2[lane + 64]; s2 = wave_sum(s2); }
        const float lam = expf(s1) - expf(s2) + LAM_INIT;
        const f32x4 sg = ((const GAS f32x4*)KARG_F(6))[lane] * (1.0f - LAM_INIT);
        for (int t = gw; t < M; t += NGW) {
            const GAS f32x4* a4 = (const GAS f32x4*)(O1 + (size_t)t * 2048) + lane; const GAS f32x4* b4 = (const GAS f32x4*)(O2 + (size_t)t * 2048) + lane;
            GAS unsigned long long* o8 = (GAS unsigned long long*)(ATT + (size_t)t * 2048) + lane;
            f32x4 d[8];
#pragma unroll
            for (int h = 0; h < 8; ++h) d[h] = a4[64 * h] - b4[64 * h] * lam;
#pragma unroll
            for (int h = 0; h < 8; ++h) { float ss = (d[h].x * d[h].x + d[h].y * d[h].y) + (d[h].z * d[h].z + d[h].w * d[h].w); ss = wave_sum(ss);
                const float rstd = 1.f / sqrtf(ss * (1.f / 256.f) + RMS_EPS); const f32x4 o = d[h] * rstd * sg;
                o8[64 * h] = (unsigned long long)pkbf(o.x, o.y) | ((unsigned long long)pkbf(o.z, o.w) << 32); }
        }
        const float* const conv_w = KARG_F(7);
        for (int it = gw; it < (M / 32) * 4; it += NGW) {
            const int run = it >> 2, c = (it & 3) * 512 + lane * 8, t0 = run * 32;
            float w0[8], w1[8], w2[8], p1[8], p2[8];
            { const GAS f32x4* cw = (const GAS f32x4*)(conv_w + c);
              const f32x4 a = cw[0], b = cw[1], c1 = cw[CWID / 4], d1 = cw[CWID / 4 + 1], e = cw[2 * CWID / 4], f = cw[2 * CWID / 4 + 1];
              w0[0] = a.x; w0[1] = a.y; w0[2] = a.z; w0[3] = a.w; w0[4] = b.x; w0[5] = b.y; w0[6] = b.z; w0[7] = b.w;
              w1[0] = c1.x; w1[1] = c1.y; w1[2] = c1.z; w1[3] = c1.w; w1[4] = d1.x; w1[5] = d1.y; w1[6] = d1.z; w1[7] = d1.w;
              w2[0] = e.x; w2[1] = e.y; w2[2] = e.z; w2[3] = e.w; w2[4] = f.x; w2[5] = f.y; w2[6] = f.z; w2[7] = f.w; }
            if ((t0 & (SEQ - 1)) == 0) {
#pragma unroll
                for (int j = 0; j < 8; ++j) { p1[j] = 0.f; p2[j] = 0.f; }
            } else {
                float ua[8], ga[8], ub[8], gb2[8];
                unpack8(*(const GAS v4u*)(PROJ + (size_t)(t0 - 1) * NIN + OFF_U + c), ua); unpack8(*(const GAS v4u*)(PROJ + (size_t)(t0 - 1) * NIN + OFF_GC + c), ga);
                unpack8(*(const GAS v4u*)(PROJ + (size_t)(t0 - 2) * NIN + OFF_U + c), ub); unpack8(*(const GAS v4u*)(PROJ + (size_t)(t0 - 2) * NIN + OFF_GC + c), gb2);
#pragma unroll
                for (int j = 0; j < 8; ++j) { p1[j] = ua[j] * ga[j]; p2[j] = ub[j] * gb2[j]; }
            }
#pragma unroll 4
            for (int i = 0; i < 32; ++i) {
                const size_t rowo = (size_t)(t0 + i) * NIN + c;
                float uu[8], gc[8], gbv[8], y[8];
                unpack8(*(const GAS v4u*)(PROJ + rowo + OFF_U), uu); unpack8(*(const GAS v4u*)(PROJ + rowo + OFF_GC), gc); unpack8(*(const GAS v4u*)(PROJ + rowo + OFF_GB), gbv);
#pragma unroll
                for (int j = 0; j < 8; ++j) { const float p0 = uu[j] * gc[j]; y[j] = gbv[j] * (w0[j] * p2[j] + w1[j] * p1[j] + w2[j] * p0); p2[j] = p1[j]; p1[j] = p0; }
                *(GAS v4u*)(YC + (size_t)(t0 + i) * CWID + c) = pack8f(y);
            }
        }
        if (BOTH(3)) GRID_BAR();
    }
    if (IN(4)) {
        unsigned char* const ws = KARG_WS(); float* const out = KARG_OUT(); bf16* const PROJ = (bf16*)(ws + WS_PROJ); bf16* const ATT = (bf16*)(ws + WS_ATTN); bf16* const Wa_t = (bf16*)(ws + WS_WA);
        pg8::Gemm g{ATT, Wa_t, M, DM, CWID}; pg8::StaticOrder S; S.init(M, DM, F.G, (int)blockIdx.x);
        pg8::EpiGateA E{out, DM, PROJ + OFF_GA, NIN};
        pg8::gemm_phase<pg8::EpiGateA, pg8::StaticOrder, true, true>(F.lds + RING_OFF, g, S, E);
        if (BOTH(4)) GRID_BAR();
    }
    if (IN(5)) {
        unsigned char* const ws = KARG_WS(); float* const out = KARG_OUT(); bf16* const PROJ = (bf16*)(ws + WS_PROJ); bf16* const YC = (bf16*)(ws + WS_YC); bf16* const Wc_t = (bf16*)(ws + WS_WC); bf16* const MERGED = (bf16*)(ws + WS_MERGED);
        pg8::Gemm g{YC, Wc_t, M, DM, CWID}; pg8::StaticOrder S; S.init(M, DM, F.G, (int)blockIdx.x);
        pg8::EpiGateC E{out, MERGED, DM, PROJ + OFF_GCV, NIN};
        pg8::gemm_phase<pg8::EpiGateC, pg8::StaticOrder, true, true>(F.lds + RING_OFF, g, S, E);
        if (BOTH(5)) GRID_BAR();
    }
    if (IN(6)) {
        unsigned char* const ws = KARG_WS(); float* const out = KARG_OUT(); bf16* const Wo_t = (bf16*)(ws + WS_WO); bf16* const MERGED = (bf16*)(ws + WS_MERGED);
        pg8::Gemm g{MERGED, Wo_t, M, DM, DM}; pg8::StaticOrder S; S.init(M, DM, F.G, (int)blockIdx.x);
        pg8::EpiResid E{KARG_F(0), out, DM, ALPHA};
        pg8::gemm_phase<pg8::EpiResid, pg8::StaticOrder, true, true>(F.lds + RING_OFF, g, S, E);
        if (BOTH(6)) GRID_BAR();
    }
    if (IN(7)) {
        const int lane = lane_id();
        unsigned char* const ws = KARG_WS(); float* const out = KARG_OUT(); bf16* const H1B = (bf16*)(ws + WS_H1B); bf16* const Wup_t = (bf16*)(ws + WS_WUP); bf16* const Wdn_t = (bf16*)(ws + WS_WDN);
        { const float* const g1 = KARG_F(11); const float* const b1 = KARG_F(12);
          for (int t = gw; t < M; t += NGW) ln_row<true>(out + (size_t)t * DM, g1, b1, H1B + (size_t)t * DM, lane, false); }
        const float* const w_up = KARG_F(13); const float* const w_dn = KARG_F(15);
        constexpr int I_UP = (DM / 64) * (NUP / 32), I_DN = (DFF / 64) * (DM / 32);
        for (int it = gw; it < I_UP + I_DN; it += NGW) {
            if (it < I_UP) transpose_item(w_up, DM, NUP, Wup_t, scr, it, lane);
            else transpose_item(w_dn, DFF, DM, Wdn_t, scr, it - I_UP, lane);
        }
        if (BOTH(7)) GRID_BAR();
    }
    if (IN(8)) {
        unsigned char* const ws = KARG_WS(); bf16* const H1B = (bf16*)(ws + WS_H1B); bf16* const Wup_t = (bf16*)(ws + WS_WUP); bf16* const ZB = (bf16*)(ws + WS_Z);
        pg8::Gemm g{H1B, Wup_t, M, NUP, DM}; pg8::StaticOrder S; S.init(M, NUP, F.G, (int)blockIdx.x);
        pg8::EpiPlain E{ZB, NUP};
        pg8::gemm_phase<pg8::EpiPlain, pg8::StaticOrder, true, true>(F.lds + RING_OFF, g, S, E);
        if (BOTH(8)) GRID_BAR();
    }
    if (IN(9)) {
        const int lane = lane_id();
        unsigned char* const ws = KARG_WS(); bf16* const ZB = (bf16*)(ws + WS_Z); bf16* const GB = (bf16*)(ws + WS_G);
        constexpr int NCH = (DFF + 511) / 512; const float* const ffn_cw = KARG_F(14);
        for (int it = gw; it < (M / 32) * NCH; it += NGW) {
            const int run = it / NCH, c = (it % NCH) * 512 + lane * 8, t0 = run * 32;
            if (c < DFF) {
                float wg[3][8], wv[3][8], g1[8], g2[8], v1[8], v2[8];
#pragma unroll
                for (int k = 0; k < 3; ++k) { const GAS f32x4* pg = (const GAS f32x4*)(ffn_cw + (size_t)k * NUP + c); const GAS f32x4* pv = (const GAS f32x4*)(ffn_cw + (size_t)k * NUP + DFF + c);
                    const f32x4 a = pg[0], b = pg[1], cc = pv[0], dd = pv[1];
                    wg[k][0] = a.x; wg[k][1] = a.y; wg[k][2] = a.z; wg[k][3] = a.w; wg[k][4] = b.x; wg[k][5] = b.y; wg[k][6] = b.z; wg[k][7] = b.w;
                    wv[k][0] = cc.x; wv[k][1] = cc.y; wv[k][2] = cc.z; wv[k][3] = cc.w; wv[k][4] = dd.x; wv[k][5] = dd.y; wv[k][6] = dd.z; wv[k][7] = dd.w; }
                if ((t0 & (SEQ - 1)) == 0) {
#pragma unroll
                    for (int j = 0; j < 8; ++j) { g1[j] = 0.f; g2[j] = 0.f; v1[j] = 0.f; v2[j] = 0.f; }
                } else {
                    unpack8(*(const GAS v4u*)(ZB + (size_t)(t0 - 1) * NUP + c), g1); unpack8(*(const GAS v4u*)(ZB + (size_t)(t0 - 2) * NUP + c), g2);
                    unpack8(*(const GAS v4u*)(ZB + (size_t)(t0 - 1) * NUP + DFF + c), v1); unpack8(*(const GAS v4u*)(ZB + (size_t)(t0 - 2) * NUP + DFF + c), v2);
                }
#pragma unroll 4
                for (int i = 0; i < 32; ++i) {
                    const size_t rowo = (size_t)(t0 + i) * NUP + c;
                    float g0[8], v0[8], y[8];
                    unpack8(*(const GAS v4u*)(ZB + rowo), g0); unpack8(*(const GAS v4u*)(ZB + rowo + DFF), v0);
#pragma unroll
                    for (int j = 0; j < 8; ++j) { const float cg = wg[0][j] * g2[j] + wg[1][j] * g1[j] + wg[2][j] * g0[j]; const float cv = wv[0][j] * v2[j] + wv[1][j] * v1[j] + wv[2][j] * v0[j];
                        y[j] = cg * pg8::sigm(cg) * cv; g2[j] = g1[j]; g1[j] = g0[j]; v2[j] = v1[j]; v1[j] = v0[j]; }
                    *(GAS v4u*)(GB + (size_t)(t0 + i) * DFF + c) = pack8f(y);
                }
            }
        }
        if (BOTH(9)) GRID_BAR();
    }
    if (IN(10)) {
        unsigned char* const ws = KARG_WS(); float* const out = KARG_OUT(); bf16* const GB = (bf16*)(ws + WS_G); bf16* const Wdn_t = (bf16*)(ws + WS_WDN);
        pg8::Gemm g{GB, Wdn_t, M, DM, DFF}; pg8::StaticOrder S; S.init(M, DM, F.G, (int)blockIdx.x);
        pg8::EpiResid E{out, out, DM, ALPHA};
        pg8::gemm_phase<pg8::EpiResid, pg8::StaticOrder, true, true>(F.lds + RING_OFF, g, S, E);
        if (BOTH(10)) GRID_BAR();
    }
    if (IN(11)) {
        const int lane = lane_id();
        float* const out = KARG_OUT();
        const bool poison = (!MK_PER_PHASE) && (__hip_atomic_load((gu32*)((unsigned*)(F.ctl + CW_BAR) + XB_TMO), RLX_AGENT) != 0u);
        const float* const g2 = KARG_F(16); const float* const b2 = KARG_F(17);
        for (int t = gw; t < M; t += NGW) ln_row<false>(out + (size_t)t * DM, g2, b2, nullptr, lane, poison);
    }
#undef IN
#undef BOTH
}

extern "C" void kernel_launch(void* const* d_in, const int* in_sizes, int n_in, void* d_out, int out_size, void* d_ws, size_t ws_size, hipStream_t stream) {
    static int grid = 0;
    if (grid == 0) {
        if (n_in != 18 || in_sizes[0] != M * DM || out_size != M * DM || ws_size < WS_END) { fprintf(stderr, "kernel_launch: unexpected shapes (n_in %d, in0 %d, out %d, ws %zu < %zu)\n", n_in, n_in > 0 ? in_sizes[0] : -1, out_size, ws_size, (size_t)WS_END); grid = -1; return; }
        int dev = 0, cus = 0, per_cu = 0;
        if (hipGetDevice(&dev) != hipSuccess || hipDeviceGetAttribute(&cus, hipDeviceAttributeMultiprocessorCount, dev) != hipSuccess) { grid = -1; return; }
        if (hipFuncSetAttribute((const void*)fwd, hipFuncAttributeMaxDynamicSharedMemorySize, LDS_BYTES) != hipSuccess) { fprintf(stderr, "kernel_launch: hipFuncSetAttribute failed\n"); grid = -1; return; }
        if (hipOccupancyMaxActiveBlocksPerMultiprocessor(&per_cu, (const void*)fwd, NWAVES * 64, LDS_BYTES) != hipSuccess || per_cu < 1) { fprintf(stderr, "kernel_launch: occupancy query reports %d\n", per_cu); }
        (void)hipGetLastError();
        grid = cus;
    }
    if (grid < 0) return;
    if (hipMemsetAsync((char*)d_ws + WS_CTL, 0, CTL_ZERO_BYTES, stream) != hipSuccess) return;
    Args a{};
    for (int i = 0; i < 18; ++i) a.in[i] = (const float*)d_in[i];
    a.out = (float*)d_out; a.ws = (unsigned char*)d_ws;
#if MK_PER_PHASE
    for (int p = 0; p < NPH; ++p) { a.ph_lo = p; a.ph_hi = p + 1; a.li = p; hipLaunchKernelGGL(fwd, dim3(grid), dim3(NWAVES * 64), LDS_BYTES, stream, a); }
#else
    a.ph_lo = 0; a.ph_hi = NPH; a.li = 0;
    hipLaunchKernelGGL(fwd, dim3(grid), dim3(NWAVES * 64), LDS_BYTES, stream, a);
#endif
}
```

```cpp
#include <hip/hip_runtime.h>
#include <hip/hip_bf16.h>
#include <cstdio>
#include <cstdint>
namespace pg8 {
#define PG8_LAS __attribute__((address_space(3)))
typedef unsigned short bf16_t;
typedef short bf16x8 __attribute__((ext_vector_type(8)));
typedef float f32x4 __attribute__((ext_vector_type(4)));
typedef unsigned u32x4 __attribute__((ext_vector_type(4)));
constexpr int BM = 256, BK = 64, HALF = 128, HTB = HALF * BK * 2  , STAGE_BYTES = 8 * HTB, NXCD = 8, WGM = 8;

__host__ __device__ __forceinline__ int lds_byte(int r, int c) { const int st = (r >> 4) * 2 + (c >> 5), rr = r & 15, cc = c & 31, ob = rr * 64 + cc * 2; return st * 1024 + (ob ^ (((ob >> 9) & 1) << 5)); }
__host__ __device__ __forceinline__ void stage_rc(int b, int& R, int& C) { const int st = b / 1024, sb = b % 1024, swz = sb ^ (((sb >> 9) & 1) << 5); R = (st >> 1) * 16 + swz / 64; C = (st & 1) * 32 + (swz % 64) / 2; }
__host__ __device__ __forceinline__ int perm32(int rho) { const int n = rho >> 4, i = rho & 15; return 8 * (i >> 2) + 4 * n + (i & 3); }

struct Unit { int pm, pn; };
struct Gemm { const bf16_t* A; const bf16_t* Bt; int M, N, K; };

struct StaticOrder {
    int nM, nN, nwg, G, c;
    __host__ __device__ void init(int M, int N, int G_, int c_) { nM = M / BM; nN = N / BM; nwg = nM * nN; G = G_; c = c_; }
    __host__ __device__ bool next(int i, Unit& u) const {
        const long L = (long)i * G + c; if (L >= nwg) return false;
        int wgid = (int)L; { const int q = nwg / NXCD, r = nwg % NXCD, xcd = wgid % NXCD, off = wgid / NXCD; wgid = (xcd < r ? xcd * (q + 1) : r * (q + 1) + (xcd - r) * q) + off; }
        const int nig = WGM * nN, gid = wgid / nig, fm = gid * WGM, gsz = (nM - fm) < WGM ? (nM - fm) : WGM;
        u.pm = fm + ((wgid % nig) % gsz); u.pn = (wgid % nig) / gsz; return true;
    }
    __device__ __forceinline__ void a_ready(const Unit&) const {}
    __device__ __forceinline__ void done(const Unit&) const {}
};

__device__ __forceinline__ unsigned cvt_pk_bf16(float lo, float hi) { unsigned r; asm volatile("v_cvt_pk_bf16_f32 %0, %1, %2" : "=v"(r) : "v"(lo), "v"(hi)); return r; }
typedef float f32x2 __attribute__((ext_vector_type(2)));
typedef unsigned u32x2 __attribute__((ext_vector_type(2)));
__device__ __forceinline__ float sigm(float v) { return __builtin_amdgcn_rcpf(1.0f + __builtin_amdgcn_exp2f(-1.4426950408889634f * v)); }
__device__ __forceinline__ float bflo(unsigned w) { return __uint_as_float(w << 16); }
__device__ __forceinline__ float bfhi(unsigned w) { return __uint_as_float(w & 0xffff0000u); }
struct EpiProj {
    static constexpr bool PERM = true, AFTER_DRAIN = false;
    bf16_t* O; int ldc; int sig_from; int gc_at;
    __device__ __forceinline__ void operator()(const f32x4 (&acc)[2][2][4][2], const Unit& u, int wr, int wc, int fr, int fq) const {
        const int row0 = u.pm * BM + wr * 64 + fr, col0 = u.pn * BM + wc * 32 + 8 * fq; const bool sg = (u.pn * BM) >= sig_from;
        if (sg) {
            const int ch = ((u.pn * BM - sig_from) >> 1) + wc * 32 + 8 * fq;
#pragma unroll
            for (int ai = 0; ai < 2; ++ai)
#pragma unroll
                for (int m = 0; m < 4; ++m) { bf16_t* rowp = O + (size_t)(row0 + ai * HALF + m * 16) * ldc + ch; float r[8], s[8];
#pragma unroll
                    for (int n = 0; n < 2; ++n)
#pragma unroll
                        for (int i = 0; i < 4; ++i) { const float ea = __builtin_amdgcn_exp2f(-1.4426950408889634f * acc[ai][0][m][n][i]), ec1 = 1.0f + __builtin_amdgcn_exp2f(-1.4426950408889634f * acc[ai][1][m][n][i]);
                            s[4 * n + i] = __builtin_amdgcn_rcpf(ec1); r[4 * n + i] = ec1 * __builtin_amdgcn_rcpf(1.0f + ea); }
                    u32x4 w; w.x = cvt_pk_bf16(r[0], r[1]); w.y = cvt_pk_bf16(r[2], r[3]); w.z = cvt_pk_bf16(r[4], r[5]); w.w = cvt_pk_bf16(r[6], r[7]);
                    *(u32x4*)(rowp + sig_from) = w;
                    w.x = cvt_pk_bf16(s[0], s[1]); w.y = cvt_pk_bf16(s[2], s[3]); w.z = cvt_pk_bf16(s[4], s[5]); w.w = cvt_pk_bf16(s[6], s[7]);
                    *(u32x4*)(rowp + gc_at) = w; }
            return; }
#pragma unroll
        for (int ai = 0; ai < 2; ++ai)
#pragma unroll
            for (int m = 0; m < 4; ++m) { bf16_t* rowp = O + (size_t)(row0 + ai * HALF + m * 16) * ldc + col0;
#pragma unroll
                for (int bj = 0; bj < 2; ++bj) { const f32x4 v0 = acc[ai][bj][m][0], v1 = acc[ai][bj][m][1];
                    u32x4 w; w.x = cvt_pk_bf16(v0[0], v0[1]); w.y = cvt_pk_bf16(v0[2], v0[3]); w.z = cvt_pk_bf16(v1[0], v1[1]); w.w = cvt_pk_bf16(v1[2], v1[3]);
                    *(u32x4*)(rowp + bj * HALF) = w; } }
    }
};
struct EpiPlain {
    static constexpr bool PERM = true, AFTER_DRAIN = false;
    bf16_t* O; int ldc;
    __device__ __forceinline__ void operator()(const f32x4 (&acc)[2][2][4][2], const Unit& u, int wr, int wc, int fr, int fq) const {
        const int row0 = u.pm * BM + wr * 64 + fr, col0 = u.pn * BM + wc * 32 + 8 * fq;
#pragma unroll
        for (int ai = 0; ai < 2; ++ai)
#pragma unroll
            for (int m = 0; m < 4; ++m) { bf16_t* rowp = O + (size_t)(row0 + ai * HALF + m * 16) * ldc + col0;
#pragma unroll
                for (int bj = 0; bj < 2; ++bj) { const f32x4 v0 = acc[ai][bj][m][0], v1 = acc[ai][bj][m][1];
                    u32x4 w; w.x = cvt_pk_bf16(v0[0], v0[1]); w.y = cvt_pk_bf16(v0[2], v0[3]); w.z = cvt_pk_bf16(v1[0], v1[1]); w.w = cvt_pk_bf16(v1[2], v1[3]);
                    *(u32x4*)(rowp + bj * HALF) = w; } }
    }
};
struct EpiGateA {
    static constexpr bool PERM = false, AFTER_DRAIN = false;
    float* P; int ldc; const bf16_t* gate; int ldg;
    __device__ __forceinline__ void operator()(const f32x4 (&acc)[2][2][4][2], const Unit& u, int wr, int wc, int fr, int fq) const {
        const int row0 = u.pm * BM + wr * 64 + fr, col0 = u.pn * BM + wc * 32 + 4 * fq;
#pragma unroll
        for (int ai = 0; ai < 2; ++ai)
#pragma unroll
            for (int m = 0; m < 4; ++m) { const size_t row = (size_t)(row0 + ai * HALF + m * 16);
#pragma unroll
                for (int bj = 0; bj < 2; ++bj)
#pragma unroll
                    for (int n = 0; n < 2; ++n) { const int col = col0 + bj * HALF + n * 16;
                        const u32x2 gw = *(const u32x2*)(gate + row * ldg + col); const f32x4 a = acc[ai][bj][m][n];
                        *(f32x4*)(P + row * ldc + col) = (f32x4){a[0] * bflo(gw.x), a[1] * bfhi(gw.x), a[2] * bflo(gw.y), a[3] * bfhi(gw.y)}; }
                if (m & 1) asm volatile("" ::: "memory"); }
    }
};
struct EpiGateC {
    static constexpr bool PERM = true, AFTER_DRAIN = false;
    const float* P; bf16_t* O; int ldc; const bf16_t* gate; int ldg;
    __device__ __forceinline__ void operator()(const f32x4 (&acc)[2][2][4][2], const Unit& u, int wr, int wc, int fr, int fq) const {
        const int row0 = u.pm * BM + wr * 64 + fr, col0 = u.pn * BM + wc * 32 + 8 * fq;
#pragma unroll
        for (int ai = 0; ai < 2; ++ai)
#pragma unroll
            for (int m = 0; m < 4; ++m) { const size_t row = (size_t)(row0 + ai * HALF + m * 16);
#pragma unroll
                for (int bj = 0; bj < 2; ++bj) { const int col = col0 + bj * HALF;
                    const u32x4 gw = *(const u32x4*)(gate + row * ldg + col); const f32x4 p0 = *(const f32x4*)(P + row * ldc + col), p1 = *(const f32x4*)(P + row * ldc + col + 4);
                    const f32x4 a0 = acc[ai][bj][m][0], a1 = acc[ai][bj][m][1];
                    const float r0 = p0[0] + a0[0] * bflo(gw.x), r1 = p0[1] + a0[1] * bfhi(gw.x), r2 = p0[2] + a0[2] * bflo(gw.y), r3 = p0[3] + a0[3] * bfhi(gw.y);
                    const float r4 = p1[0] + a1[0] * bflo(gw.z), r5 = p1[1] + a1[1] * bfhi(gw.z), r6 = p1[2] + a1[2] * bflo(gw.w), r7 = p1[3] + a1[3] * bfhi(gw.w);
                    u32x4 w; w.x = cvt_pk_bf16(r0, r1); w.y = cvt_pk_bf16(r2, r3); w.z = cvt_pk_bf16(r4, r5); w.w = cvt_pk_bf16(r6, r7);
                    *(u32x4*)(O + row * ldc + col) = w; }
                if (m & 1) asm volatile("" ::: "memory"); }
    }
};
struct EpiResid {
    static constexpr bool PERM = false, AFTER_DRAIN = false;
    const float* base; float* out; int ldc; float alpha;
    __device__ __forceinline__ void operator()(const f32x4 (&acc)[2][2][4][2], const Unit& u, int wr, int wc, int fr, int fq) const {
        const int row0 = u.pm * BM + wr * 64 + fr, col0 = u.pn * BM + wc * 32 + 4 * fq;
#pragma unroll
        for (int ai = 0; ai < 2; ++ai)
#pragma unroll
            for (int m = 0; m < 4; ++m) { const size_t off = (size_t)(row0 + ai * HALF + m * 16) * ldc + col0;
#pragma unroll
                for (int bj = 0; bj < 2; ++bj)
#pragma unroll
                    for (int n = 0; n < 2; ++n) { const f32x4 b = *(const f32x4*)(base + off + bj * HALF + n * 16);
                        *(f32x4*)(out + off + bj * HALF + n * 16) = b * alpha + acc[ai][bj][m][n]; }
                if (m & 1) asm volatile("" ::: "memory"); }
    }
};

struct EpiGateMerge {
    static constexpr bool PERM = true, AFTER_DRAIN = false;
    bf16_t* O; int ldc; const bf16_t* ga; const bf16_t* gc; int ldg;
    __device__ __forceinline__ void mid(f32x4 (&acc)[2][2][4][2], const Unit& u, int wr, int wc, int fr, int fq) const {
        int row0 = u.pm * BM + wr * 64 + fr, col0 = u.pn * BM + wc * 32 + 8 * fq;
        asm volatile("" : "+v"(row0), "+v"(col0));
#pragma unroll
        for (int ai = 0; ai < 2; ++ai) { u32x4 av[4][2];
#pragma unroll
            for (int m = 0; m < 4; ++m)
#pragma unroll
                for (int bj = 0; bj < 2; ++bj) av[m][bj] = *(const u32x4*)(ga + (size_t)(row0 + ai * HALF + m * 16) * ldg + col0 + bj * HALF);
            asm volatile("" ::: "memory");
#pragma unroll
            for (int m = 0; m < 4; ++m)
#pragma unroll
                for (int bj = 0; bj < 2; ++bj) { const u32x4 a = av[m][bj]; f32x4& v0 = acc[ai][bj][m][0]; f32x4& v1 = acc[ai][bj][m][1];
                    v0[0] *= bflo(a.x); v0[1] *= bfhi(a.x); v0[2] *= bflo(a.y); v0[3] *= bfhi(a.y); v1[0] *= bflo(a.z); v1[1] *= bfhi(a.z); v1[2] *= bflo(a.w); v1[3] *= bfhi(a.w); }
            asm volatile("" ::: "memory"); }
    }
    __device__ __forceinline__ void operator()(const f32x4 (&acc)[2][2][4][2], const Unit& u, int wr, int wc, int fr, int fq) const {
        const int row0 = u.pm * BM + wr * 64 + fr, col0 = u.pn * BM + wc * 32 + 8 * fq;
        u32x4 cv[2][4][2];
#pragma unroll
        for (int ai = 0; ai < 2; ++ai)
#pragma unroll
            for (int m = 0; m < 4; ++m)
#pragma unroll
                for (int bj = 0; bj < 2; ++bj) cv[ai][m][bj] = *(const u32x4*)(gc + (size_t)(row0 + ai * HALF + m * 16) * ldg + col0 + bj * HALF);
        asm volatile("" ::: "memory");
#pragma unroll
        for (int ai = 0; ai < 2; ++ai)
#pragma unroll
            for (int m = 0; m < 4; ++m)
#pragma unroll
                for (int bj = 0; bj < 2; ++bj) { const u32x4 c = cv[ai][m][bj]; const f32x4 a0 = acc[ai][bj][m][0], a1 = acc[ai][bj][m][1];
                    u32x4 w; w.x = cvt_pk_bf16(a0[0] * bflo(c.x), a0[1] * bfhi(c.x)); w.y = cvt_pk_bf16(a0[2] * bflo(c.y), a0[3] * bfhi(c.y));
                    w.z = cvt_pk_bf16(a1[0] * bflo(c.z), a1[1] * bfhi(c.z)); w.w = cvt_pk_bf16(a1[2] * bflo(c.w), a1[3] * bfhi(c.w));
                    *(u32x4*)(O + (size_t)(row0 + ai * HALF + m * 16) * ldc + col0 + bj * HALF) = w; }
    }
};

typedef _Float16 h16x2 __attribute__((ext_vector_type(2)));
__device__ __forceinline__ unsigned pk_h2(float lo, float hi) { const h16x2 v = {(_Float16)lo, (_Float16)hi}; return __builtin_bit_cast(unsigned, v); }
__device__ __forceinline__ float h_lo(unsigned w) { return (float)__builtin_bit_cast(h16x2, w)[0]; }
__device__ __forceinline__ float h_hi(unsigned w) { return (float)__builtin_bit_cast(h16x2, w)[1]; }
template <bool BH> struct EpiResidH {
    static constexpr bool PERM = true, AFTER_DRAIN = false;
    const void* base; bf16_t* O;
    static constexpr int ldc = 4096; static constexpr float alpha = 1.189207115002721f;
    __device__ __forceinline__ void operator()(const f32x4 (&acc)[2][2][4][2], const Unit& u, int wr, int wc, int fr, int fq) const {
        const int row0 = u.pm * BM + wr * 64 + fr, col0 = u.pn * BM + wc * 32 + 8 * fq;
#pragma unroll
        for (int ai = 0; ai < 2; ++ai) {
            u32x4 hw[4][2]; f32x4 fw[4][2][2];
#pragma unroll
            for (int m = 0; m < 4; ++m)
#pragma unroll
                for (int bj = 0; bj < 2; ++bj) { const size_t off = (size_t)(row0 + ai * HALF + m * 16) * ldc + col0 + bj * HALF;
                    if constexpr (BH) hw[m][bj] = *(const u32x4*)((const bf16_t*)base + off);
                    else { fw[m][bj][0] = *(const f32x4*)((const float*)base + off); fw[m][bj][1] = *(const f32x4*)((const float*)base + off + 4); } }
            asm volatile("" ::: "memory");
#pragma unroll
            for (int m = 0; m < 4; ++m)
#pragma unroll
                for (int bj = 0; bj < 2; ++bj) { const size_t off = (size_t)(row0 + ai * HALF + m * 16) * ldc + col0 + bj * HALF; f32x4 b0, b1;
                    if constexpr (BH) { const u32x4 h = hw[m][bj]; b0 = (f32x4){h_lo(h.x), h_hi(h.x), h_lo(h.y), h_hi(h.y)}; b1 = (f32x4){h_lo(h.z), h_hi(h.z), h_lo(h.w), h_hi(h.w)}; }
                    else { b0 = fw[m][bj][0]; b1 = fw[m][bj][1]; }
                    const f32x4 v0 = b0 * alpha + acc[ai][bj][m][0], v1 = b1 * alpha + acc[ai][bj][m][1];
                    u32x4 w; w.x = pk_h2(v0[0], v0[1]); w.y = pk_h2(v0[2], v0[3]); w.z = pk_h2(v1[0], v1[1]); w.w = pk_h2(v1[2], v1[3]);
                    *(u32x4*)(O + off) = w; }
            asm volatile("" ::: "memory"); }
    }
};

template <int CTRL> __device__ __forceinline__ float dppf(float old, float src) { return __int_as_float(__builtin_amdgcn_update_dpp(__float_as_int(old), __float_as_int(src), CTRL, 0xf, 0xf, false)); }
#define PG8_CONV2(c0, c1, x0, x1, p0, p1, wc0, wc1, wb0, wb1, wbz0, wbz1, wa0, wa1, waz0, waz1) \
    asm volatile("v_mul_f32 %0, %6, %2\n\tv_mul_f32 %1, %7, %3\n\t" \
                 "v_fmac_f32_dpp %0, %2, %8 row_shr:1 row_mask:0xf bank_mask:0xf\n\tv_fmac_f32_dpp %1, %3, %9 row_shr:1 row_mask:0xf bank_mask:0xf\n\t" \
                 "v_fmac_f32_dpp %0, %4, %10 row_ror:1 row_mask:0xf bank_mask:0xf\n\tv_fmac_f32_dpp %1, %5, %11 row_ror:1 row_mask:0xf bank_mask:0xf\n\t" \
                 "v_fmac_f32_dpp %0, %2, %12 row_shr:2 row_mask:0xf bank_mask:0xf\n\tv_fmac_f32_dpp %1, %3, %13 row_shr:2 row_mask:0xf bank_mask:0xf\n\t" \
                 "v_fmac_f32_dpp %0, %4, %14 row_ror:2 row_mask:0xf bank_mask:0xf\n\tv_fmac_f32_dpp %1, %5, %15 row_ror:2 row_mask:0xf bank_mask:0xf" \
                 : "=&v"(c0), "=&v"(c1) : "v"(x0), "v"(x1), "v"(p0), "v"(p1), "v"(wc0), "v"(wc1), "v"(wb0), "v"(wb1), "v"(wbz0), "v"(wbz1), "v"(wa0), "v"(wa1), "v"(waz0), "v"(waz1))
struct EpiConvSilu {
    static constexpr bool PERM = true, AFTER_DRAIN = false;
    bf16_t* G; int ldg; const float* cw; int nup, dff; float* halo; int nN; PG8_LAS float* H;
    __device__ __forceinline__ void operator()(const f32x4 (&acc)[2][2][4][2], const Unit& u, int wr, int wc, int fr, int fq) const {
        const int lc = wc * 32 + 8 * fq, ch = u.pn * 128 + lc;
#pragma unroll
        for (int ai = 0; ai < 2; ++ai) { const int blk = 2 * ai + wr;
            if (fr >= 14) {
#pragma unroll
                for (int bj = 0; bj < 2; ++bj)
#pragma unroll
                    for (int n = 0; n < 2; ++n) *(PG8_LAS f32x4*)(H + (blk * 2 + (fr - 14)) * 256 + bj * 128 + lc + 4 * n) = acc[ai][bj][3][n]; } }
        float* hg = halo + ((size_t)u.pm * nN + u.pn) * 1024;
        if (wr == 0 && fr < 2) {
#pragma unroll
            for (int bj = 0; bj < 2; ++bj)
#pragma unroll
                for (int n = 0; n < 2; ++n) *(f32x4*)(hg + fr * 256 + bj * 128 + lc + 4 * n) = acc[0][bj][0][n]; }
        if (wr == 1 && fr >= 14) {
#pragma unroll
            for (int bj = 0; bj < 2; ++bj)
#pragma unroll
                for (int n = 0; n < 2; ++n) *(f32x4*)(hg + (2 + fr - 14) * 256 + bj * 128 + lc + 4 * n) = acc[1][bj][3][n]; }
        asm volatile("s_waitcnt lgkmcnt(0)" ::: "memory"); __builtin_amdgcn_s_barrier(); asm volatile("" ::: "memory");
        f32x4 sg[2][4][2];
#pragma unroll
        for (int bj = 0; bj < 2; ++bj) {
            f32x4 wgt[3][2], wbz[2], waz[2];
#pragma unroll
            for (int k = 0; k < 3; ++k)
#pragma unroll
                for (int n = 0; n < 2; ++n) wgt[k][n] = *(const f32x4*)(cw + (size_t)k * nup + bj * dff + ch + 4 * n);
#pragma unroll
            for (int n = 0; n < 2; ++n)
#pragma unroll
                for (int i = 0; i < 4; ++i) { wbz[n][i] = fr == 0 ? wgt[1][n][i] : 0.f; waz[n][i] = fr < 2 ? wgt[0][n][i] : 0.f; }
#pragma unroll
            for (int ai = 0; ai < 2; ++ai) { const int blk = 2 * ai + wr;
                f32x4 pv[2];
#pragma unroll
                for (int n = 0; n < 2; ++n) { pv[n] = (f32x4){0.f, 0.f, 0.f, 0.f};
                    if (blk >= 1 && fr >= 14) pv[n] = *(const PG8_LAS f32x4*)(H + ((blk - 1) * 2 + (fr - 14)) * 256 + bj * 128 + lc + 4 * n); }
#pragma unroll
                for (int mm = 0; mm < 4; ++mm) { const int m = 3 - mm; f32x4 c[2];
#pragma unroll
                    for (int n = 0; n < 2; ++n) { const f32x4 cur = acc[ai][bj][m][n]; const f32x4 prv = (m == 0) ? pv[n] : acc[ai][bj][m == 0 ? 0 : m - 1][n];
#pragma unroll
                        for (int i = 0; i < 4; i += 2) { float c0, c1;
                            PG8_CONV2(c0, c1, cur[i], cur[i + 1], prv[i], prv[i + 1], wgt[2][n][i], wgt[2][n][i + 1], wgt[1][n][i], wgt[1][n][i + 1], wbz[n][i], wbz[n][i + 1],
                                      wgt[0][n][i], wgt[0][n][i + 1], waz[n][i], waz[n][i + 1]);
                            c[n][i] = c0; c[n][i + 1] = c1; } }
                    if (bj == 0) {
#pragma unroll
                        for (int n = 0; n < 2; ++n)
#pragma unroll
                            for (int i = 0; i < 4; ++i) sg[ai][m][n][i] = c[n][i] * sigm(c[n][i]);
                    } else {
                        float y[8];
#pragma unroll
                        for (int n = 0; n < 2; ++n)
#pragma unroll
                            for (int i = 0; i < 4; ++i) y[4 * n + i] = sg[ai][m][n][i] * c[n][i];
                        u32x4 w; w.x = cvt_pk_bf16(y[0], y[1]); w.y = cvt_pk_bf16(y[2], y[3]); w.z = cvt_pk_bf16(y[4], y[5]); w.w = cvt_pk_bf16(y[6], y[7]);
                        *(u32x4*)(G + (size_t)(u.pm * BM + ai * HALF + wr * 64 + m * 16 + fr) * ldg + ch) = w; } } } }
    }
};
typedef _Float16 f16x8 __attribute__((ext_vector_type(8)));
template <bool F16> __device__ __forceinline__ f32x4 mma16(bf16x8 a, bf16x8 b, f32x4 c) {
    if constexpr (F16) return __builtin_amdgcn_mfma_f32_16x16x32_f16(__builtin_bit_cast(f16x8, a), __builtin_bit_cast(f16x8, b), c, 0, 0, 0);
    else return __builtin_amdgcn_mfma_f32_16x16x32_bf16(a, b, c, 0, 0, 0); }
template <class Epi, class Sched, bool ALIGN_EPI = false, bool SP2 = false, bool MID = false, bool F16 = false>
__device__ __forceinline__ void gemm_phase(PG8_LAS unsigned char* lds, const Gemm g, const Sched& S, const Epi& E) {
    int tid_ = threadIdx.x; asm volatile("" : "+v"(tid_));
    const int tid = tid_, wid = __builtin_amdgcn_readfirstlane(tid >> 6), lane = tid & 63, wr = wid >> 2, wc = wid & 3, fr = lane & 15, fq = lane >> 4;
    const int K = g.K, nt = K / BK;
    unsigned voffA[2], voffB[2];
#pragma unroll
    for (int i = 0; i < 2; ++i) { int R, C; stage_rc(tid * 16 + i * 8192, R, C); const int Rb = Epi::PERM ? ((R & ~31) + perm32(R & 31)) : R;
        voffA[i] = (unsigned)(R * K + C) * 2u; voffB[i] = (unsigned)(Rb * K + C) * 2u; }
    const size_t kstep = (size_t)(BK * 2);
    const size_t hstep = (size_t)HALF * K * 2;
    const size_t tstep = 2 * hstep;
    const unsigned ldsw = (unsigned)wid * 1024u;
    const int aoff = lds_byte(wr * 64 + fr, fq * 8), boff = lds_byte(wc * 32 + fr, fq * 8);
#define PG8_SA(b, h) (((b) * 2 + (h)) * HTB)
#define PG8_SB(b, h) ((4 + (b) * 2 + (h)) * HTB)
#define PG8_STAGE(bufoff, gbase, voff) do { _Pragma("unroll") for (int _i = 0; _i < 2; ++_i) \
        __builtin_amdgcn_global_load_lds((const unsigned*)((const char*)(gbase) + (voff)[_i]), (PG8_LAS unsigned*)(lds + (bufoff) + ldsw + _i * 8192), 16, 0, 0); } while (0)
#define PG8_LDA(dst, b, h) do { _Pragma("unroll") for (int m = 0; m < 4; ++m) _Pragma("unroll") for (int k = 0; k < 2; ++k) dst[m][k] = *(const PG8_LAS bf16x8*)(lds + PG8_SA(b, h) + aoff + m * 2048 + k * 1024); } while (0)
#define PG8_LDB(dst, b, h) do { _Pragma("unroll") for (int n = 0; n < 2; ++n) _Pragma("unroll") for (int k = 0; k < 2; ++k) dst[n][k] = *(const PG8_LAS bf16x8*)(lds + PG8_SB(b, h) + boff + n * 2048 + k * 1024); } while (0)
#define PG8_MMA(ai, bj, At, Bt) do { __builtin_amdgcn_s_setprio(1); _Pragma("unroll") for (int m = 0; m < 4; ++m) _Pragma("unroll") for (int n = 0; n < 2; ++n) _Pragma("unroll") for (int k = 0; k < 2; ++k) \
        acc[ai][bj][m][n] = mma16<F16>(Bt[n][k], At[m][k], acc[ai][bj][m][n]); __builtin_amdgcn_s_setprio(0); } while (0)
#define PG8_WAIT_V(n) asm volatile("s_waitcnt vmcnt(" #n ")" ::: "memory")
#define PG8_WAIT_L(n) asm volatile("s_waitcnt lgkmcnt(" #n ")" ::: "memory")
#define PG8_BAR __builtin_amdgcn_s_barrier()
#define PG8_SCHED __builtin_amdgcn_sched_barrier(0)
    Unit cur, nxt; int ui = 0;
    if (!S.next(0, cur)) return;
    f32x4 acc[2][2][4][2];
#pragma unroll
    for (int a = 0; a < 2; ++a)
#pragma unroll
        for (int b = 0; b < 2; ++b)
#pragma unroll
            for (int m = 0; m < 4; ++m)
#pragma unroll
                for (int n = 0; n < 2; ++n) acc[a][b][m][n] = (f32x4){0.f, 0.f, 0.f, 0.f};
    bf16x8 At[4][2], B0[2][2], B1[2][2];
    const char* cA = (const char*)g.A + (size_t)cur.pm * tstep; const char* cB = (const char*)g.Bt + (size_t)cur.pn * tstep;
    S.a_ready(cur);
    if constexpr (SP2) {
        PG8_STAGE(PG8_SB(0, 0), cB, voffB); PG8_STAGE(PG8_SB(0, 1), cB + hstep, voffB); PG8_STAGE(PG8_SA(0, 0), cA, voffA); PG8_STAGE(PG8_SA(0, 1), cA + hstep, voffA);
        if (wr == 1) PG8_BAR;
        PG8_WAIT_V(2); PG8_BAR;
        PG8_STAGE(PG8_SB(1, 0), cB + kstep, voffB); PG8_STAGE(PG8_SA(1, 0), cA + kstep, voffA); PG8_STAGE(PG8_SB(1, 1), cB + hstep + kstep, voffB);
        PG8_WAIT_V(6); PG8_BAR;
    } else {
        PG8_STAGE(PG8_SB(0, 0), cB, voffB); PG8_STAGE(PG8_SA(0, 0), cA, voffA); PG8_STAGE(PG8_SB(0, 1), cB + hstep, voffB); PG8_STAGE(PG8_SA(0, 1), cA + hstep, voffA);
        if (wr == 1) PG8_BAR;
        PG8_WAIT_V(4); PG8_BAR;
        PG8_STAGE(PG8_SB(1, 0), cB + kstep, voffB); PG8_STAGE(PG8_SA(1, 0), cA + kstep, voffA); PG8_STAGE(PG8_SB(1, 1), cB + hstep + kstep, voffB);
        PG8_WAIT_V(6); PG8_BAR;
    }
    for (;;) {
        const bool has_next = S.next(ui + 1, nxt);
        const char* nA = has_next ? (const char*)g.A + (size_t)nxt.pm * tstep : cA; const char* nB = has_next ? (const char*)g.Bt + (size_t)nxt.pn * tstep : cB;
        for (int t = 0; t < nt; t += 2) {
            if constexpr (MID) { if (t == (nt >> 1)) E.mid(acc, cur, wr, wc, fr, fq); }
            const bool last = (t == nt - 2);
            const char* a1 = cA + (size_t)(t + 1) * kstep;
            const char* a2 = last ? nA : cA + (size_t)(t + 2) * kstep; const char* b2 = last ? nB : cB + (size_t)(t + 2) * kstep;
            const char* a3 = a2 + kstep; const char* b3 = b2 + kstep;
            if (last && has_next) S.a_ready(nxt);
            if constexpr (SP2) {
            PG8_LDB(B0, 0, 0); PG8_LDB(B1, 0, 1); PG8_SCHED; PG8_LDA(At, 0, 0); PG8_STAGE(PG8_SA(1, 1), a1 + hstep, voffA);
            PG8_WAIT_V(8); PG8_WAIT_L(0); PG8_BAR; PG8_MMA(0, 0, At, B0); PG8_MMA(0, 1, At, B1); PG8_BAR; PG8_SCHED;
            PG8_LDA(At, 0, 1); PG8_STAGE(PG8_SB(0, 0), b2, voffB); PG8_STAGE(PG8_SB(0, 1), b2 + hstep, voffB); PG8_STAGE(PG8_SA(0, 0), a2, voffA);
            PG8_WAIT_V(8); PG8_WAIT_L(0); PG8_BAR; PG8_MMA(1, 0, At, B0); PG8_MMA(1, 1, At, B1); PG8_BAR; PG8_SCHED;
            PG8_LDB(B0, 1, 0); PG8_LDB(B1, 1, 1); PG8_SCHED; PG8_LDA(At, 1, 0); PG8_STAGE(PG8_SA(0, 1), a2 + hstep, voffA);
            PG8_WAIT_V(8); PG8_WAIT_L(0); PG8_BAR; PG8_MMA(0, 0, At, B0); PG8_MMA(0, 1, At, B1); PG8_BAR; PG8_SCHED;
            PG8_LDA(At, 1, 1); PG8_STAGE(PG8_SB(1, 0), b3, voffB); PG8_STAGE(PG8_SB(1, 1), b3 + hstep, voffB); PG8_STAGE(PG8_SA(1, 0), a3, voffA);
            PG8_WAIT_V(8); PG8_WAIT_L(0); PG8_BAR; PG8_MMA(1, 0, At, B0); PG8_MMA(1, 1, At, B1); PG8_BAR; PG8_SCHED;
            } else {
            PG8_LDB(B0, 0, 0); PG8_SCHED; PG8_LDA(At, 0, 0); PG8_STAGE(PG8_SA(1, 1), a1 + hstep, voffA);
            PG8_WAIT_L(8); PG8_BAR; PG8_WAIT_L(0); PG8_MMA(0, 0, At, B0); PG8_BAR; PG8_SCHED;
            PG8_LDB(B1, 0, 1); PG8_STAGE(PG8_SB(0, 0), b2, voffB);
            PG8_BAR; PG8_WAIT_L(0); PG8_MMA(0, 1, At, B1); PG8_BAR;
            PG8_LDA(At, 0, 1); PG8_STAGE(PG8_SA(0, 0), a2, voffA);
            PG8_BAR; PG8_WAIT_L(0); PG8_MMA(1, 0, At, B0); PG8_BAR; PG8_SCHED;
            PG8_STAGE(PG8_SB(0, 1), b2 + hstep, voffB);
            PG8_WAIT_V(6); PG8_BAR; PG8_MMA(1, 1, At, B1); PG8_BAR;
            PG8_LDB(B0, 1, 0); PG8_SCHED; PG8_LDA(At, 1, 0); PG8_STAGE(PG8_SA(0, 1), a2 + hstep, voffA);
            PG8_WAIT_L(8); PG8_BAR; PG8_WAIT_L(0); PG8_MMA(0, 0, At, B0); PG8_BAR; PG8_SCHED;
            PG8_LDB(B1, 1, 1); PG8_STAGE(PG8_SB(1, 0), b3, voffB);
            PG8_BAR; PG8_WAIT_L(0); PG8_MMA(0, 1, At, B1); PG8_BAR;
            PG8_LDA(At, 1, 1); PG8_STAGE(PG8_SA(1, 0), a3, voffA);
            PG8_BAR; PG8_WAIT_L(0); PG8_MMA(1, 0, At, B0); PG8_BAR; PG8_SCHED;
            PG8_STAGE(PG8_SB(1, 1), b3 + hstep, voffB);
            PG8_WAIT_V(6); PG8_BAR; PG8_MMA(1, 1, At, B1); PG8_BAR;
            }
        }
        if constexpr (ALIGN_EPI) { if (wr == 0) PG8_BAR; }
        if constexpr (!Epi::AFTER_DRAIN) { E(acc, cur, wr, wc, fr, fq); S.done(cur); }
        if (!has_next) break;
#pragma unroll
        for (int a = 0; a < 2; ++a)
#pragma unroll
            for (int b = 0; b < 2; ++b)
#pragma unroll
                for (int m = 0; m < 4; ++m)
#pragma unroll
                    for (int n = 0; n < 2; ++n) acc[a][b][m][n] = (f32x4){0.f, 0.f, 0.f, 0.f};
        cur = nxt; cA = nA; cB = nB; ++ui;
        if constexpr (ALIGN_EPI) { if (wr == 1) PG8_BAR; }
    }
    PG8_WAIT_V(0);
    if constexpr (!ALIGN_EPI) { if (wr == 0) PG8_BAR; }
    PG8_BAR;
    if constexpr (Epi::AFTER_DRAIN) { E.fused(acc, cur, wr, wc, fr, fq, lds, wid, lane); S.done(cur); }
#undef PG8_SA
#undef PG8_SB
#undef PG8_STAGE
#undef PG8_LDA
#undef PG8_LDB
#undef PG8_MMA
#undef PG8_WAIT_V
#undef PG8_WAIT_L
#undef PG8_BAR
#undef PG8_SCHED
}
}
namespace swa {
constexpr int D = 128;
constexpr int LDP = 20480;
constexpr int LDO = 2048;
constexpr float THR = 8.f;
constexpr bool WSKIP = false;
constexpr float SCALE = 0.08838834764831845f;
constexpr int NW = 8, QBLK = 32, KVBLK = 64, QB = NW * QBLK;
constexpr int SHM_V = KVBLK * D * 2, SHM_K = KVBLK * D * 2;
constexpr int LDS_BYTES = 2 * SHM_V + 2 * SHM_K + NW * 64 * 4;
static_assert(D == 128, "geometry");

using bf16 = __hip_bfloat16;
typedef short bf16x8 __attribute__((ext_vector_type(8)));
typedef short s16x4 __attribute__((ext_vector_type(4)));
typedef float f32x16 __attribute__((ext_vector_type(16)));
typedef float f32x4 __attribute__((ext_vector_type(4)));
typedef unsigned u32x4 __attribute__((ext_vector_type(4)));
template <class A, class Bt> struct same_t { static constexpr bool v = false; };
template <class A> struct same_t<A, A> { static constexpr bool v = true; };

#define KSWZ(row, colB) ((row) * 256 + ((colB) ^ (((row) & 7) << 4)))
#define SBAR() __builtin_amdgcn_sched_barrier(0)
__device__ __forceinline__ int v_st(int k, int c) { const int kk = (k & ~0xC) | ((k & 4) << 1) | ((k & 8) >> 1); return ((kk >> 3) * 4 + (c >> 5)) * 512 + ((kk & 7) * 32 + (c & 31)) * 2; }
__device__ __forceinline__ int v_rd_base(int lane) { return ((lane & 3) << 3) | (((lane >> 2) & 3) << 6) | (((lane >> 4) & 1) << 5) | (((lane >> 5) & 1) << 8); }
constexpr int v_rd_off(int d0, int ks, int half) { return d0 * 512 + ks * 4096 + half * 2048; }
__device__ __forceinline__ int crow(int r, int hi) { return (r & 3) + 8 * (r >> 2) + 4 * hi; }
__device__ __forceinline__ unsigned cvtpk(float lo, float hi) {
    unsigned r; asm volatile("v_cvt_pk_bf16_f32 %0, %1, %2" : "=v"(r) : "v"(lo), "v"(hi)); return r;
}
__device__ __forceinline__ bf16x8 pack8(f32x4 a, f32x4 b) {
    u32x4 w = {cvtpk(a[0], a[1]), cvtpk(a[2], a[3]), cvtpk(b[0], b[1]), cvtpk(b[2], b[3])};
    return *reinterpret_cast<bf16x8*>(&w);
}
template <class T> __device__ __forceinline__ bf16x8 load8(const T* p) {
    if constexpr (same_t<T, float>::v) { return pack8(*(const f32x4*)p, *(const f32x4*)(p + 4)); }
    else { return *reinterpret_cast<const bf16x8*>(p); }
}
__device__ __forceinline__ void mask_tile(f32x16& p0, f32x16& p1, int dq, unsigned W) {
    const float NEG = -__builtin_inff();
#pragma unroll
    for (int r = 0; r < 16; ++r) {
        const int c = (r & 3) + 8 * (r >> 2);
        if ((unsigned)(dq - c) >= W) p0[r] = NEG;
        if ((unsigned)(dq - c - 32) >= W) p1[r] = NEG;
    }
}
__device__ __forceinline__ void partialSM(f32x16& p0, f32x16& p1, float& m_reg, float& mn, float& alpha) {
    float pmax = p0[0]; for (int r = 1; r < 16; ++r) pmax = fmaxf(pmax, p0[r]); for (int r = 0; r < 16; ++r) pmax = fmaxf(pmax, p1[r]);
    { auto rr = __builtin_amdgcn_permlane32_swap(__float_as_uint(pmax), __float_as_uint(pmax), false, false);
      pmax = fmaxf(__uint_as_float(rr[0]), __uint_as_float(rr[1])); }
    constexpr float C2 = 1.4426950408889634f * SCALE;
    if (__builtin_expect(__all((pmax - m_reg) * SCALE <= THR), 1)) { mn = m_reg; alpha = 1.f; }
    else { mn = fmaxf(m_reg, pmax); alpha = __builtin_amdgcn_exp2f((m_reg - mn) * C2); m_reg = mn; }
    const float mnL = -mn * C2;
    for (int r = 0; r < 16; ++r) p0[r] = fmaf(p0[r], C2, mnL); for (int r = 0; r < 16; ++r) p1[r] = fmaf(p1[r], C2, mnL);
    for (int r = 0; r < 16; ++r) p0[r] = __builtin_amdgcn_exp2f(p0[r]);
}
__device__ __forceinline__ void finishSM(f32x16& p0, f32x16& p1, float alpha, float& l_reg, bf16x8& pa0, bf16x8& pa1, bf16x8& pa2, bf16x8& pa3) {
    for (int r = 0; r < 16; ++r) p1[r] = __builtin_amdgcn_exp2f(p1[r]);
    float ps = 0; for (int r = 0; r < 16; ++r) ps += p0[r]; for (int r = 0; r < 16; ++r) ps += p1[r];
    { auto rr = __builtin_amdgcn_permlane32_swap(__float_as_uint(ps), __float_as_uint(ps), false, false);
      ps = __uint_as_float(rr[0]) + __uint_as_float(rr[1]); }
    l_reg = l_reg * alpha + ps;
#define PK4(P, B_, OUT) do { unsigned a0 = cvtpk(P[B_+0], P[B_+1]), a1 = cvtpk(P[B_+2], P[B_+3]);                          \
        unsigned b0 = cvtpk(P[B_+4], P[B_+5]), b1 = cvtpk(P[B_+6], P[B_+7]);                                             \
        auto r0 = __builtin_amdgcn_permlane32_swap(a0, b0, false, false); auto r1 = __builtin_amdgcn_permlane32_swap(a1, b1, false, false); \
        u32x4 w = {r0[0], r1[0], r0[1], r1[1]}; OUT = *reinterpret_cast<bf16x8*>(&w); } while (0)
    PK4(p0, 0, pa0); PK4(p0, 8, pa1); PK4(p1, 0, pa2); PK4(p1, 8, pa3);
#undef PK4
}
template <int KB, bool SK>
__device__ __forceinline__ void qkt(f32x16& p0, f32x16& p1, const char* K_lds, int r32, int hi, const bf16x8* qr, bool act) {
    if (SK && !act) { const float NEG = -__builtin_inff();
#pragma unroll
        for (int r = 0; r < 16; ++r) { p0[r] = NEG; p1[r] = NEG; } return; }
    p0 = f32x16{}; p1 = f32x16{};
    const char* kb[4];
#pragma unroll
    for (int dd = 0; dd < 4; ++dd) kb[dd] = K_lds + KB * SHM_K + KSWZ(r32, (dd * 16 + hi * 8) * 2);
#pragma unroll
    for (int d0 = 0; d0 < 8; ++d0) { const char* a = kb[d0 & 3] + (d0 >> 2) * 128;
        bf16x8 b0 = *reinterpret_cast<const bf16x8*>(a);
        bf16x8 b1 = *reinterpret_cast<const bf16x8*>(a + 32 * 256);
        p0 = __builtin_amdgcn_mfma_f32_32x32x16_bf16(b0, qr[d0], p0, 0, 0, 0);
        p1 = __builtin_amdgcn_mfma_f32_32x32x16_bf16(b1, qr[d0], p1, 0, 0, 0); }
}
template <int VB, bool SK>
__device__ __forceinline__ void pv_tile(f32x16* o, int vb0, bf16x8 pa0, bf16x8 pa1, bf16x8 pa2, bf16x8 pa3, bool act) {
    if (SK && !act) return;
#define TRRD(dst, off) asm volatile("ds_read_b64_tr_b16 %0, %1 offset:%2" : "=&v"(dst) : "v"(vb0), "i"(off) : "memory")
#define PV_D0(d0) do { s16x4 l0, l1, l2, l3, h0, h1, h2, h3; constexpr int b_ = VB * SHM_V + v_rd_off(d0, 0, 0);     \
        TRRD(l0, b_); TRRD(h0, b_ + 2048); TRRD(l1, b_ + 4096); TRRD(h1, b_ + 6144); TRRD(l2, b_ + 8192); TRRD(h2, b_ + 10240); TRRD(l3, b_ + 12288); TRRD(h3, b_ + 14336); \
        asm volatile("s_waitcnt lgkmcnt(0)" ::: "memory"); SBAR();                 \
        o[d0] = __builtin_amdgcn_mfma_f32_32x32x16_bf16(pa0, (bf16x8){l0[0], l0[1], l0[2], l0[3], h0[0], h0[1], h0[2], h0[3]}, o[d0], 0, 0, 0);   \
        o[d0] = __builtin_amdgcn_mfma_f32_32x32x16_bf16(pa1, (bf16x8){l1[0], l1[1], l1[2], l1[3], h1[0], h1[1], h1[2], h1[3]}, o[d0], 0, 0, 0);   \
        o[d0] = __builtin_amdgcn_mfma_f32_32x32x16_bf16(pa2, (bf16x8){l2[0], l2[1], l2[2], l2[3], h2[0], h2[1], h2[2], h2[3]}, o[d0], 0, 0, 0);   \
        o[d0] = __builtin_amdgcn_mfma_f32_32x32x16_bf16(pa3, (bf16x8){l3[0], l3[1], l3[2], l3[3], h3[0], h3[1], h3[2], h3[3]}, o[d0], 0, 0, 0); } while (0)
    PV_D0(0); PV_D0(1); PV_D0(2); PV_D0(3);
#undef PV_D0
#undef TRRD
}

template <class TIn, class TOut> struct BlockRef { const TIn* Q; const TIn* K; const TIn* V; TOut* O; int P0; };
template <class TIn> struct Seam {
    bf16x8 qr[8];
    bf16x8 st_v0, st_v1, st_k0, st_k1; f32x4 sf0, sf1, sf2, sf3;
    f32x4 tq[16];
};
__device__ __forceinline__ int swa_jlo(int P0, int W) { const int lowk = P0 - W + 1; return lowk > 0 ? lowk / KVBLK : 0; }
#define ROW(p, k0, rr) ((p) + (size_t)((k0) + (rr)) * LDP + sc)
#define VMW() asm volatile("s_waitcnt vmcnt(0)" ::: "memory")
#define VMWN(n) asm volatile("s_waitcnt vmcnt(%0)" :: "i"(n) : "memory")
#define SLOAD_H(Kp, Vp, k0) do { S.st_v0 = load8<TIn>(ROW(Vp, k0, sr)); S.st_v1 = load8<TIn>(ROW(Vp, k0, 32 + sr));              \
                         S.st_k0 = load8<TIn>(ROW(Kp, k0, sr)); S.st_k1 = load8<TIn>(ROW(Kp, k0, 32 + sr)); } while (0)
#define SWRITE_HK(bf) do { *(bf16x8*)(K_lds + (bf) * SHM_K + kws) = S.st_k0; *(bf16x8*)(K_lds + (bf) * SHM_K + kws + 32 * 256) = S.st_k1; } while (0)
#define SWRITE_HV(bf) do { *(bf16x8*)(V_lds + (bf) * SHM_V + vst0) = S.st_v0; *(bf16x8*)(V_lds + (bf) * SHM_V + vst1) = S.st_v1; } while (0)
#define SWRITE_H(bf) do { SWRITE_HV(bf); SWRITE_HK(bf); } while (0)
#define SLOAD_F(p, k0) do { S.sf0 = *(const f32x4*)ROW(p, k0, sr); S.sf1 = *(const f32x4*)(ROW(p, k0, sr) + 4);                \
                            S.sf2 = *(const f32x4*)ROW(p, k0, 32 + sr); S.sf3 = *(const f32x4*)(ROW(p, k0, 32 + sr) + 4); } while (0)
#define SWRITE_KF(bf) do { *(bf16x8*)(K_lds + (bf) * SHM_K + kws) = pack8(S.sf0, S.sf1); *(bf16x8*)(K_lds + (bf) * SHM_K + kws + 32 * 256) = pack8(S.sf2, S.sf3); } while (0)
#define SWRITE_VF(bf) do { *(bf16x8*)(V_lds + (bf) * SHM_V + vst0) = pack8(S.sf0, S.sf1); *(bf16x8*)(V_lds + (bf) * SHM_V + vst1) = pack8(S.sf2, S.sf3); } while (0)
template <class TIn, class TOut>
__device__ __forceinline__ void causal_swa_prime(const BlockRef<TIn, TOut>& cur, int W, char* lds, Seam<TIn>& S) {
    constexpr bool F32 = same_t<TIn, float>::v;
    int tid_ = threadIdx.x; asm volatile("" : "+v"(tid_));
    const int tid = tid_, wid = __builtin_amdgcn_readfirstlane(tid >> 6), lane = tid & 63, r32 = lane & 31, hi = lane >> 5;
    const int sr = tid >> 4, sc = (tid & 15) * 8, kws = KSWZ(sr, sc * 2); char* K_lds = lds + 2 * SHM_V;
    const int kb0 = swa_jlo(cur.P0, W) * KVBLK;
    for (int d0 = 0; d0 < 8; ++d0) S.qr[d0] = load8<TIn>(cur.Q + (size_t)(wid * QBLK + r32) * LDP + d0 * 16 + hi * 8);
    if constexpr (F32) { SLOAD_F((const float*)cur.K, kb0); VMW(); SWRITE_KF(0); SBAR(); SLOAD_F((const float*)cur.V, kb0); }
    else { SLOAD_H(cur.K, cur.V, kb0); VMW(); SWRITE_HK(0); }
    __syncthreads();
}
template <class TIn, class TOut>
__device__ __forceinline__ void causal_swa_block(const BlockRef<TIn, TOut>& cur, const BlockRef<TIn, TOut>& nxt, int skv, int W, char* lds, Seam<TIn>& S) {
    constexpr bool F32 = same_t<TIn, float>::v;
    int tid_ = threadIdx.x; asm volatile("" : "+v"(tid_));
    const int tid = tid_, wid = __builtin_amdgcn_readfirstlane(tid >> 6), lane = tid & 63, r32 = lane & 31, hi = lane >> 5;
    const int j_lo = swa_jlo(cur.P0, W);
    int j_hi = (cur.P0 + QB - 1) / KVBLK + 1; if (j_hi > skv / KVBLK) j_hi = skv / KVBLK;
    const int NT = j_hi - j_lo;
    const int kbn = swa_jlo(nxt.P0, W) * KVBLK;
    const int qlo = cur.P0 + wid * QBLK, qm = qlo + r32 - 4 * hi;
    char* V_lds = lds; char* K_lds = lds + 2 * SHM_V;
    float* ws = (float*)(lds + 2 * SHM_V + 2 * SHM_K) + wid * 64; float* li_l = ws, * al_l = ws + 32;
    float m_reg = -1e30f, l_reg = 0; f32x16 o[4] = {};
    const int sr = tid >> 4, sc = (tid & 15) * 8, vst0 = v_st(sr, sc), vst1 = v_st(32 + sr, sc), kws = KSWZ(sr, sc * 2);
    const int vb0 = (int)(uintptr_t)V_lds + v_rd_base(lane);
    const TIn* Kh = cur.K; const TIn* Vh = cur.V;
#define RESC(a) do { if (__any((a) < 1.f)) { if (hi == 0) al_l[r32] = (a); asm volatile("s_waitcnt lgkmcnt(0)" ::: "memory");              \
                     for (int d_ = 0; d_ < 4; ++d_) for (int r = 0; r < 16; ++r) o[d_][r] *= al_l[crow(r, hi)]; } } while (0)
#define KBASE(t) ((j_lo + (t)) * KVBLK)
#define ACT(t) (KBASE(t) <= qlo + QBLK - 1 && KBASE(t) + KVBLK - 1 >= qlo - W + 1)
#define MASKT(P0_, P1_, t) do { const int kb_ = KBASE(t); if ((!SK || ACT(t)) && (kb_ + KVBLK - 1 > qlo || kb_ <= qlo + QBLK - 1 - W)) mask_tile(P0_, P1_, qm - kb_, (unsigned)W); } while (0)
    constexpr int NQL = F32 ? 16 : 8;
    constexpr bool SK = WSKIP && !F32;
#define SEAM_K0() do { VMWN(NQL); if constexpr (F32) { SWRITE_KF(0); SBAR(); SLOAD_F((const float*)nxt.V, kbn); } else { SWRITE_HK(0); } SBAR(); } while (0)
    f32x16 pA0, pA1, pB0, pB1; float mnA, mnB, alA, alB; bf16x8 pa0, pa1, pa2, pa3;
    if constexpr (F32) { VMW(); SWRITE_VF(0); SBAR(); } else { SWRITE_HV(0); SBAR(); }
    if (NT > 1) { if constexpr (F32) SLOAD_F((const float*)Kh, KBASE(1)); else SLOAD_H(Kh, Vh, KBASE(1)); }
    SBAR(); qkt<0, SK>(pA0, pA1, K_lds, r32, hi, S.qr, ACT(0));
    if constexpr (F32) { if (NT > 1) { VMW(); SWRITE_KF(1); SBAR(); SLOAD_F((const float*)Vh, KBASE(1)); } }
    MASKT(pA0, pA1, 0); partialSM(pA0, pA1, m_reg, mnA, alA);
    if (NT > 1) { VMW(); if constexpr (F32) { SWRITE_VF(1); SBAR(); if (NT > 2) SLOAD_F((const float*)Kh, KBASE(2)); } else SWRITE_H(1); }
    __syncthreads();
#define HALF_STEP(PX0, PX1, mnX, alX, PY0, PY1, alY, t, KB, VB, SB) do {                                                      \
        SBAR(); qkt<KB, SK>(PX0, PX1, K_lds, r32, hi, S.qr, ACT(t));                                             \
        finishSM(PY0, PY1, alY, l_reg, pa0, pa1, pa2, pa3); SBAR();                                                           \
        if ((t) + 1 < NT) { if constexpr (F32) { VMW(); SWRITE_KF(SB); SBAR(); SLOAD_F((const float*)Vh, KBASE((t) + 1)); }  \
                            else { SLOAD_H(Kh, Vh, KBASE((t) + 1)); } SBAR(); }                                               \
        pv_tile<VB, SK>(o, vb0, pa0, pa1, pa2, pa3, ACT((t) - 1)); MASKT(PX0, PX1, (t)); partialSM(PX0, PX1, m_reg, mnX, alX);                                        \
        __syncthreads();                                                                                                      \
        if ((t) + 1 < NT) { VMW(); if constexpr (F32) { SWRITE_VF(SB); SBAR(); if ((t) + 2 < NT) SLOAD_F((const float*)Kh, KBASE((t) + 2)); } \
                            else { SWRITE_H(SB); } }                                                                          \
        RESC(alX); __syncthreads(); } while (0)
    for (int t = 1; t + 1 < NT; t += 2) {
        HALF_STEP(pB0, pB1, mnB, alB, pA0, pA1, alA, t, 1, 0, 0);
        HALF_STEP(pA0, pA1, mnA, alA, pB0, pB1, alB, t + 1, 0, 1, 1);
    }
    const bool even = (NT & 1) == 0;
    if (even) { SBAR(); qkt<1, SK>(pB0, pB1, K_lds, r32, hi, S.qr, ACT(NT - 1)); SBAR(); }
#define QROW(e) (nxt.Q + (size_t)(wid * QBLK + r32) * LDP + ((e) >> 1) * 16 + hi * 8 + ((e) & 1) * 4)
    if constexpr (F32) { SLOAD_F((const float*)nxt.K, kbn); SBAR();
#pragma unroll
        for (int e = 0; e < 8; ++e) S.tq[e] = *(const f32x4*)QROW(e); }
    else { SLOAD_H(nxt.K, nxt.V, kbn); SBAR();
#pragma unroll
        for (int d0 = 0; d0 < 8; ++d0) S.qr[d0] = load8<TIn>(nxt.Q + (size_t)(wid * QBLK + r32) * LDP + d0 * 16 + hi * 8); }
    SBAR();
    finishSM(pA0, pA1, alA, l_reg, pa0, pa1, pa2, pa3); SBAR();
    if constexpr (F32) {
#pragma unroll
        for (int e = 8; e < 16; ++e) S.tq[e] = *(const f32x4*)QROW(e); SBAR(); }
#undef QROW
    pv_tile<0, SK>(o, vb0, pa0, pa1, pa2, pa3, ACT(even ? NT - 2 : NT - 1));
    if (even) { MASKT(pB0, pB1, NT - 1); partialSM(pB0, pB1, m_reg, mnB, alB); __syncthreads(); RESC(alB);
        finishSM(pB0, pB1, alB, l_reg, pa0, pa1, pa2, pa3); SBAR(); pv_tile<1, SK>(o, vb0, pa0, pa1, pa2, pa3, ACT(NT - 1)); }
    SBAR(); SEAM_K0();
    if (hi == 0) li_l[r32] = l_reg; asm volatile("s_waitcnt lgkmcnt(0)" ::: "memory");
    float rli[16];
#pragma unroll
    for (int r = 0; r < 16; ++r) rli[r] = __builtin_amdgcn_rcpf(li_l[crow(r, hi)]);
    TOut* Ow = cur.O + (size_t)(wid * QBLK) * LDO;
#pragma unroll
    for (int r = 0; r < 16; ++r) { const int orow = crow(r, hi);
#pragma unroll
        for (int d0 = 0; d0 < 4; ++d0) { const float v = o[d0][r] * rli[r];
            if constexpr (same_t<TOut, float>::v) { Ow[(size_t)orow * LDO + d0 * 32 + r32] = v; }
            else { const float vn = __shfl_xor(v, 1);
                   if ((r32 & 1) == 0) *(unsigned*)(Ow + (size_t)orow * LDO + d0 * 32 + r32) = cvtpk(v, vn); } } }
    if constexpr (F32) {
#pragma unroll
        for (int d0 = 0; d0 < 8; ++d0) S.qr[d0] = pack8(S.tq[2 * d0], S.tq[2 * d0 + 1]); }
    __syncthreads();
#undef RESC
#undef KBASE
#undef ACT
#undef MASKT
#undef SEAM_K0
#undef HALF_STEP
}
#undef ROW
#undef VMW
#undef VMWN
#undef SLOAD_H
#undef SWRITE_HK
#undef SWRITE_HV
#undef SWRITE_H
#undef SLOAD_F
#undef SWRITE_KF
#undef SWRITE_VF

}
namespace da {
using namespace swa;
constexpr int SEQ_LEN = 8192, ATT_LD = 4096;
constexpr int STAGE_B = 65536, OFF_K = 0, OFF_VLO = 32768, OFF_VHI = 49152, QROWS = 128;
typedef __attribute__((address_space(3))) unsigned lds_u32;
__device__ __forceinline__ void dma16(const bf16* g, char* lds_dst_uniform) {
    __builtin_amdgcn_global_load_lds((const unsigned*)g, (lds_u32*)lds_dst_uniform, 16, 0, 0);
}
struct Ctx { const bf16* proj; bf16* att; const float* subln_g; float lam; };
__device__ __forceinline__ void issue_tile(const bf16* Kg, const bf16* Vg, int k0, char* stage, int wid, const int (&koff)[2], const int (&voff)[2]) {
    const bf16* kb = Kg + (size_t)k0 * LDP; const bf16* vb = Vg + (size_t)k0 * LDP;
#pragma unroll
    for (int i = 0; i < 2; ++i) {
        char* dst = stage + (2 * wid + i) * 1024;
        dma16(kb + koff[i], dst + OFF_K);
        dma16(kb + 128 + koff[i], dst + OFF_K + 16384);
        dma16(vb + voff[i], dst + OFF_VLO);
        dma16(vb + 128 + voff[i], dst + OFF_VHI);
    }
}
template <int ST>
__device__ __forceinline__ void step(f32x16 (&o)[8], const bf16x8 (&qr)[8], float& m_reg, float& l_reg, char* lds, float* al_l, int vb0, int map, int r32, int hi,
                                     bool need_mask, int dq, bool more, const bf16* Kg, const bf16* Vg, int k_next, int wid, const int (&koff)[2], const int (&voff)[2]) {
    asm volatile("s_waitcnt vmcnt(0)" ::: "memory"); __builtin_amdgcn_s_barrier(); asm volatile("" ::: "memory");
    f32x16 p0, p1; float mn, alpha; bf16x8 pa0, pa1, pa2, pa3;
    qkt<0, false>(p0, p1, lds + ST * STAGE_B + OFF_K + map * 16384, r32, hi, qr, true);
    if (need_mask) mask_tile(p0, p1, dq, 0x7fffffffu);
    partialSM(p0, p1, m_reg, mn, alpha);
    finishSM(p0, p1, alpha, l_reg, pa0, pa1, pa2, pa3);
    if (__any(alpha < 1.f)) { if (hi == 0) al_l[r32] = alpha; asm volatile("s_waitcnt lgkmcnt(0)" ::: "memory");
#pragma unroll
        for (int d_ = 0; d_ < 8; ++d_)
#pragma unroll
            for (int r = 0; r < 16; ++r) o[d_][r] *= al_l[crow(r, hi)]; }
    pv_tile<0, false>(o, vb0 + ST * STAGE_B + OFF_VLO, pa0, pa1, pa2, pa3, true);
    if (more) issue_tile(Kg, Vg, k_next, lds + (ST ^ 1) * STAGE_B, wid, koff, voff);
    pv_tile<0, false>(o + 4, vb0 + ST * STAGE_B + OFF_VHI, pa0, pa1, pa2, pa3, true);
}
__device__ __forceinline__ void unit(const Ctx& C, int b, int h, int qi, char* lds, float* wsf) {
    int tid_ = threadIdx.x; asm volatile("" : "+v"(tid_));
    const int tid = tid_, wid = __builtin_amdgcn_readfirstlane(tid >> 6), lane = tid & 63, r32 = lane & 31, hi = lane >> 5;
    const int map = wid >> 2, wq = wid & 3, q0 = qi * QROWS, NT = 2 * qi + 2;
    const size_t row0 = (size_t)b * SEQ_LEN;
    const bf16* Kg = C.proj + row0 * LDP + 2048 + h * 256;
    const bf16* Vg = C.proj + row0 * LDP + 4096 + h * 256;
    const bf16* Qg = C.proj + (row0 + q0 + wq * 32) * LDP + h * 256 + map * 128;
    float* al_l = wsf + wid * 64; float* li_l = al_l + 32;
    int koff[2], voff[2];
#pragma unroll
    for (int i = 0; i < 2; ++i) { const int c = 2 * wid + i;
        const int row = 4 * c + (lane >> 4), gch = (lane & 15) ^ (row & 7); koff[i] = row * LDP + gch * 8;
        const int sub = 2 * c + (lane >> 5), kk = (sub >> 2) * 8 + ((lane & 31) >> 2), col = (sub & 3) * 32 + (lane & 3) * 8;
        const int k = (kk & ~0xC) | ((kk & 4) << 1) | ((kk & 8) >> 1); voff[i] = k * LDP + col; }
    issue_tile(Kg, Vg, 0, lds, wid, koff, voff);
    bf16x8 qr[8];
#pragma unroll
    for (int d0 = 0; d0 < 8; ++d0) qr[d0] = load8<bf16>(Qg + (size_t)r32 * LDP + d0 * 16 + hi * 8);
    f32x16 o[8];
#pragma unroll
    for (int d = 0; d < 8; ++d) o[d] = f32x16{};
    float m_reg = -1e30f, l_reg = 0.f;
    const int vb0 = (int)(uintptr_t)lds + v_rd_base(lane);
    const int qlo = q0 + wq * 32, qm = qlo + r32 - 4 * hi;
    for (int t = 0; t < NT; t += 2) {
        { const int kb = t * 64;       step<0>(o, qr, m_reg, l_reg, lds, al_l, vb0, map, r32, hi, kb + 63 > qlo, qm - kb, true,       Kg, Vg, kb + 64,  wid, koff, voff); }
        { const int kb = (t + 1) * 64; step<1>(o, qr, m_reg, l_reg, lds, al_l, vb0, map, r32, hi, kb + 63 > qlo, qm - kb, t + 2 < NT, Kg, Vg, kb + 64, wid, koff, voff); }
    }
    if (hi == 0) li_l[r32] = l_reg; asm volatile("s_waitcnt lgkmcnt(0)" ::: "memory");
    float rli[16];
#pragma unroll
    for (int r = 0; r < 16; ++r) rli[r] = __builtin_amdgcn_rcpf(li_l[crow(r, hi)]);
#pragma unroll
    for (int d = 0; d < 8; ++d)
#pragma unroll
        for (int r = 0; r < 16; ++r) o[d][r] *= rli[r];
    asm volatile("s_waitcnt lgkmcnt(0)" ::: "memory"); __builtin_amdgcn_s_barrier(); asm volatile("" ::: "memory");
    char* xch = lds + wq * 32768 + lane * 16;
    if (map == 1) {
#pragma unroll
        for (int d = 0; d < 8; ++d)
#pragma unroll
            for (int rq = 0; rq < 4; ++rq) *(f32x4*)(xch + d * 4096 + rq * 1024) = (f32x4){o[d][4 * rq], o[d][4 * rq + 1], o[d][4 * rq + 2], o[d][4 * rq + 3]};
    }
    asm volatile("s_waitcnt lgkmcnt(0)" ::: "memory"); __builtin_amdgcn_s_barrier(); asm volatile("" ::: "memory");
    if (map == 0) {
        const float lam = C.lam; float ss[16];
#pragma unroll
        for (int r = 0; r < 16; ++r) ss[r] = 0.f;
#pragma unroll
        for (int d = 0; d < 8; ++d)
#pragma unroll
            for (int rq = 0; rq < 4; ++rq) { const f32x4 v2 = *(const f32x4*)(xch + d * 4096 + rq * 1024);
#pragma unroll
                for (int j = 0; j < 4; ++j) { const float dd = o[d][4 * rq + j] - lam * v2[j]; o[d][4 * rq + j] = dd; ss[4 * rq + j] += dd * dd; } }
#pragma unroll
        for (int r = 0; r < 16; ++r) { float s = ss[r]; s += __shfl_xor(s, 1); s += __shfl_xor(s, 2); s += __shfl_xor(s, 4); s += __shfl_xor(s, 8); s += __shfl_xor(s, 16);
            ss[r] = 1.0f / sqrtf(s * (1.0f / 256.0f) + 1e-5f); }
        bf16* Ow = C.att + (row0 + q0 + wq * 32) * ATT_LD + h * 256;
#pragma unroll
        for (int d = 0; d < 8; ++d) { const float gl = C.subln_g[d * 32 + r32] * 0.8f;
#pragma unroll
            for (int r = 0; r < 16; ++r) { const float v = o[d][r] * ss[r] * gl; const float vn = __shfl_xor(v, 1);
                if ((r32 & 1) == 0) *(unsigned*)(Ow + (size_t)crow(r, hi) * ATT_LD + d * 32 + r32) = cvtpk(v, vn); } }
    }
    asm volatile("s_waitcnt lgkmcnt(0)" ::: "memory"); __builtin_amdgcn_s_barrier(); asm volatile("" ::: "memory");
}
__device__ __forceinline__ void phase(const Ctx& C, char* lds, float* wsf, int vcu, int G) {
    const int npair = (512 - vcu + G - 1) / G;
    for (int u = 0; u < 2 * npair; ++u) { const int p = vcu + (u >> 1) * G, bh = p >> 5, x = p & 31;
        unit(C, bh >> 3, bh & 7, (u & 1) ? 63 - x : x, lds, wsf); }
}
}

constexpr int NWAVES = 8;
#ifndef MK_PER_PHASE
#define MK_PER_PHASE 0
#endif
constexpr int NPH = 12;

constexpr int BATCH = 2, SEQ = 8192, DM = 4096, M = BATCH * SEQ;
constexpr int NHEADS = 8;
constexpr int NIN = 20480, CWID = 2048, DFF = 11008, NUP = 2 * DFF;
constexpr int OFF_Q = 0, OFF_K = 2048, OFF_V = 4096, OFF_U = 6144, OFF_GB = 8192, OFF_GC = 10240, OFF_GA = 12288, OFF_GCV = 16384;
constexpr float LN_EPS = 1e-5f, RMS_EPS = 1e-5f;
constexpr float ALPHA = 1.189207115002721f;
constexpr float LAM_INIT = 0.2f;

constexpr size_t MiB = 1u << 20;
constexpr size_t WS_CTL = 0, CTL_ZERO_BYTES = 32768;
constexpr size_t WS_WA = 1 * MiB, WS_WC = 17 * MiB, WS_WO = 33 * MiB, WS_WIN = 65 * MiB, WS_WDN = 225 * MiB, WS_HALO = 311 * MiB, WS_PROJ = 353 * MiB, WS_ATTN = 993 * MiB, WS_YC = 1057 * MiB, WS_WUP = 1121 * MiB;
constexpr size_t WS_MERGED = 65 * MiB;
constexpr size_t WS_H1B = 353 * MiB;
constexpr size_t WS_G = 481 * MiB;
constexpr size_t WS_END = 1293 * MiB;
constexpr size_t DO_XB = 0, DO_O1 = 0, DO_O2 = 128 * MiB;
static_assert(WS_WIN + (size_t)NIN * DM * 2 <= WS_WDN && WS_WDN + (size_t)DM * DFF * 2 <= WS_HALO && WS_HALO + (size_t)(M / 256) * (NUP / 256) * 1024 * 4 <= WS_PROJ, "ws map (weights)");
static_assert(WS_PROJ + (size_t)M * NIN * 2 <= WS_ATTN && WS_G + (size_t)M * DFF * 2 <= WS_ATTN && WS_WUP + (size_t)NUP * DM * 2 <= WS_END && WS_H1B + (size_t)M * DM * 2 <= WS_G, "ws map");
constexpr int CW_BAR = 4096;

constexpr int RING_OFF = 0, RING_BYTES = 131072;
constexpr int LDSCTL_OFF = RING_BYTES, MISC_OFF = LDSCTL_OFF + 320, HALO_LDS_OFF = LDSCTL_OFF + 1024;
constexpr int LDS_BYTES = 147456;
static_assert(MISC_OFF + 128 <= HALO_LDS_OFF && HALO_LDS_OFF + 8192 <= LDS_BYTES, "LDS map");

#define GAS __attribute__((address_space(1)))
#define LAS __attribute__((address_space(3)))
typedef unsigned short bf16;
typedef unsigned v4u __attribute__((ext_vector_type(4)));
typedef float f32x4 __attribute__((ext_vector_type(4)));
typedef short bf16x8 __attribute__((ext_vector_type(8)));
typedef GAS unsigned gu32;
typedef GAS unsigned long long gu64;
#define RLX_AGENT __ATOMIC_RELAXED, __HIP_MEMORY_SCOPE_AGENT
#define LDS_WAIT() asm volatile("s_waitcnt lgkmcnt(0)" ::: "memory")
#define VM_WAIT() asm volatile("s_waitcnt vmcnt(0)" ::: "memory")
__device__ __forceinline__ unsigned long long rt() { return __builtin_amdgcn_s_memrealtime(); }
__device__ __forceinline__ unsigned f2bf(float f) { unsigned u = __builtin_bit_cast(unsigned, f); return (u + 0x7fffu + ((u >> 16) & 1u)) >> 16; }
__device__ __forceinline__ unsigned pk2(float lo, float hi) { return f2bf(lo) | (f2bf(hi) << 16); }

#define XB_TMO      128
#define XB_XCNT(j)  (256  + 64 * (j))
#define XB_XSUB(j)  (1280 + 64 * (j))
#define XB_XGEN(j)  (2304 + 64 * (j))
#define XB_TOP      3328
#define XB_TOPGEN   3392
#define XCD_BAR_WORDS 3456
#define XB_SPIN_CAP (1u << 18)

__device__ __forceinline__ unsigned xb_ld(unsigned* p)              { return __hip_atomic_load(p, __ATOMIC_RELAXED, __HIP_MEMORY_SCOPE_AGENT); }
__device__ __forceinline__ unsigned xb_add(unsigned* p, unsigned v) { return __hip_atomic_fetch_add(p, v, __ATOMIC_RELAXED, __HIP_MEMORY_SCOPE_AGENT); }
__device__ __forceinline__ unsigned xb_xcc_id() { return (unsigned)__builtin_amdgcn_s_getreg((3 << 11) | 20) & 0xFu; }
#define XB_SPIN(cond, bar) do { unsigned _sp = 0; while (cond) { __builtin_amdgcn_s_sleep(1); \
    if ((++_sp & 255u) == 0u) { if (xb_ld(&(bar)[XB_TMO])) break; if (_sp > XB_SPIN_CAP) { atomicAdd(&(bar)[XB_TMO], 1u); break; } } } } while (0)

struct XcdBarrier {
    unsigned* bar; unsigned x;
    volatile LAS unsigned* st;
};

__device__ __forceinline__ XcdBarrier xcd_barrier_post(unsigned* bar, volatile LAS unsigned* st) {
    XcdBarrier b; b.bar = bar; b.x = xb_xcc_id(); b.st = st;
    if (threadIdx.x == 0) (void)xb_add(&bar[XB_XCNT(b.x)], 1u);
    return b;
}
__device__ __forceinline__ void xcd_barrier_complete(unsigned* bar, unsigned x, unsigned& nloc, unsigned& nx) {
    const unsigned G = gridDim.x * gridDim.y * gridDim.z;
    unsigned sum, cnt, mine, sp = 0u;
    for (;;) {
        sum = 0u; cnt = 0u; mine = 0u;
#pragma unroll
        for (unsigned j = 0; j < 16; ++j) { const unsigned c = xb_ld(&bar[XB_XCNT(j)]); sum += c; cnt += (c > 0u) ? 1u : 0u; mine = (j == x) ? c : mine; }
        if (sum == G) break;
        __builtin_amdgcn_s_sleep(1);
        if ((++sp & 255u) == 0u) { if (xb_ld(&bar[XB_TMO])) break; if (sp > XB_SPIN_CAP) { atomicAdd(&bar[XB_TMO], 1u); break; } }
    }
    nloc = mine > 0u ? mine : 1u; nx = cnt > 0u ? cnt : 1u;
}

__device__ __forceinline__ void xcd_barrier(const XcdBarrier& b) {
    asm volatile("s_waitcnt vmcnt(0)" ::: "memory");
    __syncthreads();
    if (threadIdx.x == 0) {
        unsigned* bar = b.bar;
        __builtin_amdgcn_s_waitcnt(0);
        unsigned nloc = b.st[0], nx = b.st[1];
        if (nloc == 0u) { xcd_barrier_complete(bar, b.x, nloc, nx); b.st[0] = nloc; b.st[1] = nx; }
        const unsigned old = xb_add(&bar[XB_XSUB(b.x)], 1u);
        const unsigned gen = old / nloc;
        if (old + 1u == (gen + 1u) * nloc) {
            __builtin_amdgcn_fence(__ATOMIC_RELEASE, "agent");
            asm volatile("s_waitcnt vmcnt(0)" ::: "memory");
            const unsigned og = xb_add(&bar[XB_TOP], 1u);
            const unsigned tg = og / nx;
            if (og + 1u == (tg + 1u) * nx) xb_add(&bar[XB_TOPGEN], 1u);
            else XB_SPIN(xb_ld(&bar[XB_TOPGEN]) == tg, bar);
            __builtin_amdgcn_fence(__ATOMIC_ACQUIRE, "agent");
            xb_add(&bar[XB_XGEN(b.x)], 1u);
            asm volatile("s_waitcnt vmcnt(0)" ::: "memory");
        } else {
            XB_SPIN(xb_ld(&bar[XB_XGEN(b.x)]) == gen, bar);
            __builtin_amdgcn_fence(__ATOMIC_ACQUIRE, "agent");
            asm volatile("s_waitcnt vmcnt(0)" ::: "memory");
        }
    }
    __syncthreads();
}

struct Frame {
    LAS unsigned char* lds;
    volatile LAS unsigned* MISC;
    gu32* ctl;
    int wave;
    int vcu, G;
};
__device__ __forceinline__ unsigned pkbf(float lo, float hi) { return pg8::cvt_pk_bf16(lo, hi); }
__device__ __forceinline__ float rnd6(float v) { return __uint_as_float((__float_as_uint(v) + 0x10000u) & 0xfffe0000u); }
__device__ __forceinline__ unsigned pkw(float lo, float hi) { return pg8::cvt_pk_bf16(rnd6(lo), rnd6(hi)); }
__device__ __forceinline__ float shfl_xor_l(float v, int mask, int lane) { return __int_as_float(__builtin_amdgcn_ds_bpermute((lane ^ mask) << 2, __float_as_int(v))); }
__device__ __forceinline__ float wave_sum(float v, int lane) {
#pragma unroll
    for (int o = 1; o < 64; o <<= 1) v += shfl_xor_l(v, o, lane);
    return v;
}
template <int ILV = 0, bool HF = false> __device__ __forceinline__ void transpose_item(const float* W, int K, int N, bf16* WT, LAS float* scr, int item, int lane, int ldk = 0, int kofs = 0) {
    if (ldk == 0) ldk = K;
    const int nblk = N / 32, kb = item / nblk, nb = item % nblk, k0 = 64 * kb, n0 = 32 * nb;
    const int d0 = ILV == 1 ? ((n0 < DFF) ? (n0 / 128) * 256 + (n0 % 128) : ((n0 - DFF) / 128) * 256 + 128 + ((n0 - DFF) % 128))
                 : ILV == 2 ? ((n0 < OFF_GA) ? n0 : (n0 < OFF_GCV) ? OFF_GA + ((n0 - OFF_GA) / 128) * 256 + ((n0 - OFF_GA) % 128) : OFF_GA + ((n0 - OFF_GCV) / 128) * 256 + 128 + ((n0 - OFF_GCV) % 128)) : n0;
#pragma unroll 8
    for (int i = 0; i < 32; ++i) { const int kk = 2 * i + (lane >> 5); scr[kk * 33 + (lane & 31)] = W[(size_t)(k0 + kk) * N + n0 + (lane & 31)]; }
    LDS_WAIT(); asm volatile("" ::: "memory");
    const int c = lane & 7;
#pragma unroll
    for (int j = 0; j < 4; ++j) { const int n = (lane >> 3) + 8 * j; const LAS float* s = scr + (8 * c) * 33 + n;
        v4u o;
        if constexpr (HF) { o.x = pg8::pk_h2(s[0 * 33], s[1 * 33]); o.y = pg8::pk_h2(s[2 * 33], s[3 * 33]); o.z = pg8::pk_h2(s[4 * 33], s[5 * 33]); o.w = pg8::pk_h2(s[6 * 33], s[7 * 33]); }
        else { o.x = pkw(s[0 * 33], s[1 * 33]); o.y = pkw(s[2 * 33], s[3 * 33]); o.z = pkw(s[4 * 33], s[5 * 33]); o.w = pkw(s[6 * 33], s[7 * 33]); }
        *(GAS v4u*)(WT + (size_t)(d0 + n) * ldk + kofs + k0 + 8 * c) = o; }
    LDS_WAIT(); asm volatile("" ::: "memory");
}
template <bool FOUT> __device__ __forceinline__ void ln_row_h(bf16* hrow, const float* g, const float* b, float* orow_f, int lane, bool poison, bf16* brow = nullptr) {
    GAS v4u* xr = (GAS v4u*)hrow + lane;
    float v[8][8]; float s = 0.f;
#pragma unroll
    for (int j = 0; j < 8; ++j) { const v4u w = xr[64 * j];
        v[j][0] = pg8::h_lo(w.x); v[j][1] = pg8::h_hi(w.x); v[j][2] = pg8::h_lo(w.y); v[j][3] = pg8::h_hi(w.y); v[j][4] = pg8::h_lo(w.z); v[j][5] = pg8::h_hi(w.z); v[j][6] = pg8::h_lo(w.w); v[j][7] = pg8::h_hi(w.w);
#pragma unroll
        for (int i = 0; i < 8; ++i) s += v[j][i]; }
    const float mean = wave_sum(s, lane) * (1.f / DM); float s2 = 0.f;
#pragma unroll
    for (int j = 0; j < 8; ++j)
#pragma unroll
        for (int i = 0; i < 8; ++i) { v[j][i] -= mean; s2 += v[j][i] * v[j][i]; }
    float rstd = 1.f / sqrtf(wave_sum(s2, lane) * (1.f / DM) + LN_EPS);
    if (poison) rstd = __builtin_nanf("");
#pragma unroll
    for (int j = 0; j < 8; ++j) { const int e0 = 8 * (lane + 64 * j); const f32x4 g0 = *(const GAS f32x4*)(g + e0), g1 = *(const GAS f32x4*)(g + e0 + 4), b0 = *(const GAS f32x4*)(b + e0), b1 = *(const GAS f32x4*)(b + e0 + 4);
        const f32x4 o0 = (f32x4){v[j][0], v[j][1], v[j][2], v[j][3]} * rstd * g0 + b0, o1 = (f32x4){v[j][4], v[j][5], v[j][6], v[j][7]} * rstd * g1 + b1;
        if constexpr (FOUT) { *(GAS f32x4*)(orow_f + e0) = o0; *(GAS f32x4*)(orow_f + e0 + 4) = o1; }
        else { v4u w; w.x = pg8::pk_h2(o0[0], o0[1]); w.y = pg8::pk_h2(o0[2], o0[3]); w.z = pg8::pk_h2(o1[0], o1[1]); w.w = pg8::pk_h2(o1[2], o1[3]); xr[64 * j] = w;
               v4u wb; wb.x = pkbf(o0[0], o0[1]); wb.y = pkbf(o0[2], o0[3]); wb.z = pkbf(o1[0], o1[1]); wb.w = pkbf(o1[2], o1[3]); ((GAS v4u*)brow)[lane + 64 * j] = wb; } }
}
__device__ __forceinline__ void unpack8(const v4u w, float (&f)[8]) {
    f[0] = __uint_as_float(w.x << 16); f[1] = __uint_as_float(w.x & 0xffff0000u); f[2] = __uint_as_float(w.y << 16); f[3] = __uint_as_float(w.y & 0xffff0000u);
    f[4] = __uint_as_float(w.z << 16); f[5] = __uint_as_float(w.z & 0xffff0000u); f[6] = __uint_as_float(w.w << 16); f[7] = __uint_as_float(w.w & 0xffff0000u);
}
__device__ __forceinline__ v4u pack8f(const float (&f)[8]) { v4u o; o.x = pkbf(f[0], f[1]); o.y = pkbf(f[2], f[3]); o.z = pkbf(f[4], f[5]); o.w = pkbf(f[6], f[7]); return o; }

typedef const void __attribute__((address_space(4)))* karg_ptr_t;
template <int OFF> __device__ __forceinline__ unsigned long long karg_u64() {
    unsigned long long v; karg_ptr_t kp = (karg_ptr_t)__builtin_amdgcn_kernarg_segment_ptr();
    asm volatile("s_load_dwordx2 %0, %1, %2\n\ts_waitcnt lgkmcnt(0)" : "=s"(v) : "s"(kp), "i"(OFF)); return v; }
template <int OFF> __device__ __forceinline__ int karg_i32() {
    int v; karg_ptr_t kp = (karg_ptr_t)__builtin_amdgcn_kernarg_segment_ptr();
    asm volatile("s_load_dword %0, %1, %2\n\ts_waitcnt lgkmcnt(0)" : "=s"(v) : "s"(kp), "i"(OFF)); return v; }
#define KARG_F(k) ((const float*)(const GAS float*)karg_u64<8 * (k)>())
#define KARG_OUT() ((float*)(GAS float*)karg_u64<144>())
#define KARG_WS() ((unsigned char*)(GAS unsigned char*)karg_u64<152>())
__device__ __forceinline__ int lane_id() { int l; asm volatile("v_mbcnt_lo_u32_b32 %0, -1, 0\n\tv_mbcnt_hi_u32_b32 %0, -1, %0" : "=v"(l)); return l; }

struct RevOrder : pg8::StaticOrder {
    __device__ bool next(int i, pg8::Unit& u) const { if (!pg8::StaticOrder::next(i, u)) return false; u.pn = nN - 1 - u.pn; return true; } };
struct Order4 : pg8::StaticOrder {
    __device__ bool next(int i, pg8::Unit& u) const {
        const long L = (long)i * G + c; if (L >= nwg) return false;
        int wgid = (int)L; { const int q = nwg / pg8::NXCD, r = nwg % pg8::NXCD, xcd = wgid % pg8::NXCD, off = wgid / pg8::NXCD; wgid = (xcd < r ? xcd * (q + 1) : r * (q + 1) + (xcd - r) * q) + off; }
        constexpr int W4 = 4; const int nig = W4 * nN, gid = wgid / nig, fm = gid * W4, gsz = (nM - fm) < W4 ? (nM - fm) : W4;
        u.pm = fm + ((wgid % nig) % gsz); u.pn = (wgid % nig) / gsz; return true;
    } };
struct Args { const float* in[18]; float* out; unsigned char* ws; int ph_lo, ph_hi, li, pad; };
__global__ void __launch_bounds__(NWAVES * 64, 2) fwd(Args  ) {
    extern __shared__ __attribute__((aligned(16))) unsigned char lds[];
    Frame F;
    F.lds = (LAS unsigned char*)lds;
    F.MISC = (volatile LAS unsigned*)(F.lds + MISC_OFF);
    F.wave = __builtin_amdgcn_readfirstlane((int)threadIdx.x >> 6);
    F.G = gridDim.x; { const int bx = blockIdx.x; F.vcu = (F.G % 8 == 0) ? (bx % 8) * (F.G / 8) + bx / 8 : bx; }
    F.ctl = (gu32*)(KARG_WS() + WS_CTL);
    for (int u = threadIdx.x; u < (LDS_BYTES - LDSCTL_OFF) / 4; u += NWAVES * 64) ((LAS unsigned*)(F.lds + LDSCTL_OFF))[u] = 0u;
    __syncthreads();
    XcdBarrier bar; bar.bar = (unsigned*)(F.ctl + CW_BAR); bar.x = 0; bar.st = nullptr;
    if (!MK_PER_PHASE) bar = xcd_barrier_post((unsigned*)(F.ctl + CW_BAR), F.MISC + 8);
#define GRID_BAR() do { if (!MK_PER_PHASE) xcd_barrier(bar); } while (0)
#if MK_PER_PHASE
    const int lo = karg_i32<160>(), hi = karg_i32<164>();
#else
    constexpr int lo = 0, hi = NPH;
#endif
#define IN(k) (lo <= (k) && (k) < hi)
#define BOTH(k) (IN(k) && IN((k) + 1))
    const int gw = F.vcu * NWAVES + F.wave, NGW = F.G * NWAVES;
    LAS float* scr = (LAS float*)(F.lds + RING_OFF + F.wave * 16384);

    if (IN(0)) {
        const int lane = lane_id();
        unsigned char* const ws = KARG_WS(); bf16* const XB = (bf16*)((unsigned char*)KARG_OUT() + DO_XB);
        constexpr int I_IN = (DM / 64) * (NIN / 32), I_A = (CWID / 64) * (DM / 32), I_O = (DM / 64) * (DM / 32), I_UP = (DM / 64) * (NUP / 32), I_DN = (DFF / 64) * (DM / 32);
        constexpr int NIT = I_IN + 2 * I_A + I_O + I_UP + I_DN;
        const float* const w_in = KARG_F(1); const float* const w_ao = KARG_F(8); const float* const w_co = KARG_F(9); const float* const w_o = KARG_F(10); const float* const xin = KARG_F(0);
        const float* const w_up = KARG_F(13); const float* const w_dn = KARG_F(15);
        for (int it = gw; it < NIT; it += NGW) {
            int r = it;
            if (r < I_IN) { transpose_item<2>(w_in, DM, NIN, (bf16*)(ws + WS_WIN), scr, r, lane); continue; } r -= I_IN;
            if (r < I_A) { transpose_item(w_ao, CWID, DM, (bf16*)(ws + WS_WA), scr, r, lane, 2 * CWID, 0); continue; } r -= I_A;
            if (r < I_A) { transpose_item(w_co, CWID, DM, (bf16*)(ws + WS_WA), scr, r, lane, 2 * CWID, CWID); continue; } r -= I_A;
            if (r < I_O) { transpose_item(w_o, DM, DM, (bf16*)(ws + WS_WO), scr, r, lane); continue; } r -= I_O;
            if (r < I_UP) { transpose_item<1>(w_up, DM, NUP, (bf16*)(ws + WS_WUP), scr, r, lane); continue; } r -= I_UP;
            transpose_item(w_dn, DFF, DM, (bf16*)(ws + WS_WDN), scr, r, lane);
        }
        const size_t n8 = (size_t)M * DM / 8;
        for (size_t i = (size_t)blockIdx.x * (NWAVES * 64) + F.wave * 64 + lane; i < n8; i += (size_t)F.G * (NWAVES * 64)) {
            const f32x4 a = ((const GAS f32x4*)xin)[2 * i], b = ((const GAS f32x4*)xin)[2 * i + 1];
            v4u o; o.x = pkbf(a.x, a.y); o.y = pkbf(a.z, a.w); o.z = pkbf(b.x, b.y); o.w = pkbf(b.z, b.w);
            ((GAS v4u*)XB)[i] = o;
        }
        if (BOTH(0)) GRID_BAR();
    }
    if (IN(1)) {
        unsigned char* const ws = KARG_WS(); bf16* const Win_t = (bf16*)(ws + WS_WIN); bf16* const XB = (bf16*)((unsigned char*)KARG_OUT() + DO_XB); bf16* const PROJ = (bf16*)(ws + WS_PROJ);
        pg8::Gemm g{XB, Win_t, M, NIN, DM}; RevOrder S; S.init(M, NIN, F.G, (int)blockIdx.x);
        pg8::EpiProj E{PROJ, NIN, OFF_GA, OFF_GCV};
        pg8::gemm_phase<pg8::EpiProj, RevOrder, true, true>(F.lds + RING_OFF, g, S, E);
        if (BOTH(1)) GRID_BAR();
    }
    if (IN(2)) {
        const int lane = lane_id();
        unsigned char* const ws = KARG_WS();
        float s1, s2; { const float* const q1 = KARG_F(2); const float* const k1 = KARG_F(3); const float* const q2 = KARG_F(4); const float* const k2 = KARG_F(5);
          s1 = q1[lane] * k1[lane] + q1[lane + 64] * k1[lane + 64]; s1 = wave_sum(s1, lane); s2 = q2[lane] * k2[lane] + q2[lane + 64] * k2[lane + 64]; s2 = wave_sum(s2, lane); }
        const da::Ctx C{(const swa::bf16*)(ws + WS_PROJ), (swa::bf16*)(ws + WS_ATTN), KARG_F(6), expf(s1) - expf(s2) + LAM_INIT};
        da::phase(C, (char*)lds + RING_OFF, (float*)((char*)lds + HALO_LDS_OFF), F.vcu, F.G);
        if (MK_PER_PHASE == 0) { asm volatile("s_waitcnt vmcnt(0)" ::: "memory"); __syncthreads(); }
    }
    if (IN(3)) {
        const int lane = lane_id();
        unsigned char* const ws = KARG_WS(); bf16* const PROJ = (bf16*)(ws + WS_PROJ); float* const O1 = (float*)((unsigned char*)KARG_OUT() + DO_O1); float* const O2 = (float*)((unsigned char*)KARG_OUT() + DO_O2); bf16* const YC = (bf16*)(ws + WS_ATTN) + CWID;
        const float* const conv_w = KARG_F(7);
        for (int it = gw; it < (M / 32) * 4; it += NGW) {
            const int run = it >> 2, c = (it & 3) * 512 + lane * 8, t0 = run * 32;
            float w0[8], w1[8], w2[8], p1[8], p2[8];
            { const GAS f32x4* cw = (const GAS f32x4*)(conv_w + c);
              const f32x4 a = cw[0], b = cw[1], c1 = cw[CWID / 4], d1 = cw[CWID / 4 + 1], e = cw[2 * CWID / 4], f = cw[2 * CWID / 4 + 1];
              w0[0] = a.x; w0[1] = a.y; w0[2] = a.z; w0[3] = a.w; w0[4] = b.x; w0[5] = b.y; w0[6] = b.z; w0[7] = b.w;
              w1[0] = c1.x; w1[1] = c1.y; w1[2] = c1.z; w1[3] = c1.w; w1[4] = d1.x; w1[5] = d1.y; w1[6] = d1.z; w1[7] = d1.w;
              w2[0] = e.x; w2[1] = e.y; w2[2] = e.z; w2[3] = e.w; w2[4] = f.x; w2[5] = f.y; w2[6] = f.z; w2[7] = f.w; }
            if ((t0 & (SEQ - 1)) == 0) {
#pragma unroll
                for (int j = 0; j < 8; ++j) { p1[j] = 0.f; p2[j] = 0.f; }
            } else {
                float ua[8], ga[8], ub[8], gb2[8];
                unpack8(*(const GAS v4u*)(PROJ + (size_t)(t0 - 1) * NIN + OFF_U + c), ua); unpack8(*(const GAS v4u*)(PROJ + (size_t)(t0 - 1) * NIN + OFF_GC + c), ga);
                unpack8(*(const GAS v4u*)(PROJ + (size_t)(t0 - 2) * NIN + OFF_U + c), ub); unpack8(*(const GAS v4u*)(PROJ + (size_t)(t0 - 2) * NIN + OFF_GC + c), gb2);
#pragma unroll
                for (int j = 0; j < 8; ++j) { p1[j] = ua[j] * ga[j]; p2[j] = ub[j] * gb2[j]; }
            }
#pragma unroll 4
            for (int i = 0; i < 32; ++i) {
                const size_t rowo = (size_t)(t0 + i) * NIN + c;
                float uu[8], gc[8], gbv[8], y[8];
                unpack8(*(const GAS v4u*)(PROJ + rowo + OFF_U), uu); unpack8(*(const GAS v4u*)(PROJ + rowo + OFF_GC), gc); unpack8(*(const GAS v4u*)(PROJ + rowo + OFF_GB), gbv);
#pragma unroll
                for (int j = 0; j < 8; ++j) { const float p0 = uu[j] * gc[j]; y[j] = gbv[j] * (w0[j] * p2[j] + w1[j] * p1[j] + w2[j] * p0); p2[j] = p1[j]; p1[j] = p0; }
                *(GAS v4u*)(YC + (size_t)(t0 + i) * (2 * CWID) + c) = pack8f(y);
            }
        }
        if (BOTH(3)) GRID_BAR();
    }
    if (IN(4)) {
        unsigned char* const ws = KARG_WS(); bf16* const PROJ = (bf16*)(ws + WS_PROJ);
        pg8::Gemm g{(bf16*)(ws + WS_ATTN), (bf16*)(ws + WS_WA), M, DM, 2 * CWID}; pg8::StaticOrder S; S.init(M, DM, F.G, (int)blockIdx.x);
        pg8::EpiGateMerge E{(bf16*)(ws + WS_MERGED), DM, PROJ + OFF_GA, PROJ + OFF_GCV, NIN};
        pg8::gemm_phase<pg8::EpiGateMerge, pg8::StaticOrder, true, true, true>(F.lds + RING_OFF, g, S, E);
        if (BOTH(4)) GRID_BAR();
    }
    if (IN(6)) {
        unsigned char* const ws = KARG_WS(); float* const out = KARG_OUT(); bf16* const Wo_t = (bf16*)(ws + WS_WO); bf16* const MERGED = (bf16*)(ws + WS_MERGED);
        pg8::Gemm g{MERGED, Wo_t, M, DM, DM}; pg8::StaticOrder S; S.init(M, DM, F.G, (int)blockIdx.x);
        pg8::EpiResidH<false> E{KARG_F(0), (bf16*)out};
        pg8::gemm_phase<pg8::EpiResidH<false>, pg8::StaticOrder, true, true>(F.lds + RING_OFF, g, S, E);
        if (BOTH(6)) GRID_BAR();
    }
    if (IN(7)) {
        const int lane = lane_id();
        unsigned char* const ws = KARG_WS(); float* const out = KARG_OUT(); bf16* const H1B = (bf16*)(ws + WS_H1B);
        { const float* const g1 = KARG_F(11); const float* const b1 = KARG_F(12);
          for (int t = gw; t < M; t += NGW) ln_row_h<false>((bf16*)out + (size_t)t * DM, g1, b1, nullptr, lane, false, H1B + (size_t)t * DM); }
        if (BOTH(7)) GRID_BAR();
    }
    if (IN(8)) {
        unsigned char* const ws = KARG_WS(); bf16* const H1B = (bf16*)(ws + WS_H1B); bf16* const Wup_t = (bf16*)(ws + WS_WUP); bf16* const GB = (bf16*)(ws + WS_G);
        pg8::Gemm g{H1B, Wup_t, M, NUP, DM}; pg8::StaticOrder S; S.init(M, NUP, F.G, (int)blockIdx.x);
        pg8::EpiConvSilu E{GB, DFF, KARG_F(14), NUP, DFF, (float*)(ws + WS_HALO), NUP / 256, (LAS float*)(F.lds + HALO_LDS_OFF)};
        pg8::gemm_phase<pg8::EpiConvSilu, pg8::StaticOrder, true, true>(F.lds + RING_OFF, g, S, E);
        if (BOTH(8)) GRID_BAR();
    }
    if (IN(9)) {
        const int lane = lane_id();
        unsigned char* const ws = KARG_WS(); const float* const halo = (const float*)(ws + WS_HALO); bf16* const GB = (bf16*)(ws + WS_G); const float* const ffn_cw = KARG_F(14);
        constexpr int NPN = NUP / 256, NITEM = (M / 256) * NPN * 32;
        for (int it = blockIdx.x * (NWAVES * 64) + F.wave * 64 + lane; it < NITEM; it += F.G * (NWAVES * 64)) {
            const int q = it & 31, t = it >> 5, pn = t % NPN, pm = t / NPN, lc = q * 4, ch = pn * 128 + lc;
            const GAS float* hc = (const GAS float*)halo + ((size_t)pm * NPN + pn) * 1024;
            const f32x4 g0 = *(const GAS f32x4*)(hc + lc), g1 = *(const GAS f32x4*)(hc + 256 + lc), v0 = *(const GAS f32x4*)(hc + 128 + lc), v1 = *(const GAS f32x4*)(hc + 256 + 128 + lc);
            f32x4 gp2 = {0.f, 0.f, 0.f, 0.f}, gp1 = gp2, vp2 = gp2, vp1 = gp2;
            if ((pm & 31) != 0) { const GAS float* hp = hc - (size_t)NPN * 1024; gp2 = *(const GAS f32x4*)(hp + 512 + lc); gp1 = *(const GAS f32x4*)(hp + 768 + lc); vp2 = *(const GAS f32x4*)(hp + 512 + 128 + lc); vp1 = *(const GAS f32x4*)(hp + 768 + 128 + lc); }
            f32x4 wg[3], wv[3];
#pragma unroll
            for (int k = 0; k < 3; ++k) { wg[k] = *(const GAS f32x4*)(ffn_cw + (size_t)k * NUP + ch); wv[k] = *(const GAS f32x4*)(ffn_cw + (size_t)k * NUP + DFF + ch); }
            const f32x4 cg0 = wg[0] * gp2 + wg[1] * gp1 + wg[2] * g0, cv0 = wv[0] * vp2 + wv[1] * vp1 + wv[2] * v0;
            const f32x4 cg1 = wg[0] * gp1 + wg[1] * g0 + wg[2] * g1, cv1 = wv[0] * vp1 + wv[1] * v0 + wv[2] * v1;
            float y0[4], y1[4];
#pragma unroll
            for (int i = 0; i < 4; ++i) { y0[i] = cg0[i] * pg8::sigm(cg0[i]) * cv0[i]; y1[i] = cg1[i] * pg8::sigm(cg1[i]) * cv1[i]; }
            *(GAS unsigned long long*)(GB + (size_t)(pm * 256) * DFF + ch) = (unsigned long long)pkbf(y0[0], y0[1]) | ((unsigned long long)pkbf(y0[2], y0[3]) << 32);
            *(GAS unsigned long long*)(GB + (size_t)(pm * 256 + 1) * DFF + ch) = (unsigned long long)pkbf(y1[0], y1[1]) | ((unsigned long long)pkbf(y1[2], y1[3]) << 32);
        }
        if (BOTH(9)) GRID_BAR();
    }
    if (IN(10)) {
        unsigned char* const ws = KARG_WS(); float* const out = KARG_OUT(); bf16* const GB = (bf16*)(ws + WS_G); bf16* const Wdn_t = (bf16*)(ws + WS_WDN);
        pg8::Gemm g{GB, Wdn_t, M, DM, DFF}; Order4 S; S.init(M, DM, F.G, (int)blockIdx.x);
        pg8::EpiResidH<true> E{(const void*)out, (bf16*)(ws + WS_H1B)};
        pg8::gemm_phase<pg8::EpiResidH<true>, Order4, true, true>(F.lds + RING_OFF, g, S, E);
        if (BOTH(10)) GRID_BAR();
    }
    if (IN(11)) {
        const int lane = lane_id();
        float* const out = KARG_OUT();
        const bool poison = (!MK_PER_PHASE) && (__hip_atomic_load((gu32*)((unsigned*)(F.ctl + CW_BAR) + XB_TMO), RLX_AGENT) != 0u);
        const float* const g2 = KARG_F(16); const float* const b2 = KARG_F(17);
        bf16* const pre2 = (bf16*)(KARG_WS() + WS_H1B);
        for (int t = gw; t < M; t += NGW) ln_row_h<true>(pre2 + (size_t)t * DM, g2, b2, out + (size_t)t * DM, lane, poison);
    }
#undef IN
#undef BOTH
}

extern "C" void kernel_launch(void* const* d_in, const int* in_sizes, int n_in, void* d_out, int out_size, void* d_ws, size_t ws_size, hipStream_t stream) {
    static int grid = 0;
    if (grid == 0) {
        if (n_in != 18 || in_sizes[0] != M * DM || out_size != M * DM || ws_size < WS_END) { fprintf(stderr, "kernel_launch: unexpected shapes (n_in %d, in0 %d, out %d, ws %zu < %zu)\n", n_in, n_in > 0 ? in_sizes[0] : -1, out_size, ws_size, (size_t)WS_END); grid = -1; return; }
        int dev = 0, cus = 0, per_cu = 0;
        if (hipGetDevice(&dev) != hipSuccess || hipDeviceGetAttribute(&cus, hipDeviceAttributeMultiprocessorCount, dev) != hipSuccess) { grid = -1; return; }
        if (hipFuncSetAttribute((const void*)fwd, hipFuncAttributeMaxDynamicSharedMemorySize, LDS_BYTES) != hipSuccess) { fprintf(stderr, "kernel_launch: hipFuncSetAttribute failed\n"); grid = -1; return; }
        if (hipOccupancyMaxActiveBlocksPerMultiprocessor(&per_cu, (const void*)fwd, NWAVES * 64, LDS_BYTES) != hipSuccess || per_cu < 1) { fprintf(stderr, "kernel_launch: occupancy query reports %d\n", per_cu); }
        (void)hipGetLastError();
        grid = cus;
    }
    if (grid < 0) return;
    if (hipMemsetAsync((char*)d_ws + WS_CTL, 0, CTL_ZERO_BYTES, stream) != hipSuccess) return;
    Args a{};
    for (int i = 0; i < 18; ++i) a.in[i] = (const float*)d_in[i];
    a.out = (float*)d_out; a.ws = (unsigned char*)d_ws;
#if MK_PER_PHASE
    for (int p = 0; p < NPH; ++p) { a.ph_lo = p; a.ph_hi = p + 1; a.li = p; hipLaunchKernelGGL(fwd, dim3(grid), dim3(NWAVES * 64), LDS_BYTES, stream, a); }
#else
    a.ph_lo = 0; a.ph_hi = NPH; a.li = 0;
    hipLaunchKernelGGL(fwd, dim3(grid), dim3(NWAVES * 64), LDS_BYTES, stream, a);
#endif
}
```

```cpp
#include <hip/hip_runtime.h>
#include <hip/hip_bf16.h>
#include <cstdio>
#include <cstdint>
namespace pg8 {
#define PG8_LAS __attribute__((address_space(3)))
typedef unsigned short bf16_t;
typedef short bf16x8 __attribute__((ext_vector_type(8)));
typedef float f32x4 __attribute__((ext_vector_type(4)));
typedef unsigned u32x4 __attribute__((ext_vector_type(4)));
constexpr int BM = 256, BK = 64, HALF = 128, HTB = HALF * BK * 2  , STAGE_BYTES = 8 * HTB, NXCD = 8, WGM = 8;

__host__ __device__ __forceinline__ int lds_byte(int r, int c) { const int st = (r >> 4) * 2 + (c >> 5), rr = r & 15, cc = c & 31, ob = rr * 64 + cc * 2; return st * 1024 + (ob ^ (((ob >> 9) & 1) << 5)); }
__host__ __device__ __forceinline__ void stage_rc(int b, int& R, int& C) { const int st = b / 1024, sb = b % 1024, swz = sb ^ (((sb >> 9) & 1) << 5); R = (st >> 1) * 16 + swz / 64; C = (st & 1) * 32 + (swz % 64) / 2; }
__host__ __device__ __forceinline__ int perm32(int rho) { const int n = rho >> 4, i = rho & 15; return 8 * (i >> 2) + 4 * n + (i & 3); }

struct Unit { int pm, pn; };
struct Gemm { const bf16_t* A; const bf16_t* Bt; int M, N, K; };

struct StaticOrder {
    int nM, nN, nwg, G, c;
    __host__ __device__ void init(int M, int N, int G_, int c_) { nM = M / BM; nN = N / BM; nwg = nM * nN; G = G_; c = c_; }
    __host__ __device__ bool next(int i, Unit& u) const {
        const long L = (long)i * G + c; if (L >= nwg) return false;
        int wgid = (int)L; { const int q = nwg / NXCD, r = nwg % NXCD, xcd = wgid % NXCD, off = wgid / NXCD; wgid = (xcd < r ? xcd * (q + 1) : r * (q + 1) + (xcd - r) * q) + off; }
        const int nig = WGM * nN, gid = wgid / nig, fm = gid * WGM, gsz = (nM - fm) < WGM ? (nM - fm) : WGM;
        u.pm = fm + ((wgid % nig) % gsz); u.pn = (wgid % nig) / gsz; return true;
    }
    __device__ __forceinline__ void a_ready(const Unit&) const {}
    __device__ __forceinline__ void done(const Unit&) const {}
};

__device__ __forceinline__ unsigned cvt_pk_bf16(float lo, float hi) { unsigned r; asm volatile("v_cvt_pk_bf16_f32 %0, %1, %2" : "=v"(r) : "v"(lo), "v"(hi)); return r; }
typedef float f32x2 __attribute__((ext_vector_type(2)));
typedef unsigned u32x2 __attribute__((ext_vector_type(2)));
__device__ __forceinline__ float sigm(float v) { return __builtin_amdgcn_rcpf(1.0f + __builtin_amdgcn_exp2f(-1.4426950408889634f * v)); }
__device__ __forceinline__ float bflo(unsigned w) { return __uint_as_float(w << 16); }
__device__ __forceinline__ float bfhi(unsigned w) { return __uint_as_float(w & 0xffff0000u); }
struct EpiProj {
    static constexpr bool PERM = true, AFTER_DRAIN = false;
    bf16_t* O; int ldc; int sig_from; int gc_at;
    __device__ __forceinline__ void operator()(const f32x4 (&acc)[2][2][4][2], const Unit& u, int wr, int wc, int fr, int fq) const {
        const int row0 = u.pm * BM + wr * 64 + fr, col0 = u.pn * BM + wc * 32 + 8 * fq; const bool sg = (u.pn * BM) >= sig_from;
        if (sg) {
            const int ch = ((u.pn * BM - sig_from) >> 1) + wc * 32 + 8 * fq;
#pragma unroll
            for (int ai = 0; ai < 2; ++ai)
#pragma unroll
                for (int m = 0; m < 4; ++m) { bf16_t* rowp = O + (size_t)(row0 + ai * HALF + m * 16) * ldc + ch; float r[8], s[8];
#pragma unroll
                    for (int n = 0; n < 2; ++n)
#pragma unroll
                        for (int i = 0; i < 4; ++i) { const float ea = __builtin_amdgcn_exp2f(-1.4426950408889634f * acc[ai][0][m][n][i]), ec1 = 1.0f + __builtin_amdgcn_exp2f(-1.4426950408889634f * acc[ai][1][m][n][i]);
                            s[4 * n + i] = __builtin_amdgcn_rcpf(ec1); r[4 * n + i] = ec1 * __builtin_amdgcn_rcpf(1.0f + ea); }
                    u32x4 w; w.x = cvt_pk_bf16(r[0], r[1]); w.y = cvt_pk_bf16(r[2], r[3]); w.z = cvt_pk_bf16(r[4], r[5]); w.w = cvt_pk_bf16(r[6], r[7]);
                    *(u32x4*)(rowp + sig_from) = w;
                    w.x = cvt_pk_bf16(s[0], s[1]); w.y = cvt_pk_bf16(s[2], s[3]); w.z = cvt_pk_bf16(s[4], s[5]); w.w = cvt_pk_bf16(s[6], s[7]);
                    *(u32x4*)(rowp + gc_at) = w; }
            return; }
#pragma unroll
        for (int ai = 0; ai < 2; ++ai)
#pragma unroll
            for (int m = 0; m < 4; ++m) { bf16_t* rowp = O + (size_t)(row0 + ai * HALF + m * 16) * ldc + col0;
#pragma unroll
                for (int bj = 0; bj < 2; ++bj) { const f32x4 v0 = acc[ai][bj][m][0], v1 = acc[ai][bj][m][1];
                    u32x4 w; w.x = cvt_pk_bf16(v0[0], v0[1]); w.y = cvt_pk_bf16(v0[2], v0[3]); w.z = cvt_pk_bf16(v1[0], v1[1]); w.w = cvt_pk_bf16(v1[2], v1[3]);
                    *(u32x4*)(rowp + bj * HALF) = w; } }
    }
};
struct EpiPlain {
    static constexpr bool PERM = true, AFTER_DRAIN = false;
    bf16_t* O; int ldc;
    __device__ __forceinline__ void operator()(const f32x4 (&acc)[2][2][4][2], const Unit& u, int wr, int wc, int fr, int fq) const {
        const int row0 = u.pm * BM + wr * 64 + fr, col0 = u.pn * BM + wc * 32 + 8 * fq;
#pragma unroll
        for (int ai = 0; ai < 2; ++ai)
#pragma unroll
            for (int m = 0; m < 4; ++m) { bf16_t* rowp = O + (size_t)(row0 + ai * HALF + m * 16) * ldc + col0;
#pragma unroll
                for (int bj = 0; bj < 2; ++bj) { const f32x4 v0 = acc[ai][bj][m][0], v1 = acc[ai][bj][m][1];
                    u32x4 w; w.x = cvt_pk_bf16(v0[0], v0[1]); w.y = cvt_pk_bf16(v0[2], v0[3]); w.z = cvt_pk_bf16(v1[0], v1[1]); w.w = cvt_pk_bf16(v1[2], v1[3]);
                    *(u32x4*)(rowp + bj * HALF) = w; } }
    }
};
struct EpiGateA {
    static constexpr bool PERM = false, AFTER_DRAIN = false;
    float* P; int ldc; const bf16_t* gate; int ldg;
    __device__ __forceinline__ void operator()(const f32x4 (&acc)[2][2][4][2], const Unit& u, int wr, int wc, int fr, int fq) const {
        const int row0 = u.pm * BM + wr * 64 + fr, col0 = u.pn * BM + wc * 32 + 4 * fq;
#pragma unroll
        for (int ai = 0; ai < 2; ++ai)
#pragma unroll
            for (int m = 0; m < 4; ++m) { const size_t row = (size_t)(row0 + ai * HALF + m * 16);
#pragma unroll
                for (int bj = 0; bj < 2; ++bj)
#pragma unroll
                    for (int n = 0; n < 2; ++n) { const int col = col0 + bj * HALF + n * 16;
                        const u32x2 gw = *(const u32x2*)(gate + row * ldg + col); const f32x4 a = acc[ai][bj][m][n];
                        *(f32x4*)(P + row * ldc + col) = (f32x4){a[0] * bflo(gw.x), a[1] * bfhi(gw.x), a[2] * bflo(gw.y), a[3] * bfhi(gw.y)}; }
                if (m & 1) asm volatile("" ::: "memory"); }
    }
};
struct EpiGateC {
    static constexpr bool PERM = true, AFTER_DRAIN = false;
    const float* P; bf16_t* O; int ldc; const bf16_t* gate; int ldg;
    __device__ __forceinline__ void operator()(const f32x4 (&acc)[2][2][4][2], const Unit& u, int wr, int wc, int fr, int fq) const {
        const int row0 = u.pm * BM + wr * 64 + fr, col0 = u.pn * BM + wc * 32 + 8 * fq;
#pragma unroll
        for (int ai = 0; ai < 2; ++ai)
#pragma unroll
            for (int m = 0; m < 4; ++m) { const size_t row = (size_t)(row0 + ai * HALF + m * 16);
#pragma unroll
                for (int bj = 0; bj < 2; ++bj) { const int col = col0 + bj * HALF;
                    const u32x4 gw = *(const u32x4*)(gate + row * ldg + col); const f32x4 p0 = *(const f32x4*)(P + row * ldc + col), p1 = *(const f32x4*)(P + row * ldc + col + 4);
                    const f32x4 a0 = acc[ai][bj][m][0], a1 = acc[ai][bj][m][1];
                    const float r0 = p0[0] + a0[0] * bflo(gw.x), r1 = p0[1] + a0[1] * bfhi(gw.x), r2 = p0[2] + a0[2] * bflo(gw.y), r3 = p0[3] + a0[3] * bfhi(gw.y);
                    const float r4 = p1[0] + a1[0] * bflo(gw.z), r5 = p1[1] + a1[1] * bfhi(gw.z), r6 = p1[2] + a1[2] * bflo(gw.w), r7 = p1[3] + a1[3] * bfhi(gw.w);
                    u32x4 w; w.x = cvt_pk_bf16(r0, r1); w.y = cvt_pk_bf16(r2, r3); w.z = cvt_pk_bf16(r4, r5); w.w = cvt_pk_bf16(r6, r7);
                    *(u32x4*)(O + row * ldc + col) = w; }
                if (m & 1) asm volatile("" ::: "memory"); }
    }
};
struct EpiResid {
    static constexpr bool PERM = false, AFTER_DRAIN = false;
    const float* base; float* out; int ldc; float alpha;
    __device__ __forceinline__ void operator()(const f32x4 (&acc)[2][2][4][2], const Unit& u, int wr, int wc, int fr, int fq) const {
        const int row0 = u.pm * BM + wr * 64 + fr, col0 = u.pn * BM + wc * 32 + 4 * fq;
#pragma unroll
        for (int ai = 0; ai < 2; ++ai)
#pragma unroll
            for (int m = 0; m < 4; ++m) { const size_t off = (size_t)(row0 + ai * HALF + m * 16) * ldc + col0;
#pragma unroll
                for (int bj = 0; bj < 2; ++bj)
#pragma unroll
                    for (int n = 0; n < 2; ++n) { const f32x4 b = *(const f32x4*)(base + off + bj * HALF + n * 16);
                        *(f32x4*)(out + off + bj * HALF + n * 16) = b * alpha + acc[ai][bj][m][n]; }
                if (m & 1) asm volatile("" ::: "memory"); }
    }
};

struct EpiGateMerge {
    static constexpr bool PERM = true, AFTER_DRAIN = false;
    bf16_t* O; int ldc; const bf16_t* ga; const bf16_t* gc; int ldg;
    __device__ __forceinline__ void mid(f32x4 (&acc)[2][2][4][2], const Unit& u, int wr, int wc, int fr, int fq) const {
        int row0 = u.pm * BM + wr * 64 + fr, col0 = u.pn * BM + wc * 32 + 8 * fq;
        asm volatile("" : "+v"(row0), "+v"(col0));
#pragma unroll
        for (int ai = 0; ai < 2; ++ai) { u32x4 av[4][2];
#pragma unroll
            for (int m = 0; m < 4; ++m)
#pragma unroll
                for (int bj = 0; bj < 2; ++bj) av[m][bj] = *(const u32x4*)(ga + (size_t)(row0 + ai * HALF + m * 16) * ldg + col0 + bj * HALF);
            asm volatile("" ::: "memory");
#pragma unroll
            for (int m = 0; m < 4; ++m)
#pragma unroll
                for (int bj = 0; bj < 2; ++bj) { const u32x4 a = av[m][bj]; f32x4& v0 = acc[ai][bj][m][0]; f32x4& v1 = acc[ai][bj][m][1];
                    v0[0] *= bflo(a.x); v0[1] *= bfhi(a.x); v0[2] *= bflo(a.y); v0[3] *= bfhi(a.y); v1[0] *= bflo(a.z); v1[1] *= bfhi(a.z); v1[2] *= bflo(a.w); v1[3] *= bfhi(a.w); }
            asm volatile("" ::: "memory"); }
    }
    __device__ __forceinline__ void operator()(const f32x4 (&acc)[2][2][4][2], const Unit& u, int wr, int wc, int fr, int fq) const {
        const int row0 = u.pm * BM + wr * 64 + fr, col0 = u.pn * BM + wc * 32 + 8 * fq;
        u32x4 cv[2][4][2];
#pragma unroll
        for (int ai = 0; ai < 2; ++ai)
#pragma unroll
            for (int m = 0; m < 4; ++m)
#pragma unroll
                for (int bj = 0; bj < 2; ++bj) cv[ai][m][bj] = *(const u32x4*)(gc + (size_t)(row0 + ai * HALF + m * 16) * ldg + col0 + bj * HALF);
        asm volatile("" ::: "memory");
#pragma unroll
        for (int ai = 0; ai < 2; ++ai)
#pragma unroll
            for (int m = 0; m < 4; ++m)
#pragma unroll
                for (int bj = 0; bj < 2; ++bj) { const u32x4 c = cv[ai][m][bj]; const f32x4 a0 = acc[ai][bj][m][0], a1 = acc[ai][bj][m][1];
                    u32x4 w; w.x = cvt_pk_bf16(a0[0] * bflo(c.x), a0[1] * bfhi(c.x)); w.y = cvt_pk_bf16(a0[2] * bflo(c.y), a0[3] * bfhi(c.y));
                    w.z = cvt_pk_bf16(a1[0] * bflo(c.z), a1[1] * bfhi(c.z)); w.w = cvt_pk_bf16(a1[2] * bflo(c.w), a1[3] * bfhi(c.w));
                    *(u32x4*)(O + (size_t)(row0 + ai * HALF + m * 16) * ldc + col0 + bj * HALF) = w; }
    }
};

typedef _Float16 h16x2 __attribute__((ext_vector_type(2)));
__device__ __forceinline__ unsigned pk_h2(float lo, float hi) { const h16x2 v = {(_Float16)lo, (_Float16)hi}; return __builtin_bit_cast(unsigned, v); }
__device__ __forceinline__ float h_lo(unsigned w) { return (float)__builtin_bit_cast(h16x2, w)[0]; }
__device__ __forceinline__ float h_hi(unsigned w) { return (float)__builtin_bit_cast(h16x2, w)[1]; }
template <bool BH> struct EpiResidH {
    static constexpr bool PERM = true, AFTER_DRAIN = false;
    const void* base; bf16_t* O;
    static constexpr int ldc = 4096; static constexpr float alpha = 1.189207115002721f;
    __device__ __forceinline__ void operator()(const f32x4 (&acc)[2][2][4][2], const Unit& u, int wr, int wc, int fr, int fq) const {
        const int row0 = u.pm * BM + wr * 64 + fr, col0 = u.pn * BM + wc * 32 + 8 * fq;
#pragma unroll
        for (int ai = 0; ai < 2; ++ai) {
            u32x4 hw[4][2]; f32x4 fw[4][2][2];
#pragma unroll
            for (int m = 0; m < 4; ++m)
#pragma unroll
                for (int bj = 0; bj < 2; ++bj) { const size_t off = (size_t)(row0 + ai * HALF + m * 16) * ldc + col0 + bj * HALF;
                    if constexpr (BH) hw[m][bj] = *(const u32x4*)((const bf16_t*)base + off);
                    else { fw[m][bj][0] = *(const f32x4*)((const float*)base + off); fw[m][bj][1] = *(const f32x4*)((const float*)base + off + 4); } }
            asm volatile("" ::: "memory");
#pragma unroll
            for (int m = 0; m < 4; ++m)
#pragma unroll
                for (int bj = 0; bj < 2; ++bj) { const size_t off = (size_t)(row0 + ai * HALF + m * 16) * ldc + col0 + bj * HALF; f32x4 b0, b1;
                    if constexpr (BH) { const u32x4 h = hw[m][bj]; b0 = (f32x4){h_lo(h.x), h_hi(h.x), h_lo(h.y), h_hi(h.y)}; b1 = (f32x4){h_lo(h.z), h_hi(h.z), h_lo(h.w), h_hi(h.w)}; }
                    else { b0 = fw[m][bj][0]; b1 = fw[m][bj][1]; }
                    const f32x4 v0 = b0 * alpha + acc[ai][bj][m][0], v1 = b1 * alpha + acc[ai][bj][m][1];
                    u32x4 w; w.x = pk_h2(v0[0], v0[1]); w.y = pk_h2(v0[2], v0[3]); w.z = pk_h2(v1[0], v1[1]); w.w = pk_h2(v1[2], v1[3]);
                    *(u32x4*)(O + off) = w; }
            asm volatile("" ::: "memory"); }
    }
};

template <int CTRL> __device__ __forceinline__ float dppf(float old, float src) { return __int_as_float(__builtin_amdgcn_update_dpp(__float_as_int(old), __float_as_int(src), CTRL, 0xf, 0xf, false)); }
#define PG8_CONV2(c0, c1, x0, x1, p0, p1, wc0, wc1, wb0, wb1, wbz0, wbz1, wa0, wa1, waz0, waz1) \
    asm volatile("v_mul_f32 %0, %6, %2\n\tv_mul_f32 %1, %7, %3\n\t" \
                 "v_fmac_f32_dpp %0, %2, %8 row_shr:1 row_mask:0xf bank_mask:0xf\n\tv_fmac_f32_dpp %1, %3, %9 row_shr:1 row_mask:0xf bank_mask:0xf\n\t" \
                 "v_fmac_f32_dpp %0, %4, %10 row_ror:1 row_mask:0xf bank_mask:0xf\n\tv_fmac_f32_dpp %1, %5, %11 row_ror:1 row_mask:0xf bank_mask:0xf\n\t" \
                 "v_fmac_f32_dpp %0, %2, %12 row_shr:2 row_mask:0xf bank_mask:0xf\n\tv_fmac_f32_dpp %1, %3, %13 row_shr:2 row_mask:0xf bank_mask:0xf\n\t" \
                 "v_fmac_f32_dpp %0, %4, %14 row_ror:2 row_mask:0xf bank_mask:0xf\n\tv_fmac_f32_dpp %1, %5, %15 row_ror:2 row_mask:0xf bank_mask:0xf" \
                 : "=&v"(c0), "=&v"(c1) : "v"(x0), "v"(x1), "v"(p0), "v"(p1), "v"(wc0), "v"(wc1), "v"(wb0), "v"(wb1), "v"(wbz0), "v"(wbz1), "v"(wa0), "v"(wa1), "v"(waz0), "v"(waz1))
struct EpiConvSilu {
    static constexpr bool PERM = true, AFTER_DRAIN = false;
    bf16_t* G; int ldg; const float* cw; int nup, dff; float* halo; int nN; PG8_LAS float* H;
    __device__ __forceinline__ void operator()(const f32x4 (&acc)[2][2][4][2], const Unit& u, int wr, int wc, int fr, int fq) const {
        const int lc = wc * 32 + 8 * fq, ch = u.pn * 128 + lc;
#pragma unroll
        for (int ai = 0; ai < 2; ++ai) { const int blk = 2 * ai + wr;
            if (fr >= 14) {
#pragma unroll
                for (int bj = 0; bj < 2; ++bj)
#pragma unroll
                    for (int n = 0; n < 2; ++n) *(PG8_LAS f32x4*)(H + (blk * 2 + (fr - 14)) * 256 + bj * 128 + lc + 4 * n) = acc[ai][bj][3][n]; } }
        float* hg = halo + ((size_t)u.pm * nN + u.pn) * 1024;
        if (wr == 0 && fr < 2) {
#pragma unroll
            for (int bj = 0; bj < 2; ++bj)
#pragma unroll
                for (int n = 0; n < 2; ++n) *(f32x4*)(hg + fr * 256 + bj * 128 + lc + 4 * n) = acc[0][bj][0][n]; }
        if (wr == 1 && fr >= 14) {
#pragma unroll
            for (int bj = 0; bj < 2; ++bj)
#pragma unroll
                for (int n = 0; n < 2; ++n) *(f32x4*)(hg + (2 + fr - 14) * 256 + bj * 128 + lc + 4 * n) = acc[1][bj][3][n]; }
        asm volatile("s_waitcnt lgkmcnt(0)" ::: "memory"); __builtin_amdgcn_s_barrier(); asm volatile("" ::: "memory");
        f32x4 sg[2][4][2];
#pragma unroll
        for (int bj = 0; bj < 2; ++bj) {
            f32x4 wgt[3][2], wbz[2], waz[2];
#pragma unroll
            for (int k = 0; k < 3; ++k)
#pragma unroll
                for (int n = 0; n < 2; ++n) wgt[k][n] = *(const f32x4*)(cw + (size_t)k * nup + bj * dff + ch + 4 * n);
#pragma unroll
            for (int n = 0; n < 2; ++n)
#pragma unroll
                for (int i = 0; i < 4; ++i) { wbz[n][i] = fr == 0 ? wgt[1][n][i] : 0.f; waz[n][i] = fr < 2 ? wgt[0][n][i] : 0.f; }
#pragma unroll
            for (int ai = 0; ai < 2; ++ai) { const int blk = 2 * ai + wr;
                f32x4 pv[2];
#pragma unroll
                for (int n = 0; n < 2; ++n) { pv[n] = (f32x4){0.f, 0.f, 0.f, 0.f};
                    if (blk >= 1 && fr >= 14) pv[n] = *(const PG8_LAS f32x4*)(H + ((blk - 1) * 2 + (fr - 14)) * 256 + bj * 128 + lc + 4 * n); }
#pragma unroll
                for (int mm = 0; mm < 4; ++mm) { const int m = 3 - mm; f32x4 c[2];
#pragma unroll
                    for (int n = 0; n < 2; ++n) { const f32x4 cur = acc[ai][bj][m][n]; const f32x4 prv = (m == 0) ? pv[n] : acc[ai][bj][m == 0 ? 0 : m - 1][n];
#pragma unroll
                        for (int i = 0; i < 4; i += 2) { float c0, c1;
                            PG8_CONV2(c0, c1, cur[i], cur[i + 1], prv[i], prv[i + 1], wgt[2][n][i], wgt[2][n][i + 1], wgt[1][n][i], wgt[1][n][i + 1], wbz[n][i], wbz[n][i + 1],
                                      wgt[0][n][i], wgt[0][n][i + 1], waz[n][i], waz[n][i + 1]);
                            c[n][i] = c0; c[n][i + 1] = c1; } }
                    if (bj == 0) {
#pragma unroll
                        for (int n = 0; n < 2; ++n)
#pragma unroll
                            for (int i = 0; i < 4; ++i) sg[ai][m][n][i] = c[n][i] * sigm(c[n][i]);
                    } else {
                        float y[8];
#pragma unroll
                        for (int n = 0; n < 2; ++n)
#pragma unroll
                            for (int i = 0; i < 4; ++i) y[4 * n + i] = sg[ai][m][n][i] * c[n][i];
                        u32x4 w; w.x = cvt_pk_bf16(y[0], y[1]); w.y = cvt_pk_bf16(y[2], y[3]); w.z = cvt_pk_bf16(y[4], y[5]); w.w = cvt_pk_bf16(y[6], y[7]);
                        *(u32x4*)(G + (size_t)(u.pm * BM + ai * HALF + wr * 64 + m * 16 + fr) * ldg + ch) = w; } } } }
    }
};
typedef _Float16 f16x8 __attribute__((ext_vector_type(8)));
template <bool F16> __device__ __forceinline__ f32x4 mma16(bf16x8 a, bf16x8 b, f32x4 c) {
    if constexpr (F16) return __builtin_amdgcn_mfma_f32_16x16x32_f16(__builtin_bit_cast(f16x8, a), __builtin_bit_cast(f16x8, b), c, 0, 0, 0);
    else return __builtin_amdgcn_mfma_f32_16x16x32_bf16(a, b, c, 0, 0, 0); }
template <class Epi, class Sched, bool ALIGN_EPI = false, bool SP2 = false, bool MID = false, bool F16 = false>
__device__ __forceinline__ void gemm_phase(PG8_LAS unsigned char* lds, const Gemm g, const Sched& S, const Epi& E) {
    int tid_ = threadIdx.x; asm volatile("" : "+v"(tid_));
    const int tid = tid_, wid = __builtin_amdgcn_readfirstlane(tid >> 6), lane = tid & 63, wr = wid >> 2, wc = wid & 3, fr = lane & 15, fq = lane >> 4;
    const int K = g.K, nt = K / BK;
    unsigned voffA[2], voffB[2];
#pragma unroll
    for (int i = 0; i < 2; ++i) { int R, C; stage_rc(tid * 16 + i * 8192, R, C); const int Rb = Epi::PERM ? ((R & ~31) + perm32(R & 31)) : R;
        voffA[i] = (unsigned)(R * K + C) * 2u; voffB[i] = (unsigned)(Rb * K + C) * 2u; }
    const size_t kstep = (size_t)(BK * 2);
    const size_t hstep = (size_t)HALF * K * 2;
    const size_t tstep = 2 * hstep;
    const unsigned ldsw = (unsigned)wid * 1024u;
    const int aoff = lds_byte(wr * 64 + fr, fq * 8), boff = lds_byte(wc * 32 + fr, fq * 8);
#define PG8_SA(b, h) (((b) * 2 + (h)) * HTB)
#define PG8_SB(b, h) ((4 + (b) * 2 + (h)) * HTB)
#define PG8_STAGE(bufoff, gbase, voff) do { _Pragma("unroll") for (int _i = 0; _i < 2; ++_i) \
        __builtin_amdgcn_global_load_lds((const unsigned*)((const char*)(gbase) + (voff)[_i]), (PG8_LAS unsigned*)(lds + (bufoff) + ldsw + _i * 8192), 16, 0, 0); } while (0)
#define PG8_LDA(dst, b, h) do { _Pragma("unroll") for (int m = 0; m < 4; ++m) _Pragma("unroll") for (int k = 0; k < 2; ++k) dst[m][k] = *(const PG8_LAS bf16x8*)(lds + PG8_SA(b, h) + aoff + m * 2048 + k * 1024); } while (0)
#define PG8_LDB(dst, b, h) do { _Pragma("unroll") for (int n = 0; n < 2; ++n) _Pragma("unroll") for (int k = 0; k < 2; ++k) dst[n][k] = *(const PG8_LAS bf16x8*)(lds + PG8_SB(b, h) + boff + n * 2048 + k * 1024); } while (0)
#define PG8_MMA(ai, bj, At, Bt) do { __builtin_amdgcn_s_setprio(1); _Pragma("unroll") for (int m = 0; m < 4; ++m) _Pragma("unroll") for (int n = 0; n < 2; ++n) _Pragma("unroll") for (int k = 0; k < 2; ++k) \
        acc[ai][bj][m][n] = mma16<F16>(Bt[n][k], At[m][k], acc[ai][bj][m][n]); __builtin_amdgcn_s_setprio(0); } while (0)
#define PG8_WAIT_V(n) asm volatile("s_waitcnt vmcnt(" #n ")" ::: "memory")
#define PG8_WAIT_L(n) asm volatile("s_waitcnt lgkmcnt(" #n ")" ::: "memory")
#define PG8_BAR __builtin_amdgcn_s_barrier()
#define PG8_SCHED __builtin_amdgcn_sched_barrier(0)
    Unit cur, nxt; int ui = 0;
    if (!S.next(0, cur)) return;
    f32x4 acc[2][2][4][2];
#pragma unroll
    for (int a = 0; a < 2; ++a)
#pragma unroll
        for (int b = 0; b < 2; ++b)
#pragma unroll
            for (int m = 0; m < 4; ++m)
#pragma unroll
                for (int n = 0; n < 2; ++n) acc[a][b][m][n] = (f32x4){0.f, 0.f, 0.f, 0.f};
    bf16x8 At[4][2], B0[2][2], B1[2][2];
    const char* cA = (const char*)g.A + (size_t)cur.pm * tstep; const char* cB = (const char*)g.Bt + (size_t)cur.pn * tstep;
    S.a_ready(cur);
    if constexpr (SP2) {
        PG8_STAGE(PG8_SB(0, 0), cB, voffB); PG8_STAGE(PG8_SB(0, 1), cB + hstep, voffB); PG8_STAGE(PG8_SA(0, 0), cA, voffA); PG8_STAGE(PG8_SA(0, 1), cA + hstep, voffA);
        if (wr == 1) PG8_BAR;
        PG8_WAIT_V(2); PG8_BAR;
        PG8_STAGE(PG8_SB(1, 0), cB + kstep, voffB); PG8_STAGE(PG8_SA(1, 0), cA + kstep, voffA); PG8_STAGE(PG8_SB(1, 1), cB + hstep + kstep, voffB);
        PG8_WAIT_V(6); PG8_BAR;
    } else {
        PG8_STAGE(PG8_SB(0, 0), cB, voffB); PG8_STAGE(PG8_SA(0, 0), cA, voffA); PG8_STAGE(PG8_SB(0, 1), cB + hstep, voffB); PG8_STAGE(PG8_SA(0, 1), cA + hstep, voffA);
        if (wr == 1) PG8_BAR;
        PG8_WAIT_V(4); PG8_BAR;
        PG8_STAGE(PG8_SB(1, 0), cB + kstep, voffB); PG8_STAGE(PG8_SA(1, 0), cA + kstep, voffA); PG8_STAGE(PG8_SB(1, 1), cB + hstep + kstep, voffB);
        PG8_WAIT_V(6); PG8_BAR;
    }
    for (;;) {
        const bool has_next = S.next(ui + 1, nxt);
        const char* nA = has_next ? (const char*)g.A + (size_t)nxt.pm * tstep : cA; const char* nB = has_next ? (const char*)g.Bt + (size_t)nxt.pn * tstep : cB;
        for (int t = 0; t < nt; t += 2) {
            if constexpr (MID) { if (t == (nt >> 1)) E.mid(acc, cur, wr, wc, fr, fq); }
            const bool last = (t == nt - 2);
            const char* a1 = cA + (size_t)(t + 1) * kstep;
            const char* a2 = last ? nA : cA + (size_t)(t + 2) * kstep; const char* b2 = last ? nB : cB + (size_t)(t + 2) * kstep;
            const char* a3 = a2 + kstep; const char* b3 = b2 + kstep;
            if (last && has_next) S.a_ready(nxt);
            if constexpr (SP2) {
            PG8_LDB(B0, 0, 0); PG8_LDB(B1, 0, 1); PG8_SCHED; PG8_LDA(At, 0, 0); PG8_STAGE(PG8_SA(1, 1), a1 + hstep, voffA);
            PG8_WAIT_V(8); PG8_WAIT_L(0); PG8_BAR; PG8_MMA(0, 0, At, B0); PG8_MMA(0, 1, At, B1); PG8_BAR; PG8_SCHED;
            PG8_LDA(At, 0, 1); PG8_STAGE(PG8_SB(0, 0), b2, voffB); PG8_STAGE(PG8_SB(0, 1), b2 + hstep, voffB); PG8_STAGE(PG8_SA(0, 0), a2, voffA);
            PG8_WAIT_V(8); PG8_WAIT_L(0); PG8_BAR; PG8_MMA(1, 0, At, B0); PG8_MMA(1, 1, At, B1); PG8_BAR; PG8_SCHED;
            PG8_LDB(B0, 1, 0); PG8_LDB(B1, 1, 1); PG8_SCHED; PG8_LDA(At, 1, 0); PG8_STAGE(PG8_SA(0, 1), a2 + hstep, voffA);
            PG8_WAIT_V(8); PG8_WAIT_L(0); PG8_BAR; PG8_MMA(0, 0, At, B0); PG8_MMA(0, 1, At, B1); PG8_BAR; PG8_SCHED;
            PG8_LDA(At, 1, 1); PG8_STAGE(PG8_SB(1, 0), b3, voffB); PG8_STAGE(PG8_SB(1, 1), b3 + hstep, voffB); PG8_STAGE(PG8_SA(1, 0), a3, voffA);
            PG8_WAIT_V(8); PG8_WAIT_L(0); PG8_BAR; PG8_MMA(1, 0, At, B0); PG8_MMA(1, 1, At, B1); PG8_BAR; PG8_SCHED;
            } else {
            PG8_LDB(B0, 0, 0); PG8_SCHED; PG8_LDA(At, 0, 0); PG8_STAGE(PG8_SA(1, 1), a1 + hstep, voffA);
            PG8_WAIT_L(8); PG8_BAR; PG8_WAIT_L(0); PG8_MMA(0, 0, At, B0); PG8_BAR; PG8_SCHED;
            PG8_LDB(B1, 0, 1); PG8_STAGE(PG8_SB(0, 0), b2, voffB);
            PG8_BAR; PG8_WAIT_L(0); PG8_MMA(0, 1, At, B1); PG8_BAR;
            PG8_LDA(At, 0, 1); PG8_STAGE(PG8_SA(0, 0), a2, voffA);
            PG8_BAR; PG8_WAIT_L(0); PG8_MMA(1, 0, At, B0); PG8_BAR; PG8_SCHED;
            PG8_STAGE(PG8_SB(0, 1), b2 + hstep, voffB);
            PG8_WAIT_V(6); PG8_BAR; PG8_MMA(1, 1, At, B1); PG8_BAR;
            PG8_LDB(B0, 1, 0); PG8_SCHED; PG8_LDA(At, 1, 0); PG8_STAGE(PG8_SA(0, 1), a2 + hstep, voffA);
            PG8_WAIT_L(8); PG8_BAR; PG8_WAIT_L(0); PG8_MMA(0, 0, At, B0); PG8_BAR; PG8_SCHED;
            PG8_LDB(B1, 1, 1); PG8_STAGE(PG8_SB(1, 0), b3, voffB);
            PG8_BAR; PG8_WAIT_L(0); PG8_MMA(0, 1, At, B1); PG8_BAR;
            PG8_LDA(At, 1, 1); PG8_STAGE(PG8_SA(1, 0), a3, voffA);
            PG8_BAR; PG8_WAIT_L(0); PG8_MMA(1, 0, At, B0); PG8_BAR; PG8_SCHED;
            PG8_STAGE(PG8_SB(1, 1), b3 + hstep, voffB);
            PG8_WAIT_V(6); PG8_BAR; PG8_MMA(1, 1, At, B1); PG8_BAR;
            }
        }
        if constexpr (ALIGN_EPI) { if (wr == 0) PG8_BAR; }
        if constexpr (!Epi::AFTER_DRAIN) { E(acc, cur, wr, wc, fr, fq); S.done(cur); }
        if (!has_next) break;
#pragma unroll
        for (int a = 0; a < 2; ++a)
#pragma unroll
            for (int b = 0; b < 2; ++b)
#pragma unroll
                for (int m = 0; m < 4; ++m)
#pragma unroll
                    for (int n = 0; n < 2; ++n) acc[a][b][m][n] = (f32x4){0.f, 0.f, 0.f, 0.f};
        cur = nxt; cA = nA; cB = nB; ++ui;
        if constexpr (ALIGN_EPI) { if (wr == 1) PG8_BAR; }
    }
    PG8_WAIT_V(0);
    if constexpr (!ALIGN_EPI) { if (wr == 0) PG8_BAR; }
    PG8_BAR;
    if constexpr (Epi::AFTER_DRAIN) { E.fused(acc, cur, wr, wc, fr, fq, lds, wid, lane); S.done(cur); }
#undef PG8_SA
#undef PG8_SB
#undef PG8_STAGE
#undef PG8_LDA
#undef PG8_LDB
#undef PG8_MMA
#undef PG8_WAIT_V
#undef PG8_WAIT_L
#undef PG8_BAR
#undef PG8_SCHED
}
}
namespace swa {
constexpr int D = 128;
constexpr int LDP = 20480;
constexpr int LDO = 2048;
constexpr float THR = 8.f;
constexpr bool WSKIP = false;
constexpr float SCALE = 0.08838834764831845f;
constexpr int NW = 8, QBLK = 32, KVBLK = 64, QB = NW * QBLK;
constexpr int SHM_V = KVBLK * D * 2, SHM_K = KVBLK * D * 2;
constexpr int LDS_BYTES = 2 * SHM_V + 2 * SHM_K + NW * 64 * 4;
static_assert(D == 128, "geometry");

using bf16 = __hip_bfloat16;
typedef short bf16x8 __attribute__((ext_vector_type(8)));
typedef short s16x4 __attribute__((ext_vector_type(4)));
typedef float f32x16 __attribute__((ext_vector_type(16)));
typedef float f32x4 __attribute__((ext_vector_type(4)));
typedef unsigned u32x4 __attribute__((ext_vector_type(4)));
template <class A, class Bt> struct same_t { static constexpr bool v = false; };
template <class A> struct same_t<A, A> { static constexpr bool v = true; };

#define KSWZ(row, colB) ((row) * 256 + ((colB) ^ (((row) & 7) << 4)))
#define SBAR() __builtin_amdgcn_sched_barrier(0)
__device__ __forceinline__ int v_st(int k, int c) { const int kk = (k & ~0xC) | ((k & 4) << 1) | ((k & 8) >> 1); return ((kk >> 3) * 4 + (c >> 5)) * 512 + ((kk & 7) * 32 + (c & 31)) * 2; }
__device__ __forceinline__ int v_rd_base(int lane) { return ((lane & 3) << 3) | (((lane >> 2) & 3) << 6) | (((lane >> 4) & 1) << 5) | (((lane >> 5) & 1) << 8); }
constexpr int v_rd_off(int d0, int ks, int half) { return d0 * 512 + ks * 4096 + half * 2048; }
__device__ __forceinline__ int crow(int r, int hi) { return (r & 3) + 8 * (r >> 2) + 4 * hi; }
__device__ __forceinline__ unsigned cvtpk(float lo, float hi) {
    unsigned r; asm volatile("v_cvt_pk_bf16_f32 %0, %1, %2" : "=v"(r) : "v"(lo), "v"(hi)); return r;
}
__device__ __forceinline__ bf16x8 pack8(f32x4 a, f32x4 b) {
    u32x4 w = {cvtpk(a[0], a[1]), cvtpk(a[2], a[3]), cvtpk(b[0], b[1]), cvtpk(b[2], b[3])};
    return *reinterpret_cast<bf16x8*>(&w);
}
template <class T> __device__ __forceinline__ bf16x8 load8(const T* p) {
    if constexpr (same_t<T, float>::v) { return pack8(*(const f32x4*)p, *(const f32x4*)(p + 4)); }
    else { return *reinterpret_cast<const bf16x8*>(p); }
}
__device__ __forceinline__ void mask_tile(f32x16& p0, f32x16& p1, int dq, unsigned W) {
    const float NEG = -__builtin_inff();
#pragma unroll
    for (int r = 0; r < 16; ++r) {
        const int c = (r & 3) + 8 * (r >> 2);
        if ((unsigned)(dq - c) >= W) p0[r] = NEG;
        if ((unsigned)(dq - c - 32) >= W) p1[r] = NEG;
    }
}
__device__ __forceinline__ void partialSM(f32x16& p0, f32x16& p1, float& m_reg, float& mn, float& alpha) {
    float pmax = p0[0]; for (int r = 1; r < 16; ++r) pmax = fmaxf(pmax, p0[r]); for (int r = 0; r < 16; ++r) pmax = fmaxf(pmax, p1[r]);
    { auto rr = __builtin_amdgcn_permlane32_swap(__float_as_uint(pmax), __float_as_uint(pmax), false, false);
      pmax = fmaxf(__uint_as_float(rr[0]), __uint_as_float(rr[1])); }
    constexpr float C2 = 1.4426950408889634f * SCALE;
    if (__builtin_expect(__all((pmax - m_reg) * SCALE <= THR), 1)) { mn = m_reg; alpha = 1.f; }
    else { mn = fmaxf(m_reg, pmax); alpha = __builtin_amdgcn_exp2f((m_reg - mn) * C2); m_reg = mn; }
    const float mnL = -mn * C2;
    for (int r = 0; r < 16; ++r) p0[r] = fmaf(p0[r], C2, mnL); for (int r = 0; r < 16; ++r) p1[r] = fmaf(p1[r], C2, mnL);
    for (int r = 0; r < 16; ++r) p0[r] = __builtin_amdgcn_exp2f(p0[r]);
}
__device__ __forceinline__ void finishSM(f32x16& p0, f32x16& p1, float alpha, float& l_reg, bf16x8& pa0, bf16x8& pa1, bf16x8& pa2, bf16x8& pa3) {
    for (int r = 0; r < 16; ++r) p1[r] = __builtin_amdgcn_exp2f(p1[r]);
    float ps = 0; for (int r = 0; r < 16; ++r) ps += p0[r]; for (int r = 0; r < 16; ++r) ps += p1[r];
    { auto rr = __builtin_amdgcn_permlane32_swap(__float_as_uint(ps), __float_as_uint(ps), false, false);
      ps = __uint_as_float(rr[0]) + __uint_as_float(rr[1]); }
    l_reg = l_reg * alpha + ps;
#define PK4(P, B_, OUT) do { unsigned a0 = cvtpk(P[B_+0], P[B_+1]), a1 = cvtpk(P[B_+2], P[B_+3]);                          \
        unsigned b0 = cvtpk(P[B_+4], P[B_+5]), b1 = cvtpk(P[B_+6], P[B_+7]);                                             \
        auto r0 = __builtin_amdgcn_permlane32_swap(a0, b0, false, false); auto r1 = __builtin_amdgcn_permlane32_swap(a1, b1, false, false); \
        u32x4 w = {r0[0], r1[0], r0[1], r1[1]}; OUT = *reinterpret_cast<bf16x8*>(&w); } while (0)
    PK4(p0, 0, pa0); PK4(p0, 8, pa1); PK4(p1, 0, pa2); PK4(p1, 8, pa3);
#undef PK4
}
template <int KB, bool SK>
__device__ __forceinline__ void qkt(f32x16& p0, f32x16& p1, const char* K_lds, int r32, int hi, const bf16x8* qr, bool act) {
    if (SK && !act) { const float NEG = -__builtin_inff();
#pragma unroll
        for (int r = 0; r < 16; ++r) { p0[r] = NEG; p1[r] = NEG; } return; }
    p0 = f32x16{}; p1 = f32x16{};
    const char* kb[4];
#pragma unroll
    for (int dd = 0; dd < 4; ++dd) kb[dd] = K_lds + KB * SHM_K + KSWZ(r32, (dd * 16 + hi * 8) * 2);
#pragma unroll
    for (int d0 = 0; d0 < 8; ++d0) { const char* a = kb[d0 & 3] + (d0 >> 2) * 128;
        bf16x8 b0 = *reinterpret_cast<const bf16x8*>(a);
        bf16x8 b1 = *reinterpret_cast<const bf16x8*>(a + 32 * 256);
        p0 = __builtin_amdgcn_mfma_f32_32x32x16_bf16(b0, qr[d0], p0, 0, 0, 0);
        p1 = __builtin_amdgcn_mfma_f32_32x32x16_bf16(b1, qr[d0], p1, 0, 0, 0); }
}
template <int VB, bool SK>
__device__ __forceinline__ void pv_tile(f32x16* o, int vb0, bf16x8 pa0, bf16x8 pa1, bf16x8 pa2, bf16x8 pa3, bool act) {
    if (SK && !act) return;
#define TRRD(dst, off) asm volatile("ds_read_b64_tr_b16 %0, %1 offset:%2" : "=&v"(dst) : "v"(vb0), "i"(off) : "memory")
#define PV_D0(d0) do { s16x4 l0, l1, l2, l3, h0, h1, h2, h3; constexpr int b_ = VB * SHM_V + v_rd_off(d0, 0, 0);     \
        TRRD(l0, b_); TRRD(h0, b_ + 2048); TRRD(l1, b_ + 4096); TRRD(h1, b_ + 6144); TRRD(l2, b_ + 8192); TRRD(h2, b_ + 10240); TRRD(l3, b_ + 12288); TRRD(h3, b_ + 14336); \
        asm volatile("s_waitcnt lgkmcnt(0)" ::: "memory"); SBAR();                 \
        o[d0] = __builtin_amdgcn_mfma_f32_32x32x16_bf16(pa0, (bf16x8){l0[0], l0[1], l0[2], l0[3], h0[0], h0[1], h0[2], h0[3]}, o[d0], 0, 0, 0);   \
        o[d0] = __builtin_amdgcn_mfma_f32_32x32x16_bf16(pa1, (bf16x8){l1[0], l1[1], l1[2], l1[3], h1[0], h1[1], h1[2], h1[3]}, o[d0], 0, 0, 0);   \
        o[d0] = __builtin_amdgcn_mfma_f32_32x32x16_bf16(pa2, (bf16x8){l2[0], l2[1], l2[2], l2[3], h2[0], h2[1], h2[2], h2[3]}, o[d0], 0, 0, 0);   \
        o[d0] = __builtin_amdgcn_mfma_f32_32x32x16_bf16(pa3, (bf16x8){l3[0], l3[1], l3[2], l3[3], h3[0], h3[1], h3[2], h3[3]}, o[d0], 0, 0, 0); } while (0)
    PV_D0(0); PV_D0(1); PV_D0(2); PV_D0(3);
#undef PV_D0
#undef TRRD
}

template <class TIn, class TOut> struct BlockRef { const TIn* Q; const TIn* K; const TIn* V; TOut* O; int P0; };
template <class TIn> struct Seam {
    bf16x8 qr[8];
    bf16x8 st_v0, st_v1, st_k0, st_k1; f32x4 sf0, sf1, sf2, sf3;
    f32x4 tq[16];
};
__device__ __forceinline__ int swa_jlo(int P0, int W) { const int lowk = P0 - W + 1; return lowk > 0 ? lowk / KVBLK : 0; }
#define ROW(p, k0, rr) ((p) + (size_t)((k0) + (rr)) * LDP + sc)
#define VMW() asm volatile("s_waitcnt vmcnt(0)" ::: "memory")
#define VMWN(n) asm volatile("s_waitcnt vmcnt(%0)" :: "i"(n) : "memory")
#define SLOAD_H(Kp, Vp, k0) do { S.st_v0 = load8<TIn>(ROW(Vp, k0, sr)); S.st_v1 = load8<TIn>(ROW(Vp, k0, 32 + sr));              \
                         S.st_k0 = load8<TIn>(ROW(Kp, k0, sr)); S.st_k1 = load8<TIn>(ROW(Kp, k0, 32 + sr)); } while (0)
#define SWRITE_HK(bf) do { *(bf16x8*)(K_lds + (bf) * SHM_K + kws) = S.st_k0; *(bf16x8*)(K_lds + (bf) * SHM_K + kws + 32 * 256) = S.st_k1; } while (0)
#define SWRITE_HV(bf) do { *(bf16x8*)(V_lds + (bf) * SHM_V + vst0) = S.st_v0; *(bf16x8*)(V_lds + (bf) * SHM_V + vst1) = S.st_v1; } while (0)
#define SWRITE_H(bf) do { SWRITE_HV(bf); SWRITE_HK(bf); } while (0)
#define SLOAD_F(p, k0) do { S.sf0 = *(const f32x4*)ROW(p, k0, sr); S.sf1 = *(const f32x4*)(ROW(p, k0, sr) + 4);                \
                            S.sf2 = *(const f32x4*)ROW(p, k0, 32 + sr); S.sf3 = *(const f32x4*)(ROW(p, k0, 32 + sr) + 4); } while (0)
#define SWRITE_KF(bf) do { *(bf16x8*)(K_lds + (bf) * SHM_K + kws) = pack8(S.sf0, S.sf1); *(bf16x8*)(K_lds + (bf) * SHM_K + kws + 32 * 256) = pack8(S.sf2, S.sf3); } while (0)
#define SWRITE_VF(bf) do { *(bf16x8*)(V_lds + (bf) * SHM_V + vst0) = pack8(S.sf0, S.sf1); *(bf16x8*)(V_lds + (bf) * SHM_V + vst1) = pack8(S.sf2, S.sf3); } while (0)
template <class TIn, class TOut>
__device__ __forceinline__ void causal_swa_prime(const BlockRef<TIn, TOut>& cur, int W, char* lds, Seam<TIn>& S) {
    constexpr bool F32 = same_t<TIn, float>::v;
    int tid_ = threadIdx.x; asm volatile("" : "+v"(tid_));
    const int tid = tid_, wid = __builtin_amdgcn_readfirstlane(tid >> 6), lane = tid & 63, r32 = lane & 31, hi = lane >> 5;
    const int sr = tid >> 4, sc = (tid & 15) * 8, kws = KSWZ(sr, sc * 2); char* K_lds = lds + 2 * SHM_V;
    const int kb0 = swa_jlo(cur.P0, W) * KVBLK;
    for (int d0 = 0; d0 < 8; ++d0) S.qr[d0] = load8<TIn>(cur.Q + (size_t)(wid * QBLK + r32) * LDP + d0 * 16 + hi * 8);
    if constexpr (F32) { SLOAD_F((const float*)cur.K, kb0); VMW(); SWRITE_KF(0); SBAR(); SLOAD_F((const float*)cur.V, kb0); }
    else { SLOAD_H(cur.K, cur.V, kb0); VMW(); SWRITE_HK(0); }
    __syncthreads();
}
template <class TIn, class TOut>
__device__ __forceinline__ void causal_swa_block(const BlockRef<TIn, TOut>& cur, const BlockRef<TIn, TOut>& nxt, int skv, int W, char* lds, Seam<TIn>& S) {
    constexpr bool F32 = same_t<TIn, float>::v;
    int tid_ = threadIdx.x; asm volatile("" : "+v"(tid_));
    const int tid = tid_, wid = __builtin_amdgcn_readfirstlane(tid >> 6), lane = tid & 63, r32 = lane & 31, hi = lane >> 5;
    const int j_lo = swa_jlo(cur.P0, W);
    int j_hi = (cur.P0 + QB - 1) / KVBLK + 1; if (j_hi > skv / KVBLK) j_hi = skv / KVBLK;
    const int NT = j_hi - j_lo;
    const int kbn = swa_jlo(nxt.P0, W) * KVBLK;
    const int qlo = cur.P0 + wid * QBLK, qm = qlo + r32 - 4 * hi;
    char* V_lds = lds; char* K_lds = lds + 2 * SHM_V;
    float* ws = (float*)(lds + 2 * SHM_V + 2 * SHM_K) + wid * 64; float* li_l = ws, * al_l = ws + 32;
    float m_reg = -1e30f, l_reg = 0; f32x16 o[4] = {};
    const int sr = tid >> 4, sc = (tid & 15) * 8, vst0 = v_st(sr, sc), vst1 = v_st(32 + sr, sc), kws = KSWZ(sr, sc * 2);
    const int vb0 = (int)(uintptr_t)V_lds + v_rd_base(lane);
    const TIn* Kh = cur.K; const TIn* Vh = cur.V;
#define RESC(a) do { if (__any((a) < 1.f)) { if (hi == 0) al_l[r32] = (a); asm volatile("s_waitcnt lgkmcnt(0)" ::: "memory");              \
                     for (int d_ = 0; d_ < 4; ++d_) for (int r = 0; r < 16; ++r) o[d_][r] *= al_l[crow(r, hi)]; } } while (0)
#define KBASE(t) ((j_lo + (t)) * KVBLK)
#define ACT(t) (KBASE(t) <= qlo + QBLK - 1 && KBASE(t) + KVBLK - 1 >= qlo - W + 1)
#define MASKT(P0_, P1_, t) do { const int kb_ = KBASE(t); if ((!SK || ACT(t)) && (kb_ + KVBLK - 1 > qlo || kb_ <= qlo + QBLK - 1 - W)) mask_tile(P0_, P1_, qm - kb_, (unsigned)W); } while (0)
    constexpr int NQL = F32 ? 16 : 8;
    constexpr bool SK = WSKIP && !F32;
#define SEAM_K0() do { VMWN(NQL); if constexpr (F32) { SWRITE_KF(0); SBAR(); SLOAD_F((const float*)nxt.V, kbn); } else { SWRITE_HK(0); } SBAR(); } while (0)
    f32x16 pA0, pA1, pB0, pB1; float mnA, mnB, alA, alB; bf16x8 pa0, pa1, pa2, pa3;
    if constexpr (F32) { VMW(); SWRITE_VF(0); SBAR(); } else { SWRITE_HV(0); SBAR(); }
    if (NT > 1) { if constexpr (F32) SLOAD_F((const float*)Kh, KBASE(1)); else SLOAD_H(Kh, Vh, KBASE(1)); }
    SBAR(); qkt<0, SK>(pA0, pA1, K_lds, r32, hi, S.qr, ACT(0));
    if constexpr (F32) { if (NT > 1) { VMW(); SWRITE_KF(1); SBAR(); SLOAD_F((const float*)Vh, KBASE(1)); } }
    MASKT(pA0, pA1, 0); partialSM(pA0, pA1, m_reg, mnA, alA);
    if (NT > 1) { VMW(); if constexpr (F32) { SWRITE_VF(1); SBAR(); if (NT > 2) SLOAD_F((const float*)Kh, KBASE(2)); } else SWRITE_H(1); }
    __syncthreads();
#define HALF_STEP(PX0, PX1, mnX, alX, PY0, PY1, alY, t, KB, VB, SB) do {                                                      \
        SBAR(); qkt<KB, SK>(PX0, PX1, K_lds, r32, hi, S.qr, ACT(t));                                             \
        finishSM(PY0, PY1, alY, l_reg, pa0, pa1, pa2, pa3); SBAR();                                                           \
        if ((t) + 1 < NT) { if constexpr (F32) { VMW(); SWRITE_KF(SB); SBAR(); SLOAD_F((const float*)Vh, KBASE((t) + 1)); }  \
                            else { SLOAD_H(Kh, Vh, KBASE((t) + 1)); } SBAR(); }                                               \
        pv_tile<VB, SK>(o, vb0, pa0, pa1, pa2, pa3, ACT((t) - 1)); MASKT(PX0, PX1, (t)); partialSM(PX0, PX1, m_reg, mnX, alX);                                        \
        __syncthreads();                                                                                                      \
        if ((t) + 1 < NT) { VMW(); if constexpr (F32) { SWRITE_VF(SB); SBAR(); if ((t) + 2 < NT) SLOAD_F((const float*)Kh, KBASE((t) + 2)); } \
                            else { SWRITE_H(SB); } }                                                                          \
        RESC(alX); __syncthreads(); } while (0)
    for (int t = 1; t + 1 < NT; t += 2) {
        HALF_STEP(pB0, pB1, mnB, alB, pA0, pA1, alA, t, 1, 0, 0);
        HALF_STEP(pA0, pA1, mnA, alA, pB0, pB1, alB, t + 1, 0, 1, 1);
    }
    const bool even = (NT & 1) == 0;
    if (even) { SBAR(); qkt<1, SK>(pB0, pB1, K_lds, r32, hi, S.qr, ACT(NT - 1)); SBAR(); }
#define QROW(e) (nxt.Q + (size_t)(wid * QBLK + r32) * LDP + ((e) >> 1) * 16 + hi * 8 + ((e) & 1) * 4)
    if constexpr (F32) { SLOAD_F((const float*)nxt.K, kbn); SBAR();
#pragma unroll
        for (int e = 0; e < 8; ++e) S.tq[e] = *(const f32x4*)QROW(e); }
    else { SLOAD_H(nxt.K, nxt.V, kbn); SBAR();
#pragma unroll
        for (int d0 = 0; d0 < 8; ++d0) S.qr[d0] = load8<TIn>(nxt.Q + (size_t)(wid * QBLK + r32) * LDP + d0 * 16 + hi * 8); }
    SBAR();
    finishSM(pA0, pA1, alA, l_reg, pa0, pa1, pa2, pa3); SBAR();
    if constexpr (F32) {
#pragma unroll
        for (int e = 8; e < 16; ++e) S.tq[e] = *(const f32x4*)QROW(e); SBAR(); }
#undef QROW
    pv_tile<0, SK>(o, vb0, pa0, pa1, pa2, pa3, ACT(even ? NT - 2 : NT - 1));
    if (even) { MASKT(pB0, pB1, NT - 1); partialSM(pB0, pB1, m_reg, mnB, alB); __syncthreads(); RESC(alB);
        finishSM(pB0, pB1, alB, l_reg, pa0, pa1, pa2, pa3); SBAR(); pv_tile<1, SK>(o, vb0, pa0, pa1, pa2, pa3, ACT(NT - 1)); }
    SBAR(); SEAM_K0();
    if (hi == 0) li_l[r32] = l_reg; asm volatile("s_waitcnt lgkmcnt(0)" ::: "memory");
    float rli[16];
#pragma unroll
    for (int r = 0; r < 16; ++r) rli[r] = __builtin_amdgcn_rcpf(li_l[crow(r, hi)]);
    TOut* Ow = cur.O + (size_t)(wid * QBLK) * LDO;
#pragma unroll
    for (int r = 0; r < 16; ++r) { const int orow = crow(r, hi);
#pragma unroll
        for (int d0 = 0; d0 < 4; ++d0) { const float v = o[d0][r] * rli[r];
            if constexpr (same_t<TOut, float>::v) { Ow[(size_t)orow * LDO + d0 * 32 + r32] = v; }
            else { const float vn = __shfl_xor(v, 1);
                   if ((r32 & 1) == 0) *(unsigned*)(Ow + (size_t)orow * LDO + d0 * 32 + r32) = cvtpk(v, vn); } } }
    if constexpr (F32) {
#pragma unroll
        for (int d0 = 0; d0 < 8; ++d0) S.qr[d0] = pack8(S.tq[2 * d0], S.tq[2 * d0 + 1]); }
    __syncthreads();
#undef RESC
#undef KBASE
#undef ACT
#undef MASKT
#undef SEAM_K0
#undef HALF_STEP
}
#undef ROW
#undef VMW
#undef VMWN
#undef SLOAD_H
#undef SWRITE_HK
#undef SWRITE_HV
#undef SWRITE_H
#undef SLOAD_F
#undef SWRITE_KF
#undef SWRITE_VF

}
namespace da {
using namespace swa;
constexpr int SEQ_LEN = 8192, ATT_LD = 4096;
constexpr int STAGE_B = 65536, OFF_K = 0, OFF_V = 32768, QROWS = 128;
typedef __attribute__((address_space(3))) unsigned lds_u32;
typedef float f32x4v __attribute__((ext_vector_type(4)));
__device__ __forceinline__ void dma16(const bf16* g, char* lds_dst_uniform) { __builtin_amdgcn_global_load_lds((const unsigned*)g, (lds_u32*)lds_dst_uniform, 16, 0, 0); }
__device__ __forceinline__ f32x4v mfma16(bf16x8 a, bf16x8 b, f32x4v c) { return __builtin_amdgcn_mfma_f32_16x16x32_bf16(a, b, c, 0, 0, 0); }
__device__ __forceinline__ float bpx(float v, int lane, int mask) { return __int_as_float(__builtin_amdgcn_ds_bpermute((lane ^ mask) << 2, __float_as_int(v))); }
struct Ctx { const bf16* proj; bf16* att; const float* subln_g; float lam; };
__device__ __forceinline__ void issue_tile(const bf16* Kg, const bf16* Vg, int k0, char* stage, int wid, int lane_) {
    const bf16* kb = Kg + (size_t)k0 * LDP;
    int lane = lane_; asm volatile("" : "+v"(lane));
#pragma unroll
    for (int i = 0; i < 2; ++i) { const int c = 2 * wid + i, row = 4 * c + (lane >> 4), gch = (lane & 15) ^ (row & 7), ko = row * LDP + gch * 8;
        char* dst = stage + (2 * wid + i) * 1024; dma16(kb + ko, dst + OFF_K); dma16(kb + 128 + ko, dst + OFF_K + 16384); }
    const int ks = wid >> 2;
#pragma unroll
    for (int i = 0; i < 4; ++i) { const int c = (4 * wid + i) & 7, row = 8 * (c >> 1) + ((lane >> 2) & 7), ch = 4 * (2 * (c & 1) + (lane >> 5)) + ((lane & 3) ^ ((row >> 2) & 3));
        const bf16* src = (Vg + (size_t)(k0 + 32 * ks) * LDP + 128 * ((wid >> 1) & 1)) + (row * LDP + 8 * ch);
        dma16(src, stage + OFF_V + (4 * wid + i) * 1024); }
}
#define DA16_TR(dst, addr, off) asm volatile("ds_read_b64_tr_b16 %0, %1 offset:%2" : "=&v"(dst) : "v"(addr), "i"(off) : "memory")
#define DA16_FR(l, h) (bf16x8){l[0], l[1], l[2], l[3], h[0], h[1], h[2], h[3]}
__device__ __forceinline__ void p_swap16(bf16x8 x, bf16x8 y, bf16x8& lo, bf16x8& hi16) {
    u32x4 xv = *reinterpret_cast<u32x4*>(&x), yv = *reinterpret_cast<u32x4*>(&y), l, h;
#pragma unroll
    for (int j = 0; j < 4; ++j) { auto r = __builtin_amdgcn_permlane16_swap(xv[j], yv[j], false, false); l[j] = r[0]; h[j] = r[1]; }
    lo = *reinterpret_cast<bf16x8*>(&l); hi16 = *reinterpret_cast<bf16x8*>(&h);
}
__device__ __forceinline__ void qkt6(f32x16& p0, f32x16& p1, const char* K_lds, int r32, int hi, const bf16x8 (&qr)[6], const char* qsp_l) {
    p0 = f32x16{}; p1 = f32x16{};
    const char* kb[4];
#pragma unroll
    for (int dd = 0; dd < 4; ++dd) kb[dd] = K_lds + KSWZ(r32, (dd * 16 + hi * 8) * 2);
#pragma unroll
    for (int d0 = 0; d0 < 8; ++d0) { const char* a = kb[d0 & 3] + (d0 >> 2) * 128;
        bf16x8 b0 = *reinterpret_cast<const bf16x8*>(a);
        bf16x8 b1 = *reinterpret_cast<const bf16x8*>(a + 32 * 256);
        bf16x8 q; if (d0 < 6) q = qr[d0 < 6 ? d0 : 0]; else q = *reinterpret_cast<const bf16x8*>(qsp_l + (d0 - 6) * 1024);
        p0 = __builtin_amdgcn_mfma_f32_32x32x16_bf16(b0, q, p0, 0, 0, 0);
        p1 = __builtin_amdgcn_mfma_f32_32x32x16_bf16(b1, q, p1, 0, 0, 0); }
}
template <int ST>
__device__ __forceinline__ void step(f32x4v (&o)[2][16], const bf16x8 (&qr)[6], const char* qsp_w, float& m_reg, float& l_reg, char* lds, float* al_l, int map,
                                     bool need_mask, int dqu  , bool more, const bf16* Kg, const bf16* Vg, int k_next, int wid) {
    asm volatile("s_waitcnt vmcnt(0)" ::: "memory"); __builtin_amdgcn_s_barrier(); asm volatile("" ::: "memory");
    int lane_; asm volatile("v_mbcnt_lo_u32_b32 %0, -1, 0\n\tv_mbcnt_hi_u32_b32 %0, -1, %0" : "=v"(lane_));
    const int r32 = lane_ & 31, hi = lane_ >> 5, dq = dqu + r32 - 4 * hi;
    if (more) issue_tile(Kg, Vg, k_next, lds + (ST ^ 1) * STAGE_B, wid, lane_);
    bf16x8 P00, P10, P01, P11;
    { f32x16 p0, p1; float mn, alpha; bf16x8 pa0, pa1, pa2, pa3;
      qkt6(p0, p1, lds + ST * STAGE_B + OFF_K + map * 16384, r32, hi, qr, qsp_w + lane_ * 16);
      if (need_mask) mask_tile(p0, p1, dq, 0x7fffffffu);
      partialSM(p0, p1, m_reg, mn, alpha);
      finishSM(p0, p1, alpha, l_reg, pa0, pa1, pa2, pa3);
      if (__any(alpha < 1.f)) { if (hi == 0) al_l[r32] = alpha; asm volatile("s_waitcnt lgkmcnt(0)" ::: "memory");
          int lq = lane_; asm volatile("" : "+v"(lq)); const int fqr = lq >> 4;
#pragma unroll
          for (int qb = 0; qb < 2; ++qb) { const f32x4v a4 = *(const f32x4v*)(al_l + 16 * qb + 4 * fqr);
#pragma unroll
              for (int c = 0; c < 16; ++c) o[qb][c] *= a4; } }
      p_swap16(pa0, pa1, P00, P10); p_swap16(pa2, pa3, P01, P11); }
    int lane = lane_; asm volatile("" : "+v"(lane));
    const int fr = lane & 15, fq = lane >> 4, fqv = ((fq & 1) << 1) | (fq >> 1);
    const int vq = fr >> 2, vp = fr & 3;
    const int vb00 = 2048 * fqv + 64 * vq + 16 * ((vp >> 1) ^ ((2 * fqv) & 3)) + 8 * (vp & 1), vb10 = 2048 * fqv + 64 * (4 + vq) + 16 * ((vp >> 1) ^ ((2 * fqv + 1) & 3)) + 8 * (vp & 1);
    const int vst = (int)(uintptr_t)lds + ST * STAGE_B + OFF_V;
    const int va00 = vst + vb00, va10 = vst + vb10;
    s16x4 fl0, fh0, fl1, fh1, fl2, fh2;
    asm volatile("s_waitcnt lgkmcnt(0)" ::: "memory");
    DA16_TR(fl0, va00, 0); DA16_TR(fh0, va10, 0); DA16_TR(fl1, (va00 ^ 32), 0); DA16_TR(fh1, (va10 ^ 32), 0);
    DA16_TR(fl2, va00, 512); DA16_TR(fh2, va10, 512); asm volatile("s_waitcnt lgkmcnt(4)" ::: "memory"); SBAR(); { const bf16x8 vf = DA16_FR(fl0, fh0); o[0][0] = mfma16(P00, vf, o[0][0]); o[1][0] = mfma16(P10, vf, o[1][0]); } SBAR();
    DA16_TR(fl0, (va00 ^ 32), 512); DA16_TR(fh0, (va10 ^ 32), 512); asm volatile("s_waitcnt lgkmcnt(4)" ::: "memory"); SBAR(); { const bf16x8 vf = DA16_FR(fl1, fh1); o[0][1] = mfma16(P00, vf, o[0][1]); o[1][1] = mfma16(P10, vf, o[1][1]); } SBAR();
    DA16_TR(fl1, va00, 1024); DA16_TR(fh1, va10, 1024); asm volatile("s_waitcnt lgkmcnt(4)" ::: "memory"); SBAR(); { const bf16x8 vf = DA16_FR(fl2, fh2); o[0][2] = mfma16(P00, vf, o[0][2]); o[1][2] = mfma16(P10, vf, o[1][2]); } SBAR();
    DA16_TR(fl2, (va00 ^ 32), 1024); DA16_TR(fh2, (va10 ^ 32), 1024); asm volatile("s_waitcnt lgkmcnt(4)" ::: "memory"); SBAR(); { const bf16x8 vf = DA16_FR(fl0, fh0); o[0][3] = mfma16(P00, vf, o[0][3]); o[1][3] = mfma16(P10, vf, o[1][3]); } SBAR();
    DA16_TR(fl0, va00, 1536); DA16_TR(fh0, va10, 1536); asm volatile("s_waitcnt lgkmcnt(4)" ::: "memory"); SBAR(); { const bf16x8 vf = DA16_FR(fl1, fh1); o[0][4] = mfma16(P00, vf, o[0][4]); o[1][4] = mfma16(P10, vf, o[1][4]); } SBAR();
    DA16_TR(fl1, (va00 ^ 32), 1536); DA16_TR(fh1, (va10 ^ 32), 1536); asm volatile("s_waitcnt lgkmcnt(4)" ::: "memory"); SBAR(); { const bf16x8 vf = DA16_FR(fl2, fh2); o[0][5] = mfma16(P00, vf, o[0][5]); o[1][5] = mfma16(P10, vf, o[1][5]); } SBAR();
    DA16_TR(fl2, va00, 8192); DA16_TR(fh2, va10, 8192); asm volatile("s_waitcnt lgkmcnt(4)" ::: "memory"); SBAR(); { const bf16x8 vf = DA16_FR(fl0, fh0); o[0][6] = mfma16(P00, vf, o[0][6]); o[1][6] = mfma16(P10, vf, o[1][6]); } SBAR();
    DA16_TR(fl0, (va00 ^ 32), 8192); DA16_TR(fh0, (va10 ^ 32), 8192); asm volatile("s_waitcnt lgkmcnt(4)" ::: "memory"); SBAR(); { const bf16x8 vf = DA16_FR(fl1, fh1); o[0][7] = mfma16(P00, vf, o[0][7]); o[1][7] = mfma16(P10, vf, o[1][7]); } SBAR();
    DA16_TR(fl1, va00, 8704); DA16_TR(fh1, va10, 8704); asm volatile("s_waitcnt lgkmcnt(4)" ::: "memory"); SBAR(); { const bf16x8 vf = DA16_FR(fl2, fh2); o[0][8] = mfma16(P00, vf, o[0][8]); o[1][8] = mfma16(P10, vf, o[1][8]); } SBAR();
    DA16_TR(fl2, (va00 ^ 32), 8704); DA16_TR(fh2, (va10 ^ 32), 8704); asm volatile("s_waitcnt lgkmcnt(4)" ::: "memory"); SBAR(); { const bf16x8 vf = DA16_FR(fl0, fh0); o[0][9] = mfma16(P00, vf, o[0][9]); o[1][9] = mfma16(P10, vf, o[1][9]); } SBAR();
    DA16_TR(fl0, va00, 9216); DA16_TR(fh0, va10, 9216); asm volatile("s_waitcnt lgkmcnt(4)" ::: "memory"); SBAR(); { const bf16x8 vf = DA16_FR(fl1, fh1); o[0][10] = mfma16(P00, vf, o[0][10]); o[1][10] = mfma16(P10, vf, o[1][10]); } SBAR();
    DA16_TR(fl1, (va00 ^ 32), 9216); DA16_TR(fh1, (va10 ^ 32), 9216); asm volatile("s_waitcnt lgkmcnt(4)" ::: "memory"); SBAR(); { const bf16x8 vf = DA16_FR(fl2, fh2); o[0][11] = mfma16(P00, vf, o[0][11]); o[1][11] = mfma16(P10, vf, o[1][11]); } SBAR();
    DA16_TR(fl2, va00, 9728); DA16_TR(fh2, va10, 9728); asm volatile("s_waitcnt lgkmcnt(4)" ::: "memory"); SBAR(); { const bf16x8 vf = DA16_FR(fl0, fh0); o[0][12] = mfma16(P00, vf, o[0][12]); o[1][12] = mfma16(P10, vf, o[1][12]); } SBAR();
    DA16_TR(fl0, (va00 ^ 32), 9728); DA16_TR(fh0, (va10 ^ 32), 9728); asm volatile("s_waitcnt lgkmcnt(4)" ::: "memory"); SBAR(); { const bf16x8 vf = DA16_FR(fl1, fh1); o[0][13] = mfma16(P00, vf, o[0][13]); o[1][13] = mfma16(P10, vf, o[1][13]); } SBAR();
    DA16_TR(fl1, va00, 16384); DA16_TR(fh1, va10, 16384); asm volatile("s_waitcnt lgkmcnt(4)" ::: "memory"); SBAR(); { const bf16x8 vf = DA16_FR(fl2, fh2); o[0][14] = mfma16(P00, vf, o[0][14]); o[1][14] = mfma16(P10, vf, o[1][14]); } SBAR();
    DA16_TR(fl2, (va00 ^ 32), 16384); DA16_TR(fh2, (va10 ^ 32), 16384); asm volatile("s_waitcnt lgkmcnt(4)" ::: "memory"); SBAR(); { const bf16x8 vf = DA16_FR(fl0, fh0); o[0][15] = mfma16(P00, vf, o[0][15]); o[1][15] = mfma16(P10, vf, o[1][15]); } SBAR();
    DA16_TR(fl0, va00, 16896); DA16_TR(fh0, va10, 16896); asm volatile("s_waitcnt lgkmcnt(4)" ::: "memory"); SBAR(); { const bf16x8 vf = DA16_FR(fl1, fh1); o[0][0] = mfma16(P01, vf, o[0][0]); o[1][0] = mfma16(P11, vf, o[1][0]); } SBAR();
    DA16_TR(fl1, (va00 ^ 32), 16896); DA16_TR(fh1, (va10 ^ 32), 16896); asm volatile("s_waitcnt lgkmcnt(4)" ::: "memory"); SBAR(); { const bf16x8 vf = DA16_FR(fl2, fh2); o[0][1] = mfma16(P01, vf, o[0][1]); o[1][1] = mfma16(P11, vf, o[1][1]); } SBAR();
    DA16_TR(fl2, va00, 17408); DA16_TR(fh2, va10, 17408); asm volatile("s_waitcnt lgkmcnt(4)" ::: "memory"); SBAR(); { const bf16x8 vf = DA16_FR(fl0, fh0); o[0][2] = mfma16(P01, vf, o[0][2]); o[1][2] = mfma16(P11, vf, o[1][2]); } SBAR();
    DA16_TR(fl0, (va00 ^ 32), 17408); DA16_TR(fh0, (va10 ^ 32), 17408); asm volatile("s_waitcnt lgkmcnt(4)" ::: "memory"); SBAR(); { const bf16x8 vf = DA16_FR(fl1, fh1); o[0][3] = mfma16(P01, vf, o[0][3]); o[1][3] = mfma16(P11, vf, o[1][3]); } SBAR();
    DA16_TR(fl1, va00, 17920); DA16_TR(fh1, va10, 17920); asm volatile("s_waitcnt lgkmcnt(4)" ::: "memory"); SBAR(); { const bf16x8 vf = DA16_FR(fl2, fh2); o[0][4] = mfma16(P01, vf, o[0][4]); o[1][4] = mfma16(P11, vf, o[1][4]); } SBAR();
    DA16_TR(fl2, (va00 ^ 32), 17920); DA16_TR(fh2, (va10 ^ 32), 17920); asm volatile("s_waitcnt lgkmcnt(4)" ::: "memory"); SBAR(); { const bf16x8 vf = DA16_FR(fl0, fh0); o[0][5] = mfma16(P01, vf, o[0][5]); o[1][5] = mfma16(P11, vf, o[1][5]); } SBAR();
    DA16_TR(fl0, va00, 24576); DA16_TR(fh0, va10, 24576); asm volatile("s_waitcnt lgkmcnt(4)" ::: "memory"); SBAR(); { const bf16x8 vf = DA16_FR(fl1, fh1); o[0][6] = mfma16(P01, vf, o[0][6]); o[1][6] = mfma16(P11, vf, o[1][6]); } SBAR();
    DA16_TR(fl1, (va00 ^ 32), 24576); DA16_TR(fh1, (va10 ^ 32), 24576); asm volatile("s_waitcnt lgkmcnt(4)" ::: "memory"); SBAR(); { const bf16x8 vf = DA16_FR(fl2, fh2); o[0][7] = mfma16(P01, vf, o[0][7]); o[1][7] = mfma16(P11, vf, o[1][7]); } SBAR();
    DA16_TR(fl2, va00, 25088); DA16_TR(fh2, va10, 25088); asm volatile("s_waitcnt lgkmcnt(4)" ::: "memory"); SBAR(); { const bf16x8 vf = DA16_FR(fl0, fh0); o[0][8] = mfma16(P01, vf, o[0][8]); o[1][8] = mfma16(P11, vf, o[1][8]); } SBAR();
    DA16_TR(fl0, (va00 ^ 32), 25088); DA16_TR(fh0, (va10 ^ 32), 25088); asm volatile("s_waitcnt lgkmcnt(4)" ::: "memory"); SBAR(); { const bf16x8 vf = DA16_FR(fl1, fh1); o[0][9] = mfma16(P01, vf, o[0][9]); o[1][9] = mfma16(P11, vf, o[1][9]); } SBAR();
    DA16_TR(fl1, va00, 25600); DA16_TR(fh1, va10, 25600); asm volatile("s_waitcnt lgkmcnt(4)" ::: "memory"); SBAR(); { const bf16x8 vf = DA16_FR(fl2, fh2); o[0][10] = mfma16(P01, vf, o[0][10]); o[1][10] = mfma16(P11, vf, o[1][10]); } SBAR();
    DA16_TR(fl2, (va00 ^ 32), 25600); DA16_TR(fh2, (va10 ^ 32), 25600); asm volatile("s_waitcnt lgkmcnt(4)" ::: "memory"); SBAR(); { const bf16x8 vf = DA16_FR(fl0, fh0); o[0][11] = mfma16(P01, vf, o[0][11]); o[1][11] = mfma16(P11, vf, o[1][11]); } SBAR();
    DA16_TR(fl0, va00, 26112); DA16_TR(fh0, va10, 26112); asm volatile("s_waitcnt lgkmcnt(4)" ::: "memory"); SBAR(); { const bf16x8 vf = DA16_FR(fl1, fh1); o[0][12] = mfma16(P01, vf, o[0][12]); o[1][12] = mfma16(P11, vf, o[1][12]); } SBAR();
    DA16_TR(fl1, (va00 ^ 32), 26112); DA16_TR(fh1, (va10 ^ 32), 26112); asm volatile("s_waitcnt lgkmcnt(4)" ::: "memory"); SBAR(); { const bf16x8 vf = DA16_FR(fl2, fh2); o[0][13] = mfma16(P01, vf, o[0][13]); o[1][13] = mfma16(P11, vf, o[1][13]); } SBAR();
    asm volatile("s_waitcnt lgkmcnt(2)" ::: "memory"); SBAR(); { const bf16x8 vf = DA16_FR(fl0, fh0); o[0][14] = mfma16(P01, vf, o[0][14]); o[1][14] = mfma16(P11, vf, o[1][14]); } SBAR();
    asm volatile("s_waitcnt lgkmcnt(0)" ::: "memory"); SBAR(); { const bf16x8 vf = DA16_FR(fl1, fh1); o[0][15] = mfma16(P01, vf, o[0][15]); o[1][15] = mfma16(P11, vf, o[1][15]); } SBAR();
}
__device__ __forceinline__ void unit(const Ctx& C, int b, int h, int qi, char* lds, float* wsf, char* qsp) {
    int tid_ = threadIdx.x; asm volatile("" : "+v"(tid_));
    const int tid = tid_, wid = __builtin_amdgcn_readfirstlane(tid >> 6), lane = tid & 63, r32 = lane & 31, hi = lane >> 5;
    const int map = wid >> 2, wq = wid & 3, q0 = qi * QROWS, NT = 2 * qi + 2;
    const size_t row0 = (size_t)b * SEQ_LEN;
    const bf16* Kg = C.proj + row0 * LDP + 2048 + h * 256;
    const bf16* Vg = C.proj + row0 * LDP + 4096 + h * 256;
    const bf16* Qg = C.proj + (row0 + q0 + wq * 32) * LDP + h * 256 + map * 128;
    float* al_l = wsf + wid * 64; float* li_l = al_l + 32;
    issue_tile(Kg, Vg, 0, lds, wid, lane);
    bf16x8 qr[6]; const char* qsp_w = qsp + wid * 2048;
#pragma unroll
    for (int d0 = 0; d0 < 6; ++d0) qr[d0] = load8<bf16>(Qg + (size_t)r32 * LDP + d0 * 16 + hi * 8);
#pragma unroll
    for (int d0 = 6; d0 < 8; ++d0) *(bf16x8*)(qsp + wid * 2048 + (d0 - 6) * 1024 + lane * 16) = load8<bf16>(Qg + (size_t)r32 * LDP + d0 * 16 + hi * 8);
    f32x4v o[2][16];
#pragma unroll
    for (int qb = 0; qb < 2; ++qb)
#pragma unroll
        for (int c = 0; c < 16; ++c) { float z0, z1, z2, z3; asm volatile("v_mov_b32 %0, 0\n\tv_mov_b32 %1, 0\n\tv_mov_b32 %2, 0\n\tv_mov_b32 %3, 0" : "=v"(z0), "=v"(z1), "=v"(z2), "=v"(z3)); o[qb][c] = (f32x4v){z0, z1, z2, z3}; }
    float m_reg = -1e30f, l_reg = 0.f;
    const int qlo = q0 + wq * 32;
    for (int t = 0; t < NT; t += 2) {
        { const int kb = t * 64;       step<0>(o, qr, qsp_w, m_reg, l_reg, lds, al_l, map, kb + 63 > qlo, qlo - kb, true,       Kg, Vg, kb + 64, wid); }
        { const int kb = (t + 1) * 64; step<1>(o, qr, qsp_w, m_reg, l_reg, lds, al_l, map, kb + 63 > qlo, qlo - kb, t + 2 < NT, Kg, Vg, kb + 64, wid); }
    }
    int laneE; asm volatile("v_mbcnt_lo_u32_b32 %0, -1, 0\n\tv_mbcnt_hi_u32_b32 %0, -1, %0" : "=v"(laneE)); const int frE = laneE & 15, fqE = laneE >> 4;
    if (laneE < 32) li_l[laneE] = l_reg; asm volatile("s_waitcnt lgkmcnt(0)" ::: "memory");
#pragma unroll
    for (int qb = 0; qb < 2; ++qb) { const f32x4v l4 = *(const f32x4v*)(li_l + 16 * qb + 4 * fqE); const f32x4v r4 = {__builtin_amdgcn_rcpf(l4[0]), __builtin_amdgcn_rcpf(l4[1]), __builtin_amdgcn_rcpf(l4[2]), __builtin_amdgcn_rcpf(l4[3])};
#pragma unroll
        for (int c = 0; c < 16; ++c) o[qb][c] *= r4; }
    asm volatile("s_waitcnt lgkmcnt(0)" ::: "memory"); __builtin_amdgcn_s_barrier(); asm volatile("" ::: "memory");
    char* xch = lds + wq * 32768 + laneE * 16;
    if (map == 1) {
#pragma unroll
        for (int qb = 0; qb < 2; ++qb)
#pragma unroll
            for (int c = 0; c < 16; ++c) *(f32x4v*)(xch + (qb * 16 + c) * 1024) = o[qb][c];
    }
    asm volatile("s_waitcnt lgkmcnt(0)" ::: "memory"); __builtin_amdgcn_s_barrier(); asm volatile("" ::: "memory");
    if (map == 0) {
        const float lam = wsf[512 + wid];
        bf16* Ow = C.att + (row0 + q0 + wq * 32) * ATT_LD + h * 256;
#pragma unroll
        for (int qb = 0; qb < 2; ++qb) { f32x4v ss = {0.f, 0.f, 0.f, 0.f};
#pragma unroll
            for (int c = 0; c < 16; ++c) { const f32x4v v2 = *(const f32x4v*)(xch + (qb * 16 + c) * 1024); const f32x4v dd = o[qb][c] - v2 * lam; o[qb][c] = dd; ss += dd * dd; }
#pragma unroll
            for (int e = 0; e < 4; ++e) { float s = ss[e]; s += bpx(s, laneE, 1); s += bpx(s, laneE, 2); s += bpx(s, laneE, 4); s += bpx(s, laneE, 8); ss[e] = 1.0f / sqrtf(s * (1.0f / 256.0f) + 1e-5f); }
#pragma unroll
            for (int c = 0; c < 16; ++c) { const float gl = C.subln_g[16 * c + frE] * 0.8f;
#pragma unroll
                for (int e = 0; e < 4; ++e) { const float v = o[qb][c][e] * ss[e] * gl; const float vn = bpx(v, laneE, 1);
                    if ((frE & 1) == 0) *(unsigned*)((Ow + (16 * qb + e) * ATT_LD + 16 * c) + (4 * fqE * ATT_LD + frE)) = cvtpk(v, vn); } } }
    }
    asm volatile("s_waitcnt lgkmcnt(0)" ::: "memory"); __builtin_amdgcn_s_barrier(); asm volatile("" ::: "memory");
}
#undef DA16_TR
#undef DA16_FR
__device__ __forceinline__ void phase(const Ctx& C, char* lds, float* wsf, char* qsp, int vcu, int G) {
    { const int wid = __builtin_amdgcn_readfirstlane((int)threadIdx.x >> 6); wsf[512 + wid] = C.lam; asm volatile("s_waitcnt lgkmcnt(0)" ::: "memory"); }
    const int npair = (512 - vcu + G - 1) / G;
    for (int u = 0; u < 2 * npair; ++u) { const int p = vcu + (u >> 1) * G, bh = p >> 5, x = p & 31;
        unit(C, bh >> 3, bh & 7, (u & 1) ? 63 - x : x, lds, wsf, qsp); }
}
}

constexpr int NWAVES = 8;
#ifndef MK_PER_PHASE
#define MK_PER_PHASE 0
#endif
constexpr int NPH = 12;

constexpr int BATCH = 2, SEQ = 8192, DM = 4096, M = BATCH * SEQ;
constexpr int NHEADS = 8;
constexpr int NIN = 20480, CWID = 2048, DFF = 11008, NUP = 2 * DFF;
constexpr int OFF_Q = 0, OFF_K = 2048, OFF_V = 4096, OFF_U = 6144, OFF_GB = 8192, OFF_GC = 10240, OFF_GA = 12288, OFF_GCV = 16384;
constexpr float LN_EPS = 1e-5f, RMS_EPS = 1e-5f;
constexpr float ALPHA = 1.189207115002721f;
constexpr float LAM_INIT = 0.2f;

constexpr size_t MiB = 1u << 20;
constexpr size_t WS_CTL = 0, CTL_ZERO_BYTES = 32768;
constexpr size_t WS_WA = 1 * MiB, WS_WC = 17 * MiB, WS_WO = 33 * MiB, WS_WIN = 65 * MiB, WS_WDN = 225 * MiB, WS_HALO = 311 * MiB, WS_PROJ = 353 * MiB, WS_ATTN = 993 * MiB, WS_YC = 1057 * MiB, WS_WUP = 1121 * MiB;
constexpr size_t WS_MERGED = 65 * MiB;
constexpr size_t WS_H1B = 353 * MiB;
constexpr size_t WS_G = 481 * MiB;
constexpr size_t WS_END = 1293 * MiB;
constexpr size_t DO_XB = 0, DO_O1 = 0, DO_O2 = 128 * MiB;
static_assert(WS_WIN + (size_t)NIN * DM * 2 <= WS_WDN && WS_WDN + (size_t)DM * DFF * 2 <= WS_HALO && WS_HALO + (size_t)(M / 256) * (NUP / 256) * 1024 * 4 <= WS_PROJ, "ws map (weights)");
static_assert(WS_PROJ + (size_t)M * NIN * 2 <= WS_ATTN && WS_G + (size_t)M * DFF * 2 <= WS_ATTN && WS_WUP + (size_t)NUP * DM * 2 <= WS_END && WS_H1B + (size_t)M * DM * 2 <= WS_G, "ws map");
constexpr int CW_BAR = 4096;

constexpr int RING_OFF = 0, RING_BYTES = 131072;
constexpr int LDSCTL_OFF = RING_BYTES, MISC_OFF = LDSCTL_OFF + 320, HALO_LDS_OFF = LDSCTL_OFF + 1024;
constexpr int QSP_LDS_OFF = HALO_LDS_OFF + 8192;
constexpr int LDS_BYTES = 163840;
static_assert(MISC_OFF + 128 <= HALO_LDS_OFF && QSP_LDS_OFF + 16384 <= LDS_BYTES, "LDS map");

#define GAS __attribute__((address_space(1)))
#define LAS __attribute__((address_space(3)))
typedef unsigned short bf16;
typedef unsigned v4u __attribute__((ext_vector_type(4)));
typedef float f32x4 __attribute__((ext_vector_type(4)));
typedef short bf16x8 __attribute__((ext_vector_type(8)));
typedef GAS unsigned gu32;
typedef GAS unsigned long long gu64;
#define RLX_AGENT __ATOMIC_RELAXED, __HIP_MEMORY_SCOPE_AGENT
#define LDS_WAIT() asm volatile("s_waitcnt lgkmcnt(0)" ::: "memory")
#define VM_WAIT() asm volatile("s_waitcnt vmcnt(0)" ::: "memory")
__device__ __forceinline__ unsigned long long rt() { return __builtin_amdgcn_s_memrealtime(); }
__device__ __forceinline__ unsigned f2bf(float f) { unsigned u = __builtin_bit_cast(unsigned, f); return (u + 0x7fffu + ((u >> 16) & 1u)) >> 16; }
__device__ __forceinline__ unsigned pk2(float lo, float hi) { return f2bf(lo) | (f2bf(hi) << 16); }

#define XB_TMO      128
#define XB_XCNT(j)  (256  + 64 * (j))
#define XB_XSUB(j)  (1280 + 64 * (j))
#define XB_XGEN(j)  (2304 + 64 * (j))
#define XB_TOP      3328
#define XB_TOPGEN   3392
#define XCD_BAR_WORDS 3456
#define XB_SPIN_CAP (1u << 18)

__device__ __forceinline__ unsigned xb_ld(unsigned* p)              { return __hip_atomic_load(p, __ATOMIC_RELAXED, __HIP_MEMORY_SCOPE_AGENT); }
__device__ __forceinline__ unsigned xb_add(unsigned* p, unsigned v) { return __hip_atomic_fetch_add(p, v, __ATOMIC_RELAXED, __HIP_MEMORY_SCOPE_AGENT); }
__device__ __forceinline__ unsigned xb_xcc_id() { return (unsigned)__builtin_amdgcn_s_getreg((3 << 11) | 20) & 0xFu; }
#define XB_SPIN(cond, bar) do { unsigned _sp = 0; while (cond) { __builtin_amdgcn_s_sleep(1); \
    if ((++_sp & 255u) == 0u) { if (xb_ld(&(bar)[XB_TMO])) break; if (_sp > XB_SPIN_CAP) { atomicAdd(&(bar)[XB_TMO], 1u); break; } } } } while (0)

struct XcdBarrier {
    unsigned* bar; unsigned x;
    volatile LAS unsigned* st;
};

__device__ __forceinline__ XcdBarrier xcd_barrier_post(unsigned* bar, volatile LAS unsigned* st) {
    XcdBarrier b; b.bar = bar; b.x = xb_xcc_id(); b.st = st;
    if (threadIdx.x == 0) (void)xb_add(&bar[XB_XCNT(b.x)], 1u);
    return b;
}
__device__ __forceinline__ void xcd_barrier_complete(unsigned* bar, unsigned x, unsigned& nloc, unsigned& nx) {
    const unsigned G = gridDim.x * gridDim.y * gridDim.z;
    unsigned sum, cnt, mine, sp = 0u;
    for (;;) {
        sum = 0u; cnt = 0u; mine = 0u;
#pragma unroll
        for (unsigned j = 0; j < 16; ++j) { const unsigned c = xb_ld(&bar[XB_XCNT(j)]); sum += c; cnt += (c > 0u) ? 1u : 0u; mine = (j == x) ? c : mine; }
        if (sum == G) break;
        __builtin_amdgcn_s_sleep(1);
        if ((++sp & 255u) == 0u) { if (xb_ld(&bar[XB_TMO])) break; if (sp > XB_SPIN_CAP) { atomicAdd(&bar[XB_TMO], 1u); break; } }
    }
    nloc = mine > 0u ? mine : 1u; nx = cnt > 0u ? cnt : 1u;
}

__device__ __forceinline__ void xcd_barrier(const XcdBarrier& b) {
    asm volatile("s_waitcnt vmcnt(0)" ::: "memory");
    __syncthreads();
    if (threadIdx.x == 0) {
        unsigned* bar = b.bar;
        __builtin_amdgcn_s_waitcnt(0);
        unsigned nloc = b.st[0], nx = b.st[1];
        if (nloc == 0u) { xcd_barrier_complete(bar, b.x, nloc, nx); b.st[0] = nloc; b.st[1] = nx; }
        const unsigned old = xb_add(&bar[XB_XSUB(b.x)], 1u);
        const unsigned gen = old / nloc;
        if (old + 1u == (gen + 1u) * nloc) {
            __builtin_amdgcn_fence(__ATOMIC_RELEASE, "agent");
            asm volatile("s_waitcnt vmcnt(0)" ::: "memory");
            const unsigned og = xb_add(&bar[XB_TOP], 1u);
            const unsigned tg = og / nx;
            if (og + 1u == (tg + 1u) * nx) xb_add(&bar[XB_TOPGEN], 1u);
            else XB_SPIN(xb_ld(&bar[XB_TOPGEN]) == tg, bar);
            __builtin_amdgcn_fence(__ATOMIC_ACQUIRE, "agent");
            xb_add(&bar[XB_XGEN(b.x)], 1u);
            asm volatile("s_waitcnt vmcnt(0)" ::: "memory");
        } else {
            XB_SPIN(xb_ld(&bar[XB_XGEN(b.x)]) == gen, bar);
            __builtin_amdgcn_fence(__ATOMIC_ACQUIRE, "agent");
            asm volatile("s_waitcnt vmcnt(0)" ::: "memory");
        }
    }
    __syncthreads();
}

struct Frame {
    LAS unsigned char* lds;
    volatile LAS unsigned* MISC;
    gu32* ctl;
    int wave;
    int vcu, G;
};
__device__ __forceinline__ unsigned pkbf(float lo, float hi) { return pg8::cvt_pk_bf16(lo, hi); }
__device__ __forceinline__ float rnd6(float v) { return __uint_as_float((__float_as_uint(v) + 0x10000u) & 0xfffe0000u); }
__device__ __forceinline__ unsigned pkw(float lo, float hi) { return pg8::cvt_pk_bf16(rnd6(lo), rnd6(hi)); }
__device__ __forceinline__ float shfl_xor_l(float v, int mask, int lane) { return __int_as_float(__builtin_amdgcn_ds_bpermute((lane ^ mask) << 2, __float_as_int(v))); }
__device__ __forceinline__ float wave_sum(float v, int lane) {
#pragma unroll
    for (int o = 1; o < 64; o <<= 1) v += shfl_xor_l(v, o, lane);
    return v;
}
template <int ILV = 0, bool HF = false> __device__ __forceinline__ void transpose_item(const float* W, int K, int N, bf16* WT, LAS float* scr, int item, int lane, int ldk = 0, int kofs = 0) {
    if (ldk == 0) ldk = K;
    const int nblk = N / 32, kb = item / nblk, nb = item % nblk, k0 = 64 * kb, n0 = 32 * nb;
    const int d0 = ILV == 1 ? ((n0 < DFF) ? (n0 / 128) * 256 + (n0 % 128) : ((n0 - DFF) / 128) * 256 + 128 + ((n0 - DFF) % 128))
                 : ILV == 2 ? ((n0 < OFF_GA) ? n0 : (n0 < OFF_GCV) ? OFF_GA + ((n0 - OFF_GA) / 128) * 256 + ((n0 - OFF_GA) % 128) : OFF_GA + ((n0 - OFF_GCV) / 128) * 256 + 128 + ((n0 - OFF_GCV) % 128)) : n0;
#pragma unroll 8
    for (int i = 0; i < 32; ++i) { const int kk = 2 * i + (lane >> 5); scr[kk * 33 + (lane & 31)] = W[(size_t)(k0 + kk) * N + n0 + (lane & 31)]; }
    LDS_WAIT(); asm volatile("" ::: "memory");
    const int c = lane & 7;
#pragma unroll
    for (int j = 0; j < 4; ++j) { const int n = (lane >> 3) + 8 * j; const LAS float* s = scr + (8 * c) * 33 + n;
        v4u o;
        if constexpr (HF) { o.x = pg8::pk_h2(s[0 * 33], s[1 * 33]); o.y = pg8::pk_h2(s[2 * 33], s[3 * 33]); o.z = pg8::pk_h2(s[4 * 33], s[5 * 33]); o.w = pg8::pk_h2(s[6 * 33], s[7 * 33]); }
        else { o.x = pkw(s[0 * 33], s[1 * 33]); o.y = pkw(s[2 * 33], s[3 * 33]); o.z = pkw(s[4 * 33], s[5 * 33]); o.w = pkw(s[6 * 33], s[7 * 33]); }
        *(GAS v4u*)(WT + (size_t)(d0 + n) * ldk + kofs + k0 + 8 * c) = o; }
    LDS_WAIT(); asm volatile("" ::: "memory");
}
template <bool FOUT> __device__ __forceinline__ void ln_row_h(bf16* hrow, const float* g, const float* b, float* orow_f, int lane, bool poison, bf16* brow = nullptr) {
    GAS v4u* xr = (GAS v4u*)hrow + lane;
    float v[8][8]; float s = 0.f;
#pragma unroll
    for (int j = 0; j < 8; ++j) { const v4u w = xr[64 * j];
        v[j][0] = pg8::h_lo(w.x); v[j][1] = pg8::h_hi(w.x); v[j][2] = pg8::h_lo(w.y); v[j][3] = pg8::h_hi(w.y); v[j][4] = pg8::h_lo(w.z); v[j][5] = pg8::h_hi(w.z); v[j][6] = pg8::h_lo(w.w); v[j][7] = pg8::h_hi(w.w);
#pragma unroll
        for (int i = 0; i < 8; ++i) s += v[j][i]; }
    const float mean = wave_sum(s, lane) * (1.f / DM); float s2 = 0.f;
#pragma unroll
    for (int j = 0; j < 8; ++j)
#pragma unroll
        for (int i = 0; i < 8; ++i) { v[j][i] -= mean; s2 += v[j][i] * v[j][i]; }
    float rstd = 1.f / sqrtf(wave_sum(s2, lane) * (1.f / DM) + LN_EPS);
    if (poison) rstd = __builtin_nanf("");
#pragma unroll
    for (int j = 0; j < 8; ++j) { const int e0 = 8 * (lane + 64 * j); const f32x4 g0 = *(const GAS f32x4*)(g + e0), g1 = *(const GAS f32x4*)(g + e0 + 4), b0 = *(const GAS f32x4*)(b + e0), b1 = *(const GAS f32x4*)(b + e0 + 4);
        const f32x4 o0 = (f32x4){v[j][0], v[j][1], v[j][2], v[j][3]} * rstd * g0 + b0, o1 = (f32x4){v[j][4], v[j][5], v[j][6], v[j][7]} * rstd * g1 + b1;
        if constexpr (FOUT) { *(GAS f32x4*)(orow_f + e0) = o0; *(GAS f32x4*)(orow_f + e0 + 4) = o1; }
        else { v4u w; w.x = pg8::pk_h2(o0[0], o0[1]); w.y = pg8::pk_h2(o0[2], o0[3]); w.z = pg8::pk_h2(o1[0], o1[1]); w.w = pg8::pk_h2(o1[2], o1[3]); xr[64 * j] = w;
               v4u wb; wb.x = pkbf(o0[0], o0[1]); wb.y = pkbf(o0[2], o0[3]); wb.z = pkbf(o1[0], o1[1]); wb.w = pkbf(o1[2], o1[3]); ((GAS v4u*)brow)[lane + 64 * j] = wb; } }
}
__device__ __forceinline__ void unpack8(const v4u w, float (&f)[8]) {
    f[0] = __uint_as_float(w.x << 16); f[1] = __uint_as_float(w.x & 0xffff0000u); f[2] = __uint_as_float(w.y << 16); f[3] = __uint_as_float(w.y & 0xffff0000u);
    f[4] = __uint_as_float(w.z << 16); f[5] = __uint_as_float(w.z & 0xffff0000u); f[6] = __uint_as_float(w.w << 16); f[7] = __uint_as_float(w.w & 0xffff0000u);
}
__device__ __forceinline__ v4u pack8f(const float (&f)[8]) { v4u o; o.x = pkbf(f[0], f[1]); o.y = pkbf(f[2], f[3]); o.z = pkbf(f[4], f[5]); o.w = pkbf(f[6], f[7]); return o; }

typedef const void __attribute__((address_space(4)))* karg_ptr_t;
template <int OFF> __device__ __forceinline__ unsigned long long karg_u64() {
    unsigned long long v; karg_ptr_t kp = (karg_ptr_t)__builtin_amdgcn_kernarg_segment_ptr();
    asm volatile("s_load_dwordx2 %0, %1, %2\n\ts_waitcnt lgkmcnt(0)" : "=s"(v) : "s"(kp), "i"(OFF)); return v; }
template <int OFF> __device__ __forceinline__ int karg_i32() {
    int v; karg_ptr_t kp = (karg_ptr_t)__builtin_amdgcn_kernarg_segment_ptr();
    asm volatile("s_load_dword %0, %1, %2\n\ts_waitcnt lgkmcnt(0)" : "=s"(v) : "s"(kp), "i"(OFF)); return v; }
#define KARG_F(k) ((const float*)(const GAS float*)karg_u64<8 * (k)>())
#define KARG_OUT() ((float*)(GAS float*)karg_u64<144>())
#define KARG_WS() ((unsigned char*)(GAS unsigned char*)karg_u64<152>())
__device__ __forceinline__ int lane_id() { int l; asm volatile("v_mbcnt_lo_u32_b32 %0, -1, 0\n\tv_mbcnt_hi_u32_b32 %0, -1, %0" : "=v"(l)); return l; }

struct RevOrder : pg8::StaticOrder {
    __device__ bool next(int i, pg8::Unit& u) const { if (!pg8::StaticOrder::next(i, u)) return false; u.pn = nN - 1 - u.pn; return true; } };
struct Order4 : pg8::StaticOrder {
    __device__ bool next(int i, pg8::Unit& u) const {
        const long L = (long)i * G + c; if (L >= nwg) return false;
        int wgid = (int)L; { const int q = nwg / pg8::NXCD, r = nwg % pg8::NXCD, xcd = wgid % pg8::NXCD, off = wgid / pg8::NXCD; wgid = (xcd < r ? xcd * (q + 1) : r * (q + 1) + (xcd - r) * q) + off; }
        constexpr int W4 = 4; const int nig = W4 * nN, gid = wgid / nig, fm = gid * W4, gsz = (nM - fm) < W4 ? (nM - fm) : W4;
        u.pm = fm + ((wgid % nig) % gsz); u.pn = (wgid % nig) / gsz; return true;
    } };
struct Args { const float* in[18]; float* out; unsigned char* ws; int ph_lo, ph_hi, li, pad; };
__global__ void __launch_bounds__(NWAVES * 64, 2) fwd(Args  ) {
    extern __shared__ __attribute__((aligned(16))) unsigned char lds[];
    Frame F;
    F.lds = (LAS unsigned char*)lds;
    F.MISC = (volatile LAS unsigned*)(F.lds + MISC_OFF);
    F.wave = __builtin_amdgcn_readfirstlane((int)threadIdx.x >> 6);
    F.G = gridDim.x; { const int bx = blockIdx.x; F.vcu = (F.G % 8 == 0) ? (bx % 8) * (F.G / 8) + bx / 8 : bx; }
    F.ctl = (gu32*)(KARG_WS() + WS_CTL);
    for (int u = threadIdx.x; u < (LDS_BYTES - LDSCTL_OFF) / 4; u += NWAVES * 64) ((LAS unsigned*)(F.lds + LDSCTL_OFF))[u] = 0u;
    __syncthreads();
    XcdBarrier bar; bar.bar = (unsigned*)(F.ctl + CW_BAR); bar.x = 0; bar.st = nullptr;
    if (!MK_PER_PHASE) bar = xcd_barrier_post((unsigned*)(F.ctl + CW_BAR), F.MISC + 8);
#define GRID_BAR() do { if (!MK_PER_PHASE) xcd_barrier(bar); } while (0)
#if MK_PER_PHASE
    const int lo = karg_i32<160>(), hi = karg_i32<164>();
#else
    constexpr int lo = 0, hi = NPH;
#endif
#define IN(k) (lo <= (k) && (k) < hi)
#define BOTH(k) (IN(k) && IN((k) + 1))
    const int gw = F.vcu * NWAVES + F.wave, NGW = F.G * NWAVES;
    LAS float* scr = (LAS float*)(F.lds + RING_OFF + F.wave * 16384);

    if (IN(0)) {
        const int lane = lane_id();
        unsigned char* const ws = KARG_WS(); bf16* const XB = (bf16*)((unsigned char*)KARG_OUT() + DO_XB);
        constexpr int I_IN = (DM / 64) * (NIN / 32), I_A = (CWID / 64) * (DM / 32), I_O = (DM / 64) * (DM / 32), I_UP = (DM / 64) * (NUP / 32), I_DN = (DFF / 64) * (DM / 32);
        constexpr int NIT = I_IN + 2 * I_A + I_O + I_UP + I_DN;
        const float* const w_in = KARG_F(1); const float* const w_ao = KARG_F(8); const float* const w_co = KARG_F(9); const float* const w_o = KARG_F(10); const float* const xin = KARG_F(0);
        const float* const w_up = KARG_F(13); const float* const w_dn = KARG_F(15);
        for (int it = gw; it < NIT; it += NGW) {
            int r = it;
            if (r < I_IN) { transpose_item<2>(w_in, DM, NIN, (bf16*)(ws + WS_WIN), scr, r, lane); continue; } r -= I_IN;
            if (r < I_A) { transpose_item(w_ao, CWID, DM, (bf16*)(ws + WS_WA), scr, r, lane, 2 * CWID, 0); continue; } r -= I_A;
            if (r < I_A) { transpose_item(w_co, CWID, DM, (bf16*)(ws + WS_WA), scr, r, lane, 2 * CWID, CWID); continue; } r -= I_A;
            if (r < I_O) { transpose_item(w_o, DM, DM, (bf16*)(ws + WS_WO), scr, r, lane); continue; } r -= I_O;
            if (r < I_UP) { transpose_item<1>(w_up, DM, NUP, (bf16*)(ws + WS_WUP), scr, r, lane); continue; } r -= I_UP;
            transpose_item(w_dn, DFF, DM, (bf16*)(ws + WS_WDN), scr, r, lane);
        }
        const size_t n8 = (size_t)M * DM / 8;
        for (size_t i = (size_t)blockIdx.x * (NWAVES * 64) + F.wave * 64 + lane; i < n8; i += (size_t)F.G * (NWAVES * 64)) {
            const f32x4 a = ((const GAS f32x4*)xin)[2 * i], b = ((const GAS f32x4*)xin)[2 * i + 1];
            v4u o; o.x = pkbf(a.x, a.y); o.y = pkbf(a.z, a.w); o.z = pkbf(b.x, b.y); o.w = pkbf(b.z, b.w);
            ((GAS v4u*)XB)[i] = o;
        }
        if (BOTH(0)) GRID_BAR();
    }
    if (IN(1)) {
        unsigned char* const ws = KARG_WS(); bf16* const Win_t = (bf16*)(ws + WS_WIN); bf16* const XB = (bf16*)((unsigned char*)KARG_OUT() + DO_XB); bf16* const PROJ = (bf16*)(ws + WS_PROJ);
        pg8::Gemm g{XB, Win_t, M, NIN, DM}; RevOrder S; S.init(M, NIN, F.G, (int)blockIdx.x);
        pg8::EpiProj E{PROJ, NIN, OFF_GA, OFF_GCV};
        pg8::gemm_phase<pg8::EpiProj, RevOrder, true, true>(F.lds + RING_OFF, g, S, E);
        if (BOTH(1)) GRID_BAR();
    }
    if (IN(2)) {
        const int lane = lane_id();
        unsigned char* const ws = KARG_WS();
        float s1, s2; { const float* const q1 = KARG_F(2); const float* const k1 = KARG_F(3); const float* const q2 = KARG_F(4); const float* const k2 = KARG_F(5);
          s1 = q1[lane] * k1[lane] + q1[lane + 64] * k1[lane + 64]; s1 = wave_sum(s1, lane); s2 = q2[lane] * k2[lane] + q2[lane + 64] * k2[lane + 64]; s2 = wave_sum(s2, lane); }
        const da::Ctx C{(const swa::bf16*)(ws + WS_PROJ), (swa::bf16*)(ws + WS_ATTN), KARG_F(6), expf(s1) - expf(s2) + LAM_INIT};
        da::phase(C, (char*)lds + RING_OFF, (float*)((char*)lds + HALO_LDS_OFF), (char*)lds + QSP_LDS_OFF, F.vcu, F.G);
        if (MK_PER_PHASE == 0) { asm volatile("s_waitcnt vmcnt(0)" ::: "memory"); __syncthreads(); }
    }
    if (IN(3)) {
        const int lane = lane_id();
        unsigned char* const ws = KARG_WS(); bf16* const PROJ = (bf16*)(ws + WS_PROJ); float* const O1 = (float*)((unsigned char*)KARG_OUT() + DO_O1); float* const O2 = (float*)((unsigned char*)KARG_OUT() + DO_O2); bf16* const YC = (bf16*)(ws + WS_ATTN) + CWID;
        const float* const conv_w = KARG_F(7);
        for (int it = gw; it < (M / 32) * 4; it += NGW) {
            const int run = it >> 2, c = (it & 3) * 512 + lane * 8, t0 = run * 32;
            float w0[8], w1[8], w2[8], p1[8], p2[8];
            { const GAS f32x4* cw = (const GAS f32x4*)(conv_w + c);
              const f32x4 a = cw[0], b = cw[1], c1 = cw[CWID / 4], d1 = cw[CWID / 4 + 1], e = cw[2 * CWID / 4], f = cw[2 * CWID / 4 + 1];
              w0[0] = a.x; w0[1] = a.y; w0[2] = a.z; w0[3] = a.w; w0[4] = b.x; w0[5] = b.y; w0[6] = b.z; w0[7] = b.w;
              w1[0] = c1.x; w1[1] = c1.y; w1[2] = c1.z; w1[3] = c1.w; w1[4] = d1.x; w1[5] = d1.y; w1[6] = d1.z; w1[7] = d1.w;
              w2[0] = e.x; w2[1] = e.y; w2[2] = e.z; w2[3] = e.w; w2[4] = f.x; w2[5] = f.y; w2[6] = f.z; w2[7] = f.w; }
            if ((t0 & (SEQ - 1)) == 0) {
#pragma unroll
                for (int j = 0; j < 8; ++j) { p1[j] = 0.f; p2[j] = 0.f; }
            } else {
                float ua[8], ga[8], ub[8], gb2[8];
                unpack8(*(const GAS v4u*)(PROJ + (size_t)(t0 - 1) * NIN + OFF_U + c), ua); unpack8(*(const GAS v4u*)(PROJ + (size_t)(t0 - 1) * NIN + OFF_GC + c), ga);
                unpack8(*(const GAS v4u*)(PROJ + (size_t)(t0 - 2) * NIN + OFF_U + c), ub); unpack8(*(const GAS v4u*)(PROJ + (size_t)(t0 - 2) * NIN + OFF_GC + c), gb2);
#pragma unroll
                for (int j = 0; j < 8; ++j) { p1[j] = ua[j] * ga[j]; p2[j] = ub[j] * gb2[j]; }
            }
#pragma unroll 4
            for (int i = 0; i < 32; ++i) {
                const size_t rowo = (size_t)(t0 + i) * NIN + c;
                float uu[8], gc[8], gbv[8], y[8];
                unpack8(*(const GAS v4u*)(PROJ + rowo + OFF_U), uu); unpack8(*(const GAS v4u*)(PROJ + rowo + OFF_GC), gc); unpack8(*(const GAS v4u*)(PROJ + rowo + OFF_GB), gbv);
#pragma unroll
                for (int j = 0; j < 8; ++j) { const float p0 = uu[j] * gc[j]; y[j] = gbv[j] * (w0[j] * p2[j] + w1[j] * p1[j] + w2[j] * p0); p2[j] = p1[j]; p1[j] = p0; }
                *(GAS v4u*)(YC + (size_t)(t0 + i) * (2 * CWID) + c) = pack8f(y);
            }
        }
        if (BOTH(3)) GRID_BAR();
    }
    if (IN(4)) {
        unsigned char* const ws = KARG_WS(); bf16* const PROJ = (bf16*)(ws + WS_PROJ);
        pg8::Gemm g{(bf16*)(ws + WS_ATTN), (bf16*)(ws + WS_WA), M, DM, 2 * CWID}; pg8::StaticOrder S; S.init(M, DM, F.G, (int)blockIdx.x);
        pg8::EpiGateMerge E{(bf16*)(ws + WS_MERGED), DM, PROJ + OFF_GA, PROJ + OFF_GCV, NIN};
        pg8::gemm_phase<pg8::EpiGateMerge, pg8::StaticOrder, true, true, true>(F.lds + RING_OFF, g, S, E);
        if (BOTH(4)) GRID_BAR();
    }
    if (IN(6)) {
        unsigned char* const ws = KARG_WS(); float* const out = KARG_OUT(); bf16* const Wo_t = (bf16*)(ws + WS_WO); bf16* const MERGED = (bf16*)(ws + WS_MERGED);
        pg8::Gemm g{MERGED, Wo_t, M, DM, DM}; pg8::StaticOrder S; S.init(M, DM, F.G, (int)blockIdx.x);
        pg8::EpiResidH<false> E{KARG_F(0), (bf16*)out};
        pg8::gemm_phase<pg8::EpiResidH<false>, pg8::StaticOrder, true, true>(F.lds + RING_OFF, g, S, E);
        if (BOTH(6)) GRID_BAR();
    }
    if (IN(7)) {
        const int lane = lane_id();
        unsigned char* const ws = KARG_WS(); float* const out = KARG_OUT(); bf16* const H1B = (bf16*)(ws + WS_H1B);
        { const float* const g1 = KARG_F(11); const float* const b1 = KARG_F(12);
          for (int t = gw; t < M; t += NGW) ln_row_h<false>((bf16*)out + (size_t)t * DM, g1, b1, nullptr, lane, false, H1B + (size_t)t * DM); }
        if (BOTH(7)) GRID_BAR();
    }
    if (IN(8)) {
        unsigned char* const ws = KARG_WS(); bf16* const H1B = (bf16*)(ws + WS_H1B); bf16* const Wup_t = (bf16*)(ws + WS_WUP); bf16* const GB = (bf16*)(ws + WS_G);
        pg8::Gemm g{H1B, Wup_t, M, NUP, DM}; pg8::StaticOrder S; S.init(M, NUP, F.G, (int)blockIdx.x);
        pg8::EpiConvSilu E{GB, DFF, KARG_F(14), NUP, DFF, (float*)(ws + WS_HALO), NUP / 256, (LAS float*)(F.lds + HALO_LDS_OFF)};
        pg8::gemm_phase<pg8::EpiConvSilu, pg8::StaticOrder, true, true>(F.lds + RING_OFF, g, S, E);
        if (BOTH(8)) GRID_BAR();
    }
    if (IN(9)) {
        const int lane = lane_id();
        unsigned char* const ws = KARG_WS(); const float* const halo = (const float*)(ws + WS_HALO); bf16* const GB = (bf16*)(ws + WS_G); const float* const ffn_cw = KARG_F(14);
        constexpr int NPN = NUP / 256, NITEM = (M / 256) * NPN * 32;
        for (int it = blockIdx.x * (NWAVES * 64) + F.wave * 64 + lane; it < NITEM; it += F.G * (NWAVES * 64)) {
            const int q = it & 31, t = it >> 5, pn = t % NPN, pm = t / NPN, lc = q * 4, ch = pn * 128 + lc;
            const GAS float* hc = (const GAS float*)halo + ((size_t)pm * NPN + pn) * 1024;
            const f32x4 g0 = *(const GAS f32x4*)(hc + lc), g1 = *(const GAS f32x4*)(hc + 256 + lc), v0 = *(const GAS f32x4*)(hc + 128 + lc), v1 = *(const GAS f32x4*)(hc + 256 + 128 + lc);
            f32x4 gp2 = {0.f, 0.f, 0.f, 0.f}, gp1 = gp2, vp2 = gp2, vp1 = gp2;
            if ((pm & 31) != 0) { const GAS float* hp = hc - (size_t)NPN * 1024; gp2 = *(const GAS f32x4*)(hp + 512 + lc); gp1 = *(const GAS f32x4*)(hp + 768 + lc); vp2 = *(const GAS f32x4*)(hp + 512 + 128 + lc); vp1 = *(const GAS f32x4*)(hp + 768 + 128 + lc); }
            f32x4 wg[3], wv[3];
#pragma unroll
            for (int k = 0; k < 3; ++k) { wg[k] = *(const GAS f32x4*)(ffn_cw + (size_t)k * NUP + ch); wv[k] = *(const GAS f32x4*)(ffn_cw + (size_t)k * NUP + DFF + ch); }
            const f32x4 cg0 = wg[0] * gp2 + wg[1] * gp1 + wg[2] * g0, cv0 = wv[0] * vp2 + wv[1] * vp1 + wv[2] * v0;
            const f32x4 cg1 = wg[0] * gp1 + wg[1] * g0 + wg[2] * g1, cv1 = wv[0] * vp1 + wv[1] * v0 + wv[2] * v1;
            float y0[4], y1[4];
#pragma unroll
            for (int i = 0; i < 4; ++i) { y0[i] = cg0[i] * pg8::sigm(cg0[i]) * cv0[i]; y1[i] = cg1[i] * pg8::sigm(cg1[i]) * cv1[i]; }
            *(GAS unsigned long long*)(GB + (size_t)(pm * 256) * DFF + ch) = (unsigned long long)pkbf(y0[0], y0[1]) | ((unsigned long long)pkbf(y0[2], y0[3]) << 32);
            *(GAS unsigned long long*)(GB + (size_t)(pm * 256 + 1) * DFF + ch) = (unsigned long long)pkbf(y1[0], y1[1]) | ((unsigned long long)pkbf(y1[2], y1[3]) << 32);
        }
        if (BOTH(9)) GRID_BAR();
    }
    if (IN(10)) {
        unsigned char* const ws = KARG_WS(); float* const out = KARG_OUT(); bf16* const GB = (bf16*)(ws + WS_G); bf16* const Wdn_t = (bf16*)(ws + WS_WDN);
        pg8::Gemm g{GB, Wdn_t, M, DM, DFF}; Order4 S; S.init(M, DM, F.G, (int)blockIdx.x);
        pg8::EpiResidH<true> E{(const void*)out, (bf16*)(ws + WS_H1B)};
        pg8::gemm_phase<pg8::EpiResidH<true>, Order4, true, true>(F.lds + RING_OFF, g, S, E);
        if (BOTH(10)) GRID_BAR();
    }
    if (IN(11)) {
        const int lane = lane_id();
        float* const out = KARG_OUT();
        const bool poison = (!MK_PER_PHASE) && (__hip_atomic_load((gu32*)((unsigned*)(F.ctl + CW_BAR) + XB_TMO), RLX_AGENT) != 0u);
        const float* const g2 = KARG_F(16); const float* const b2 = KARG_F(17);
        bf16* const pre2 = (bf16*)(KARG_WS() + WS_H1B);
        for (int t = gw; t < M; t += NGW) ln_row_h<true>(pre2 + (size_t)t * DM, g2, b2, out + (size_t)t * DM, lane, poison);
    }
#undef IN
#undef BOTH
}

extern "C" void kernel_launch(void* const* d_in, const int* in_sizes, int n_in, void* d_out, int out_size, void* d_ws, size_t ws_size, hipStream_t stream) {
    static int grid = 0;
    if (grid == 0) {
        if (n_in != 18 || in_sizes[0] != M * DM || out_size != M * DM || ws_size < WS_END) { fprintf(stderr, "kernel_launch: unexpected shapes (n_in %d, in0 %d, out %d, ws %zu < %zu)\n", n_in, n_in > 0 ? in_sizes[0] : -1, out_size, ws_size, (size_t)WS_END); grid = -1; return; }
        int dev = 0, cus = 0, per_cu = 0;
        if (hipGetDevice(&dev) != hipSuccess || hipDeviceGetAttribute(&cus, hipDeviceAttributeMultiprocessorCount, dev) != hipSuccess) { grid = -1; return; }
        if (hipFuncSetAttribute((const void*)fwd, hipFuncAttributeMaxDynamicSharedMemorySize, LDS_BYTES) != hipSuccess) { fprintf(stderr, "kernel_launch: hipFuncSetAttribute failed\n"); grid = -1; return; }
        if (hipOccupancyMaxActiveBlocksPerMultiprocessor(&per_cu, (const void*)fwd, NWAVES * 64, LDS_BYTES) != hipSuccess || per_cu < 1) { fprintf(stderr, "kernel_launch: occupancy query reports %d\n", per_cu); }
        (void)hipGetLastError();
        grid = cus;
    }
    if (grid < 0) return;
    if (hipMemsetAsync((char*)d_ws + WS_CTL, 0, CTL_ZERO_BYTES, stream) != hipSuccess) return;
    Args a{};
    for (int i = 0; i < 18; ++i) a.in[i] = (const float*)d_in[i];
    a.out = (float*)d_out; a.ws = (unsigned char*)d_ws;
#if MK_PER_PHASE
    for (int p = 0; p < NPH; ++p) { a.ph_lo = p; a.ph_hi = p + 1; a.li = p; hipLaunchKernelGGL(fwd, dim3(grid), dim3(NWAVES * 64), LDS_BYTES, stream, a); }
#else
    a.ph_lo = 0; a.ph_hi = NPH; a.li = 0;
    hipLaunchKernelGGL(fwd, dim3(grid), dim3(NWAVES * 64), LDS_BYTES, stream, a);
#endif
}
```

```cpp
#include <hip/hip_runtime.h>
#include <hip/hip_bf16.h>
#include <cstdio>
#include <cstdint>
namespace pg8 {
#define PG8_LAS __attribute__((address_space(3)))
typedef unsigned short bf16_t;
typedef short bf16x8 __attribute__((ext_vector_type(8)));
typedef float f32x4 __attribute__((ext_vector_type(4)));
typedef unsigned u32x4 __attribute__((ext_vector_type(4)));
constexpr int BM = 256, BK = 64, HALF = 128, HTB = HALF * BK * 2  , STAGE_BYTES = 8 * HTB, NXCD = 8, WGM = 8;

__host__ __device__ __forceinline__ int lds_byte(int r, int c) { const int st = (r >> 4) * 2 + (c >> 5), rr = r & 15, cc = c & 31, ob = rr * 64 + cc * 2; return st * 1024 + (ob ^ (((ob >> 9) & 1) << 5)); }
__host__ __device__ __forceinline__ void stage_rc(int b, int& R, int& C) { const int st = b / 1024, sb = b % 1024, swz = sb ^ (((sb >> 9) & 1) << 5); R = (st >> 1) * 16 + swz / 64; C = (st & 1) * 32 + (swz % 64) / 2; }
__host__ __device__ __forceinline__ int perm32(int rho) { const int n = rho >> 4, i = rho & 15; return 8 * (i >> 2) + 4 * n + (i & 3); }

struct Unit { int pm, pn; };
struct Gemm { const bf16_t* A; const bf16_t* Bt; int M, N, K; };

struct StaticOrder {
    int nM, nN, nwg, G, c;
    __host__ __device__ void init(int M, int N, int G_, int c_) { nM = M / BM; nN = N / BM; nwg = nM * nN; G = G_; c = c_; }
    __host__ __device__ bool next(int i, Unit& u) const {
        const long L = (long)i * G + c; if (L >= nwg) return false;
        int wgid = (int)L; { const int q = nwg / NXCD, r = nwg % NXCD, xcd = wgid % NXCD, off = wgid / NXCD; wgid = (xcd < r ? xcd * (q + 1) : r * (q + 1) + (xcd - r) * q) + off; }
        const int nig = WGM * nN, gid = wgid / nig, fm = gid * WGM, gsz = (nM - fm) < WGM ? (nM - fm) : WGM;
        u.pm = fm + ((wgid % nig) % gsz); u.pn = (wgid % nig) / gsz; return true;
    }
    __device__ __forceinline__ void a_ready(const Unit&) const {}
    __device__ __forceinline__ void done(const Unit&) const {}
};

__device__ __forceinline__ unsigned cvt_pk_bf16(float lo, float hi) { unsigned r; asm volatile("v_cvt_pk_bf16_f32 %0, %1, %2" : "=v"(r) : "v"(lo), "v"(hi)); return r; }
typedef float f32x2 __attribute__((ext_vector_type(2)));
typedef unsigned u32x2 __attribute__((ext_vector_type(2)));
__device__ __forceinline__ float sigm(float v) { return __builtin_amdgcn_rcpf(1.0f + __builtin_amdgcn_exp2f(-1.4426950408889634f * v)); }
__device__ __forceinline__ float bflo(unsigned w) { return __uint_as_float(w << 16); }
__device__ __forceinline__ float bfhi(unsigned w) { return __uint_as_float(w & 0xffff0000u); }
struct EpiProj {
    static constexpr bool PERM = true, AFTER_DRAIN = false;
    bf16_t* O; int ldc; int sig_from; int gc_at;
    __device__ __forceinline__ void operator()(const f32x4 (&acc)[2][2][4][2], const Unit& u, int wr, int wc, int fr, int fq) const {
        const int row0 = u.pm * BM + wr * 64 + fr, col0 = u.pn * BM + wc * 32 + 8 * fq; const bool sg = (u.pn * BM) >= sig_from;
        if (sg) {
            const int ch = ((u.pn * BM - sig_from) >> 1) + wc * 32 + 8 * fq;
#pragma unroll
            for (int ai = 0; ai < 2; ++ai)
#pragma unroll
                for (int m = 0; m < 4; ++m) { bf16_t* rowp = O + (size_t)(row0 + ai * HALF + m * 16) * ldc + ch; float r[8], s[8];
#pragma unroll
                    for (int n = 0; n < 2; ++n)
#pragma unroll
                        for (int i = 0; i < 4; ++i) { const float ea = __builtin_amdgcn_exp2f(-1.4426950408889634f * acc[ai][0][m][n][i]), ec1 = 1.0f + __builtin_amdgcn_exp2f(-1.4426950408889634f * acc[ai][1][m][n][i]);
                            s[4 * n + i] = __builtin_amdgcn_rcpf(ec1); r[4 * n + i] = ec1 * __builtin_amdgcn_rcpf(1.0f + ea); }
                    u32x4 w; w.x = cvt_pk_bf16(r[0], r[1]); w.y = cvt_pk_bf16(r[2], r[3]); w.z = cvt_pk_bf16(r[4], r[5]); w.w = cvt_pk_bf16(r[6], r[7]);
                    *(u32x4*)(rowp + sig_from) = w;
                    w.x = cvt_pk_bf16(s[0], s[1]); w.y = cvt_pk_bf16(s[2], s[3]); w.z = cvt_pk_bf16(s[4], s[5]); w.w = cvt_pk_bf16(s[6], s[7]);
                    *(u32x4*)(rowp + gc_at) = w; }
            return; }
#pragma unroll
        for (int ai = 0; ai < 2; ++ai)
#pragma unroll
            for (int m = 0; m < 4; ++m) { bf16_t* rowp = O + (size_t)(row0 + ai * HALF + m * 16) * ldc + col0;
#pragma unroll
                for (int bj = 0; bj < 2; ++bj) { const f32x4 v0 = acc[ai][bj][m][0], v1 = acc[ai][bj][m][1];
                    u32x4 w; w.x = cvt_pk_bf16(v0[0], v0[1]); w.y = cvt_pk_bf16(v0[2], v0[3]); w.z = cvt_pk_bf16(v1[0], v1[1]); w.w = cvt_pk_bf16(v1[2], v1[3]);
                    *(u32x4*)(rowp + bj * HALF) = w; } }
    }
};
struct EpiPlain {
    static constexpr bool PERM = true, AFTER_DRAIN = false;
    bf16_t* O; int ldc;
    __device__ __forceinline__ void operator()(const f32x4 (&acc)[2][2][4][2], const Unit& u, int wr, int wc, int fr, int fq) const {
        const int row0 = u.pm * BM + wr * 64 + fr, col0 = u.pn * BM + wc * 32 + 8 * fq;
#pragma unroll
        for (int ai = 0; ai < 2; ++ai)
#pragma unroll
            for (int m = 0; m < 4; ++m) { bf16_t* rowp = O + (size_t)(row0 + ai * HALF + m * 16) * ldc + col0;
#pragma unroll
                for (int bj = 0; bj < 2; ++bj) { const f32x4 v0 = acc[ai][bj][m][0], v1 = acc[ai][bj][m][1];
                    u32x4 w; w.x = cvt_pk_bf16(v0[0], v0[1]); w.y = cvt_pk_bf16(v0[2], v0[3]); w.z = cvt_pk_bf16(v1[0], v1[1]); w.w = cvt_pk_bf16(v1[2], v1[3]);
                    *(u32x4*)(rowp + bj * HALF) = w; } }
    }
};
struct EpiGateA {
    static constexpr bool PERM = false, AFTER_DRAIN = false;
    float* P; int ldc; const bf16_t* gate; int ldg;
    __device__ __forceinline__ void operator()(const f32x4 (&acc)[2][2][4][2], const Unit& u, int wr, int wc, int fr, int fq) const {
        const int row0 = u.pm * BM + wr * 64 + fr, col0 = u.pn * BM + wc * 32 + 4 * fq;
#pragma unroll
        for (int ai = 0; ai < 2; ++ai)
#pragma unroll
            for (int m = 0; m < 4; ++m) { const size_t row = (size_t)(row0 + ai * HALF + m * 16);
#pragma unroll
                for (int bj = 0; bj < 2; ++bj)
#pragma unroll
                    for (int n = 0; n < 2; ++n) { const int col = col0 + bj * HALF + n * 16;
                        const u32x2 gw = *(const u32x2*)(gate + row * ldg + col); const f32x4 a = acc[ai][bj][m][n];
                        *(f32x4*)(P + row * ldc + col) = (f32x4){a[0] * bflo(gw.x), a[1] * bfhi(gw.x), a[2] * bflo(gw.y), a[3] * bfhi(gw.y)}; }
                if (m & 1) asm volatile("" ::: "memory"); }
    }
};
struct EpiGateC {
    static constexpr bool PERM = true, AFTER_DRAIN = false;
    const float* P; bf16_t* O; int ldc; const bf16_t* gate; int ldg;
    __device__ __forceinline__ void operator()(const f32x4 (&acc)[2][2][4][2], const Unit& u, int wr, int wc, int fr, int fq) const {
        const int row0 = u.pm * BM + wr * 64 + fr, col0 = u.pn * BM + wc * 32 + 8 * fq;
#pragma unroll
        for (int ai = 0; ai < 2; ++ai)
#pragma unroll
            for (int m = 0; m < 4; ++m) { const size_t row = (size_t)(row0 + ai * HALF + m * 16);
#pragma unroll
                for (int bj = 0; bj < 2; ++bj) { const int col = col0 + bj * HALF;
                    const u32x4 gw = *(const u32x4*)(gate + row * ldg + col); const f32x4 p0 = *(const f32x4*)(P + row * ldc + col), p1 = *(const f32x4*)(P + row * ldc + col + 4);
                    const f32x4 a0 = acc[ai][bj][m][0], a1 = acc[ai][bj][m][1];
                    const float r0 = p0[0] + a0[0] * bflo(gw.x), r1 = p0[1] + a0[1] * bfhi(gw.x), r2 = p0[2] + a0[2] * bflo(gw.y), r3 = p0[3] + a0[3] * bfhi(gw.y);
                    const float r4 = p1[0] + a1[0] * bflo(gw.z), r5 = p1[1] + a1[1] * bfhi(gw.z), r6 = p1[2] + a1[2] * bflo(gw.w), r7 = p1[3] + a1[3] * bfhi(gw.w);
                    u32x4 w; w.x = cvt_pk_bf16(r0, r1); w.y = cvt_pk_bf16(r2, r3); w.z = cvt_pk_bf16(r4, r5); w.w = cvt_pk_bf16(r6, r7);
                    *(u32x4*)(O + row * ldc + col) = w; }
                if (m & 1) asm volatile("" ::: "memory"); }
    }
};
struct EpiResid {
    static constexpr bool PERM = false, AFTER_DRAIN = false;
    const float* base; float* out; int ldc; float alpha;
    __device__ __forceinline__ void operator()(const f32x4 (&acc)[2][2][4][2], const Unit& u, int wr, int wc, int fr, int fq) const {
        const int row0 = u.pm * BM + wr * 64 + fr, col0 = u.pn * BM + wc * 32 + 4 * fq;
#pragma unroll
        for (int ai = 0; ai < 2; ++ai)
#pragma unroll
            for (int m = 0; m < 4; ++m) { const size_t off = (size_t)(row0 + ai * HALF + m * 16) * ldc + col0;
#pragma unroll
                for (int bj = 0; bj < 2; ++bj)
#pragma unroll
                    for (int n = 0; n < 2; ++n) { const f32x4 b = *(const f32x4*)(base + off + bj * HALF + n * 16);
                        *(f32x4*)(out + off + bj * HALF + n * 16) = b * alpha + acc[ai][bj][m][n]; }
                if (m & 1) asm volatile("" ::: "memory"); }
    }
};

struct EpiGateMerge {
    static constexpr bool PERM = true, AFTER_DRAIN = false;
    bf16_t* O; int ldc; const bf16_t* ga; const bf16_t* gc; int ldg;
    __device__ __forceinline__ void mid(f32x4 (&acc)[2][2][4][2], const Unit& u, int wr, int wc, int fr, int fq) const {
        int row0 = u.pm * BM + wr * 64 + fr, col0 = u.pn * BM + wc * 32 + 8 * fq;
        asm volatile("" : "+v"(row0), "+v"(col0));
#pragma unroll
        for (int ai = 0; ai < 2; ++ai) { u32x4 av[4][2];
#pragma unroll
            for (int m = 0; m < 4; ++m)
#pragma unroll
                for (int bj = 0; bj < 2; ++bj) av[m][bj] = *(const u32x4*)(ga + (size_t)(row0 + ai * HALF + m * 16) * ldg + col0 + bj * HALF);
            asm volatile("" ::: "memory");
#pragma unroll
            for (int m = 0; m < 4; ++m)
#pragma unroll
                for (int bj = 0; bj < 2; ++bj) { const u32x4 a = av[m][bj]; f32x4& v0 = acc[ai][bj][m][0]; f32x4& v1 = acc[ai][bj][m][1];
                    v0[0] *= bflo(a.x); v0[1] *= bfhi(a.x); v0[2] *= bflo(a.y); v0[3] *= bfhi(a.y); v1[0] *= bflo(a.z); v1[1] *= bfhi(a.z); v1[2] *= bflo(a.w); v1[3] *= bfhi(a.w); }
            asm volatile("" ::: "memory"); }
    }
    __device__ __forceinline__ void operator()(const f32x4 (&acc)[2][2][4][2], const Unit& u, int wr, int wc, int fr, int fq) const {
        const int row0 = u.pm * BM + wr * 64 + fr, col0 = u.pn * BM + wc * 32 + 8 * fq;
        u32x4 cv[2][4][2];
#pragma unroll
        for (int ai = 0; ai < 2; ++ai)
#pragma unroll
            for (int m = 0; m < 4; ++m)
#pragma unroll
                for (int bj = 0; bj < 2; ++bj) cv[ai][m][bj] = *(const u32x4*)(gc + (size_t)(row0 + ai * HALF + m * 16) * ldg + col0 + bj * HALF);
        asm volatile("" ::: "memory");
#pragma unroll
        for (int ai = 0; ai < 2; ++ai)
#pragma unroll
            for (int m = 0; m < 4; ++m)
#pragma unroll
                for (int bj = 0; bj < 2; ++bj) { const u32x4 c = cv[ai][m][bj]; const f32x4 a0 = acc[ai][bj][m][0], a1 = acc[ai][bj][m][1];
                    u32x4 w; w.x = cvt_pk_bf16(a0[0] * bflo(c.x), a0[1] * bfhi(c.x)); w.y = cvt_pk_bf16(a0[2] * bflo(c.y), a0[3] * bfhi(c.y));
                    w.z = cvt_pk_bf16(a1[0] * bflo(c.z), a1[1] * bfhi(c.z)); w.w = cvt_pk_bf16(a1[2] * bflo(c.w), a1[3] * bfhi(c.w));
                    *(u32x4*)(O + (size_t)(row0 + ai * HALF + m * 16) * ldc + col0 + bj * HALF) = w; }
    }
};

typedef _Float16 h16x2 __attribute__((ext_vector_type(2)));
__device__ __forceinline__ unsigned pk_h2(float lo, float hi) { const h16x2 v = {(_Float16)lo, (_Float16)hi}; return __builtin_bit_cast(unsigned, v); }
__device__ __forceinline__ float h_lo(unsigned w) { return (float)__builtin_bit_cast(h16x2, w)[0]; }
__device__ __forceinline__ float h_hi(unsigned w) { return (float)__builtin_bit_cast(h16x2, w)[1]; }
template <bool BH> struct EpiResidH {
    static constexpr bool PERM = true, AFTER_DRAIN = false;
    const void* base; bf16_t* O;
    static constexpr int ldc = 4096; static constexpr float alpha = 1.189207115002721f;
    __device__ __forceinline__ void operator()(const f32x4 (&acc)[2][2][4][2], const Unit& u, int wr, int wc, int fr, int fq) const {
        const int row0 = u.pm * BM + wr * 64 + fr, col0 = u.pn * BM + wc * 32 + 8 * fq;
#pragma unroll
        for (int ai = 0; ai < 2; ++ai) {
            u32x4 hw[4][2]; f32x4 fw[4][2][2];
#pragma unroll
            for (int m = 0; m < 4; ++m)
#pragma unroll
                for (int bj = 0; bj < 2; ++bj) { const size_t off = (size_t)(row0 + ai * HALF + m * 16) * ldc + col0 + bj * HALF;
                    if constexpr (BH) hw[m][bj] = *(const u32x4*)((const bf16_t*)base + off);
                    else { fw[m][bj][0] = *(const f32x4*)((const float*)base + off); fw[m][bj][1] = *(const f32x4*)((const float*)base + off + 4); } }
            asm volatile("" ::: "memory");
#pragma unroll
            for (int m = 0; m < 4; ++m)
#pragma unroll
                for (int bj = 0; bj < 2; ++bj) { const size_t off = (size_t)(row0 + ai * HALF + m * 16) * ldc + col0 + bj * HALF; f32x4 b0, b1;
                    if constexpr (BH) { const u32x4 h = hw[m][bj]; b0 = (f32x4){h_lo(h.x), h_hi(h.x), h_lo(h.y), h_hi(h.y)}; b1 = (f32x4){h_lo(h.z), h_hi(h.z), h_lo(h.w), h_hi(h.w)}; }
                    else { b0 = fw[m][bj][0]; b1 = fw[m][bj][1]; }
                    const f32x4 v0 = b0 * alpha + acc[ai][bj][m][0], v1 = b1 * alpha + acc[ai][bj][m][1];
                    u32x4 w; w.x = pk_h2(v0[0], v0[1]); w.y = pk_h2(v0[2], v0[3]); w.z = pk_h2(v1[0], v1[1]); w.w = pk_h2(v1[2], v1[3]);
                    *(u32x4*)(O + off) = w; }
            asm volatile("" ::: "memory"); }
    }
};

template <int CTRL> __device__ __forceinline__ float dppf(float old, float src) { return __int_as_float(__builtin_amdgcn_update_dpp(__float_as_int(old), __float_as_int(src), CTRL, 0xf, 0xf, false)); }
#define PG8_CONV2(c0, c1, x0, x1, p0, p1, wc0, wc1, wb0, wb1, wbz0, wbz1, wa0, wa1, waz0, waz1) \
    asm volatile("v_mul_f32 %0, %6, %2\n\tv_mul_f32 %1, %7, %3\n\t" \
                 "v_fmac_f32_dpp %0, %2, %8 row_shr:1 row_mask:0xf bank_mask:0xf\n\tv_fmac_f32_dpp %1, %3, %9 row_shr:1 row_mask:0xf bank_mask:0xf\n\t" \
                 "v_fmac_f32_dpp %0, %4, %10 row_ror:1 row_mask:0xf bank_mask:0xf\n\tv_fmac_f32_dpp %1, %5, %11 row_ror:1 row_mask:0xf bank_mask:0xf\n\t" \
                 "v_fmac_f32_dpp %0, %2, %12 row_shr:2 row_mask:0xf bank_mask:0xf\n\tv_fmac_f32_dpp %1, %3, %13 row_shr:2 row_mask:0xf bank_mask:0xf\n\t" \
                 "v_fmac_f32_dpp %0, %4, %14 row_ror:2 row_mask:0xf bank_mask:0xf\n\tv_fmac_f32_dpp %1, %5, %15 row_ror:2 row_mask:0xf bank_mask:0xf" \
                 : "=&v"(c0), "=&v"(c1) : "v"(x0), "v"(x1), "v"(p0), "v"(p1), "v"(wc0), "v"(wc1), "v"(wb0), "v"(wb1), "v"(wbz0), "v"(wbz1), "v"(wa0), "v"(wa1), "v"(waz0), "v"(waz1))
struct EpiConvSilu {
    static constexpr bool PERM = true, AFTER_DRAIN = false;
    bf16_t* G; int ldg; const float* cw; int nup, dff; float* halo; int nN; PG8_LAS float* H;
    __device__ __forceinline__ void operator()(const f32x4 (&acc)[2][2][4][2], const Unit& u, int wr, int wc, int fr, int fq) const {
        const int lc = wc * 32 + 8 * fq, ch = u.pn * 128 + lc;
#pragma unroll
        for (int ai = 0; ai < 2; ++ai) { const int blk = 2 * ai + wr;
            if (fr >= 14) {
#pragma unroll
                for (int bj = 0; bj < 2; ++bj)
#pragma unroll
                    for (int n = 0; n < 2; ++n) *(PG8_LAS f32x4*)(H + (blk * 2 + (fr - 14)) * 256 + bj * 128 + lc + 4 * n) = acc[ai][bj][3][n]; } }
        float* hg = halo + ((size_t)u.pm * nN + u.pn) * 1024;
        if (wr == 0 && fr < 2) {
#pragma unroll
            for (int bj = 0; bj < 2; ++bj)
#pragma unroll
                for (int n = 0; n < 2; ++n) *(f32x4*)(hg + fr * 256 + bj * 128 + lc + 4 * n) = acc[0][bj][0][n]; }
        if (wr == 1 && fr >= 14) {
#pragma unroll
            for (int bj = 0; bj < 2; ++bj)
#pragma unroll
                for (int n = 0; n < 2; ++n) *(f32x4*)(hg + (2 + fr - 14) * 256 + bj * 128 + lc + 4 * n) = acc[1][bj][3][n]; }
        asm volatile("s_waitcnt lgkmcnt(0)" ::: "memory"); __builtin_amdgcn_s_barrier(); asm volatile("" ::: "memory");
        f32x4 sg[2][4][2];
#pragma unroll
        for (int bj = 0; bj < 2; ++bj) {
            f32x4 wgt[3][2], wbz[2], waz[2];
#pragma unroll
            for (int k = 0; k < 3; ++k)
#pragma unroll
                for (int n = 0; n < 2; ++n) wgt[k][n] = *(const f32x4*)(cw + (size_t)k * nup + bj * dff + ch + 4 * n);
#pragma unroll
            for (int n = 0; n < 2; ++n)
#pragma unroll
                for (int i = 0; i < 4; ++i) { wbz[n][i] = fr == 0 ? wgt[1][n][i] : 0.f; waz[n][i] = fr < 2 ? wgt[0][n][i] : 0.f; }
#pragma unroll
            for (int ai = 0; ai < 2; ++ai) { const int blk = 2 * ai + wr;
                f32x4 pv[2];
#pragma unroll
                for (int n = 0; n < 2; ++n) { pv[n] = (f32x4){0.f, 0.f, 0.f, 0.f};
                    if (blk >= 1 && fr >= 14) pv[n] = *(const PG8_LAS f32x4*)(H + ((blk - 1) * 2 + (fr - 14)) * 256 + bj * 128 + lc + 4 * n); }
#pragma unroll
                for (int mm = 0; mm < 4; ++mm) { const int m = 3 - mm; f32x4 c[2];
#pragma unroll
                    for (int n = 0; n < 2; ++n) { const f32x4 cur = acc[ai][bj][m][n]; const f32x4 prv = (m == 0) ? pv[n] : acc[ai][bj][m == 0 ? 0 : m - 1][n];
#pragma unroll
                        for (int i = 0; i < 4; i += 2) { float c0, c1;
                            PG8_CONV2(c0, c1, cur[i], cur[i + 1], prv[i], prv[i + 1], wgt[2][n][i], wgt[2][n][i + 1], wgt[1][n][i], wgt[1][n][i + 1], wbz[n][i], wbz[n][i + 1],
                                      wgt[0][n][i], wgt[0][n][i + 1], waz[n][i], waz[n][i + 1]);
                            c[n][i] = c0; c[n][i + 1] = c1; } }
                    if (bj == 0) {
#pragma unroll
                        for (int n = 0; n < 2; ++n)
#pragma unroll
                            for (int i = 0; i < 4; ++i) sg[ai][m][n][i] = c[n][i] * sigm(c[n][i]);
                    } else {
                        float y[8];
#pragma unroll
                        for (int n = 0; n < 2; ++n)
#pragma unroll
                            for (int i = 0; i < 4; ++i) y[4 * n + i] = sg[ai][m][n][i] * c[n][i];
                        u32x4 w; w.x = cvt_pk_bf16(y[0], y[1]); w.y = cvt_pk_bf16(y[2], y[3]); w.z = cvt_pk_bf16(y[4], y[5]); w.w = cvt_pk_bf16(y[6], y[7]);
                        *(u32x4*)(G + (size_t)(u.pm * BM + ai * HALF + wr * 64 + m * 16 + fr) * ldg + ch) = w; } } } }
    }
};
typedef _Float16 f16x8 __attribute__((ext_vector_type(8)));
template <bool F16> __device__ __forceinline__ f32x4 mma16(bf16x8 a, bf16x8 b, f32x4 c) {
    if constexpr (F16) return __builtin_amdgcn_mfma_f32_16x16x32_f16(__builtin_bit_cast(f16x8, a), __builtin_bit_cast(f16x8, b), c, 0, 0, 0);
    else return __builtin_amdgcn_mfma_f32_16x16x32_bf16(a, b, c, 0, 0, 0); }
template <class Epi, class Sched, bool ALIGN_EPI = false, bool SP2 = false, bool MID = false, bool F16 = false>
__device__ __forceinline__ void gemm_phase(PG8_LAS unsigned char* lds, const Gemm g, const Sched& S, const Epi& E) {
    int tid_ = threadIdx.x; asm volatile("" : "+v"(tid_));
    const int tid = tid_, wid = __builtin_amdgcn_readfirstlane(tid >> 6), lane = tid & 63, wr = wid >> 2, wc = wid & 3, fr = lane & 15, fq = lane >> 4;
    const int K = g.K, nt = K / BK;
    unsigned voffA[2], voffB[2];
#pragma unroll
    for (int i = 0; i < 2; ++i) { int R, C; stage_rc(tid * 16 + i * 8192, R, C); const int Rb = Epi::PERM ? ((R & ~31) + perm32(R & 31)) : R;
        voffA[i] = (unsigned)(R * K + C) * 2u; voffB[i] = (unsigned)(Rb * K + C) * 2u; }
    const size_t kstep = (size_t)(BK * 2);
    const size_t hstep = (size_t)HALF * K * 2;
    const size_t tstep = 2 * hstep;
    const unsigned ldsw = (unsigned)wid * 1024u;
    const int aoff = lds_byte(wr * 64 + fr, fq * 8), boff = lds_byte(wc * 32 + fr, fq * 8);
#define PG8_SA(b, h) (((b) * 2 + (h)) * HTB)
#define PG8_SB(b, h) ((4 + (b) * 2 + (h)) * HTB)
#define PG8_STAGE(bufoff, gbase, voff) do { _Pragma("unroll") for (int _i = 0; _i < 2; ++_i) \
        __builtin_amdgcn_global_load_lds((const unsigned*)((const char*)(gbase) + (voff)[_i]), (PG8_LAS unsigned*)(lds + (bufoff) + ldsw + _i * 8192), 16, 0, 0); } while (0)
#define PG8_LDA(dst, b, h) do { _Pragma("unroll") for (int m = 0; m < 4; ++m) _Pragma("unroll") for (int k = 0; k < 2; ++k) dst[m][k] = *(const PG8_LAS bf16x8*)(lds + PG8_SA(b, h) + aoff + m * 2048 + k * 1024); } while (0)
#define PG8_LDB(dst, b, h) do { _Pragma("unroll") for (int n = 0; n < 2; ++n) _Pragma("unroll") for (int k = 0; k < 2; ++k) dst[n][k] = *(const PG8_LAS bf16x8*)(lds + PG8_SB(b, h) + boff + n * 2048 + k * 1024); } while (0)
#define PG8_MMA(ai, bj, At, Bt) do { __builtin_amdgcn_s_setprio(1); _Pragma("unroll") for (int m = 0; m < 4; ++m) _Pragma("unroll") for (int n = 0; n < 2; ++n) _Pragma("unroll") for (int k = 0; k < 2; ++k) \
        acc[ai][bj][m][n] = mma16<F16>(Bt[n][k], At[m][k], acc[ai][bj][m][n]); __builtin_amdgcn_s_setprio(0); } while (0)
#define PG8_WAIT_V(n) asm volatile("s_waitcnt vmcnt(" #n ")" ::: "memory")
#define PG8_WAIT_L(n) asm volatile("s_waitcnt lgkmcnt(" #n ")" ::: "memory")
#define PG8_BAR __builtin_amdgcn_s_barrier()
#define PG8_SCHED __builtin_amdgcn_sched_barrier(0)
    Unit cur, nxt; int ui = 0;
    if (!S.next(0, cur)) return;
    f32x4 acc[2][2][4][2];
#pragma unroll
    for (int a = 0; a < 2; ++a)
#pragma unroll
        for (int b = 0; b < 2; ++b)
#pragma unroll
            for (int m = 0; m < 4; ++m)
#pragma unroll
                for (int n = 0; n < 2; ++n) acc[a][b][m][n] = (f32x4){0.f, 0.f, 0.f, 0.f};
    bf16x8 At[4][2], B0[2][2], B1[2][2];
    const char* cA = (const char*)g.A + (size_t)cur.pm * tstep; const char* cB = (const char*)g.Bt + (size_t)cur.pn * tstep;
    S.a_ready(cur);
    if constexpr (SP2) {
        PG8_STAGE(PG8_SB(0, 0), cB, voffB); PG8_STAGE(PG8_SB(0, 1), cB + hstep, voffB); PG8_STAGE(PG8_SA(0, 0), cA, voffA); PG8_STAGE(PG8_SA(0, 1), cA + hstep, voffA);
        if (wr == 1) PG8_BAR;
        PG8_WAIT_V(2); PG8_BAR;
        PG8_STAGE(PG8_SB(1, 0), cB + kstep, voffB); PG8_STAGE(PG8_SA(1, 0), cA + kstep, voffA); PG8_STAGE(PG8_SB(1, 1), cB + hstep + kstep, voffB);
        PG8_WAIT_V(6); PG8_BAR;
    } else {
        PG8_STAGE(PG8_SB(0, 0), cB, voffB); PG8_STAGE(PG8_SA(0, 0), cA, voffA); PG8_STAGE(PG8_SB(0, 1), cB + hstep, voffB); PG8_STAGE(PG8_SA(0, 1), cA + hstep, voffA);
        if (wr == 1) PG8_BAR;
        PG8_WAIT_V(4); PG8_BAR;
        PG8_STAGE(PG8_SB(1, 0), cB + kstep, voffB); PG8_STAGE(PG8_SA(1, 0), cA + kstep, voffA); PG8_STAGE(PG8_SB(1, 1), cB + hstep + kstep, voffB);
        PG8_WAIT_V(6); PG8_BAR;
    }
    for (;;) {
        const bool has_next = S.next(ui + 1, nxt);
        const char* nA = has_next ? (const char*)g.A + (size_t)nxt.pm * tstep : cA; const char* nB = has_next ? (const char*)g.Bt + (size_t)nxt.pn * tstep : cB;
        for (int t = 0; t < nt; t += 2) {
            if constexpr (MID) { if (t == (nt >> 1)) E.mid(acc, cur, wr, wc, fr, fq); }
            const bool last = (t == nt - 2);
            const char* a1 = cA + (size_t)(t + 1) * kstep;
            const char* a2 = last ? nA : cA + (size_t)(t + 2) * kstep; const char* b2 = last ? nB : cB + (size_t)(t + 2) * kstep;
            const char* a3 = a2 + kstep; const char* b3 = b2 + kstep;
            if (last && has_next) S.a_ready(nxt);
            if constexpr (SP2) {
            PG8_LDB(B0, 0, 0); PG8_LDB(B1, 0, 1); PG8_SCHED; PG8_LDA(At, 0, 0); PG8_STAGE(PG8_SA(1, 1), a1 + hstep, voffA);
            PG8_WAIT_V(8); PG8_WAIT_L(0); PG8_BAR; PG8_MMA(0, 0, At, B0); PG8_MMA(0, 1, At, B1); PG8_BAR; PG8_SCHED;
            PG8_LDA(At, 0, 1); PG8_STAGE(PG8_SB(0, 0), b2, voffB); PG8_STAGE(PG8_SB(0, 1), b2 + hstep, voffB); PG8_STAGE(PG8_SA(0, 0), a2, voffA);
            PG8_WAIT_V(8); PG8_WAIT_L(0); PG8_BAR; PG8_MMA(1, 0, At, B0); PG8_MMA(1, 1, At, B1); PG8_BAR; PG8_SCHED;
            PG8_LDB(B0, 1, 0); PG8_LDB(B1, 1, 1); PG8_SCHED; PG8_LDA(At, 1, 0); PG8_STAGE(PG8_SA(0, 1), a2 + hstep, voffA);
            PG8_WAIT_V(8); PG8_WAIT_L(0); PG8_BAR; PG8_MMA(0, 0, At, B0); PG8_MMA(0, 1, At, B1); PG8_BAR; PG8_SCHED;
            PG8_LDA(At, 1, 1); PG8_STAGE(PG8_SB(1, 0), b3, voffB); PG8_STAGE(PG8_SB(1, 1), b3 + hstep, voffB); PG8_STAGE(PG8_SA(1, 0), a3, voffA);
            PG8_WAIT_V(8); PG8_WAIT_L(0); PG8_BAR; PG8_MMA(1, 0, At, B0); PG8_MMA(1, 1, At, B1); PG8_BAR; PG8_SCHED;
            } else {
            PG8_LDB(B0, 0, 0); PG8_SCHED; PG8_LDA(At, 0, 0); PG8_STAGE(PG8_SA(1, 1), a1 + hstep, voffA);
            PG8_WAIT_L(8); PG8_BAR; PG8_WAIT_L(0); PG8_MMA(0, 0, At, B0); PG8_BAR; PG8_SCHED;
            PG8_LDB(B1, 0, 1); PG8_STAGE(PG8_SB(0, 0), b2, voffB);
            PG8_BAR; PG8_WAIT_L(0); PG8_MMA(0, 1, At, B1); PG8_BAR;
            PG8_LDA(At, 0, 1); PG8_STAGE(PG8_SA(0, 0), a2, voffA);
            PG8_BAR; PG8_WAIT_L(0); PG8_MMA(1, 0, At, B0); PG8_BAR; PG8_SCHED;
            PG8_STAGE(PG8_SB(0, 1), b2 + hstep, voffB);
            PG8_WAIT_V(6); PG8_BAR; PG8_MMA(1, 1, At, B1); PG8_BAR;
            PG8_LDB(B0, 1, 0); PG8_SCHED; PG8_LDA(At, 1, 0); PG8_STAGE(PG8_SA(0, 1), a2 + hstep, voffA);
            PG8_WAIT_L(8); PG8_BAR; PG8_WAIT_L(0); PG8_MMA(0, 0, At, B0); PG8_BAR; PG8_SCHED;
            PG8_LDB(B1, 1, 1); PG8_STAGE(PG8_SB(1, 0), b3, voffB);
            PG8_BAR; PG8_WAIT_L(0); PG8_MMA(0, 1, At, B1); PG8_BAR;
            PG8_LDA(At, 1, 1); PG8_STAGE(PG8_SA(1, 0), a3, voffA);
            PG8_BAR; PG8_WAIT_L(0); PG8_MMA(1, 0, At, B0); PG8_BAR; PG8_SCHED;
            PG8_STAGE(PG8_SB(1, 1), b3 + hstep, voffB);
            PG8_WAIT_V(6); PG8_BAR; PG8_MMA(1, 1, At, B1); PG8_BAR;
            }
        }
        if constexpr (ALIGN_EPI) { if (wr == 0) PG8_BAR; }
        if constexpr (!Epi::AFTER_DRAIN) { E(acc, cur, wr, wc, fr, fq); S.done(cur); }
        if (!has_next) break;
#pragma unroll
        for (int a = 0; a < 2; ++a)
#pragma unroll
            for (int b = 0; b < 2; ++b)
#pragma unroll
                for (int m = 0; m < 4; ++m)
#pragma unroll
                    for (int n = 0; n < 2; ++n) acc[a][b][m][n] = (f32x4){0.f, 0.f, 0.f, 0.f};
        cur = nxt; cA = nA; cB = nB; ++ui;
        if constexpr (ALIGN_EPI) { if (wr == 1) PG8_BAR; }
    }
    PG8_WAIT_V(0);
    if constexpr (!ALIGN_EPI) { if (wr == 0) PG8_BAR; }
    PG8_BAR;
    if constexpr (Epi::AFTER_DRAIN) { E.fused(acc, cur, wr, wc, fr, fq, lds, wid, lane); S.done(cur); }
#undef PG8_SA
#undef PG8_SB
#undef PG8_STAGE
#undef PG8_LDA
#undef PG8_LDB
#undef PG8_MMA
#undef PG8_WAIT_V
#undef PG8_WAIT_L
#undef PG8_BAR
#undef PG8_SCHED
}
}
namespace swa {
constexpr int D = 128;
constexpr int LDP = 20480;
constexpr int LDO = 2048;
constexpr float THR = 8.f;
constexpr bool WSKIP = false;
constexpr float SCALE = 0.08838834764831845f;
constexpr int NW = 8, QBLK = 32, KVBLK = 64, QB = NW * QBLK;
constexpr int SHM_V = KVBLK * D * 2, SHM_K = KVBLK * D * 2;
constexpr int LDS_BYTES = 2 * SHM_V + 2 * SHM_K + NW * 64 * 4;
static_assert(D == 128, "geometry");

using bf16 = __hip_bfloat16;
typedef short bf16x8 __attribute__((ext_vector_type(8)));
typedef short s16x4 __attribute__((ext_vector_type(4)));
typedef float f32x16 __attribute__((ext_vector_type(16)));
typedef float f32x4 __attribute__((ext_vector_type(4)));
typedef unsigned u32x4 __attribute__((ext_vector_type(4)));
template <class A, class Bt> struct same_t { static constexpr bool v = false; };
template <class A> struct same_t<A, A> { static constexpr bool v = true; };

#define KSWZ(row, colB) ((row) * 256 + ((colB) ^ (((row) & 7) << 4)))
#define SBAR() __builtin_amdgcn_sched_barrier(0)
__device__ __forceinline__ int v_st(int k, int c) { const int kk = (k & ~0xC) | ((k & 4) << 1) | ((k & 8) >> 1); return ((kk >> 3) * 4 + (c >> 5)) * 512 + ((kk & 7) * 32 + (c & 31)) * 2; }
__device__ __forceinline__ int v_rd_base(int lane) { return ((lane & 3) << 3) | (((lane >> 2) & 3) << 6) | (((lane >> 4) & 1) << 5) | (((lane >> 5) & 1) << 8); }
constexpr int v_rd_off(int d0, int ks, int half) { return d0 * 512 + ks * 4096 + half * 2048; }
__device__ __forceinline__ int crow(int r, int hi) { return (r & 3) + 8 * (r >> 2) + 4 * hi; }
__device__ __forceinline__ unsigned cvtpk(float lo, float hi) {
    unsigned r; asm volatile("v_cvt_pk_bf16_f32 %0, %1, %2" : "=v"(r) : "v"(lo), "v"(hi)); return r;
}
__device__ __forceinline__ bf16x8 pack8(f32x4 a, f32x4 b) {
    u32x4 w = {cvtpk(a[0], a[1]), cvtpk(a[2], a[3]), cvtpk(b[0], b[1]), cvtpk(b[2], b[3])};
    return *reinterpret_cast<bf16x8*>(&w);
}
template <class T> __device__ __forceinline__ bf16x8 load8(const T* p) {
    if constexpr (same_t<T, float>::v) { return pack8(*(const f32x4*)p, *(const f32x4*)(p + 4)); }
    else { return *reinterpret_cast<const bf16x8*>(p); }
}
__device__ __forceinline__ void mask_tile(f32x16& p0, f32x16& p1, int dq, unsigned W) {
    const float NEG = -__builtin_inff();
#pragma unroll
    for (int r = 0; r < 16; ++r) {
        const int c = (r & 3) + 8 * (r >> 2);
        if ((unsigned)(dq - c) >= W) p0[r] = NEG;
        if ((unsigned)(dq - c - 32) >= W) p1[r] = NEG;
    }
}
__device__ __forceinline__ void partialSM(f32x16& p0, f32x16& p1, float& m_reg, float& mn, float& alpha) {
    float pmax = p0[0]; for (int r = 1; r < 16; ++r) pmax = fmaxf(pmax, p0[r]); for (int r = 0; r < 16; ++r) pmax = fmaxf(pmax, p1[r]);
    { auto rr = __builtin_amdgcn_permlane32_swap(__float_as_uint(pmax), __float_as_uint(pmax), false, false);
      pmax = fmaxf(__uint_as_float(rr[0]), __uint_as_float(rr[1])); }
    constexpr float C2 = 1.4426950408889634f * SCALE;
    if (__builtin_expect(__all((pmax - m_reg) * SCALE <= THR), 1)) { mn = m_reg; alpha = 1.f; }
    else { mn = fmaxf(m_reg, pmax); alpha = __builtin_amdgcn_exp2f((m_reg - mn) * C2); m_reg = mn; }
    const float mnL = -mn * C2;
    for (int r = 0; r < 16; ++r) p0[r] = fmaf(p0[r], C2, mnL); for (int r = 0; r < 16; ++r) p1[r] = fmaf(p1[r], C2, mnL);
    for (int r = 0; r < 16; ++r) p0[r] = __builtin_amdgcn_exp2f(p0[r]);
}
__device__ __forceinline__ void finishSM(f32x16& p0, f32x16& p1, float alpha, float& l_reg, bf16x8& pa0, bf16x8& pa1, bf16x8& pa2, bf16x8& pa3) {
    for (int r = 0; r < 16; ++r) p1[r] = __builtin_amdgcn_exp2f(p1[r]);
    float ps = 0; for (int r = 0; r < 16; ++r) ps += p0[r]; for (int r = 0; r < 16; ++r) ps += p1[r];
    { auto rr = __builtin_amdgcn_permlane32_swap(__float_as_uint(ps), __float_as_uint(ps), false, false);
      ps = __uint_as_float(rr[0]) + __uint_as_float(rr[1]); }
    l_reg = l_reg * alpha + ps;
#define PK4(P, B_, OUT) do { unsigned a0 = cvtpk(P[B_+0], P[B_+1]), a1 = cvtpk(P[B_+2], P[B_+3]);                          \
        unsigned b0 = cvtpk(P[B_+4], P[B_+5]), b1 = cvtpk(P[B_+6], P[B_+7]);                                             \
        auto r0 = __builtin_amdgcn_permlane32_swap(a0, b0, false, false); auto r1 = __builtin_amdgcn_permlane32_swap(a1, b1, false, false); \
        u32x4 w = {r0[0], r1[0], r0[1], r1[1]}; OUT = *reinterpret_cast<bf16x8*>(&w); } while (0)
    PK4(p0, 0, pa0); PK4(p0, 8, pa1); PK4(p1, 0, pa2); PK4(p1, 8, pa3);
#undef PK4
}
template <int KB, bool SK>
__device__ __forceinline__ void qkt(f32x16& p0, f32x16& p1, const char* K_lds, int r32, int hi, const bf16x8* qr, bool act) {
    if (SK && !act) { const float NEG = -__builtin_inff();
#pragma unroll
        for (int r = 0; r < 16; ++r) { p0[r] = NEG; p1[r] = NEG; } return; }
    p0 = f32x16{}; p1 = f32x16{};
    const char* kb[4];
#pragma unroll
    for (int dd = 0; dd < 4; ++dd) kb[dd] = K_lds + KB * SHM_K + KSWZ(r32, (dd * 16 + hi * 8) * 2);
#pragma unroll
    for (int d0 = 0; d0 < 8; ++d0) { const char* a = kb[d0 & 3] + (d0 >> 2) * 128;
        bf16x8 b0 = *reinterpret_cast<const bf16x8*>(a);
        bf16x8 b1 = *reinterpret_cast<const bf16x8*>(a + 32 * 256);
        p0 = __builtin_amdgcn_mfma_f32_32x32x16_bf16(b0, qr[d0], p0, 0, 0, 0);
        p1 = __builtin_amdgcn_mfma_f32_32x32x16_bf16(b1, qr[d0], p1, 0, 0, 0); }
}
template <int VB, bool SK>
__device__ __forceinline__ void pv_tile(f32x16* o, int vb0, bf16x8 pa0, bf16x8 pa1, bf16x8 pa2, bf16x8 pa3, bool act) {
    if (SK && !act) return;
#define TRRD(dst, off) asm volatile("ds_read_b64_tr_b16 %0, %1 offset:%2" : "=&v"(dst) : "v"(vb0), "i"(off) : "memory")
#define PV_D0(d0) do { s16x4 l0, l1, l2, l3, h0, h1, h2, h3; constexpr int b_ = VB * SHM_V + v_rd_off(d0, 0, 0);     \
        TRRD(l0, b_); TRRD(h0, b_ + 2048); TRRD(l1, b_ + 4096); TRRD(h1, b_ + 6144); TRRD(l2, b_ + 8192); TRRD(h2, b_ + 10240); TRRD(l3, b_ + 12288); TRRD(h3, b_ + 14336); \
        asm volatile("s_waitcnt lgkmcnt(0)" ::: "memory"); SBAR();                 \
        o[d0] = __builtin_amdgcn_mfma_f32_32x32x16_bf16(pa0, (bf16x8){l0[0], l0[1], l0[2], l0[3], h0[0], h0[1], h0[2], h0[3]}, o[d0], 0, 0, 0);   \
        o[d0] = __builtin_amdgcn_mfma_f32_32x32x16_bf16(pa1, (bf16x8){l1[0], l1[1], l1[2], l1[3], h1[0], h1[1], h1[2], h1[3]}, o[d0], 0, 0, 0);   \
        o[d0] = __builtin_amdgcn_mfma_f32_32x32x16_bf16(pa2, (bf16x8){l2[0], l2[1], l2[2], l2[3], h2[0], h2[1], h2[2], h2[3]}, o[d0], 0, 0, 0);   \
        o[d0] = __builtin_amdgcn_mfma_f32_32x32x16_bf16(pa3, (bf16x8){l3[0], l3[1], l3[2], l3[3], h3[0], h3[1], h3[2], h3[3]}, o[d0], 0, 0, 0); } while (0)
    PV_D0(0); PV_D0(1); PV_D0(2); PV_D0(3);
#undef PV_D0
#undef TRRD
}

template <class TIn, class TOut> struct BlockRef { const TIn* Q; const TIn* K; const TIn* V; TOut* O; int P0; };
template <class TIn> struct Seam {
    bf16x8 qr[8];
    bf16x8 st_v0, st_v1, st_k0, st_k1; f32x4 sf0, sf1, sf2, sf3;
    f32x4 tq[16];
};
__device__ __forceinline__ int swa_jlo(int P0, int W) { const int lowk = P0 - W + 1; return lowk > 0 ? lowk / KVBLK : 0; }
#define ROW(p, k0, rr) ((p) + (size_t)((k0) + (rr)) * LDP + sc)
#define VMW() asm volatile("s_waitcnt vmcnt(0)" ::: "memory")
#define VMWN(n) asm volatile("s_waitcnt vmcnt(%0)" :: "i"(n) : "memory")
#define SLOAD_H(Kp, Vp, k0) do { S.st_v0 = load8<TIn>(ROW(Vp, k0, sr)); S.st_v1 = load8<TIn>(ROW(Vp, k0, 32 + sr));              \
                         S.st_k0 = load8<TIn>(ROW(Kp, k0, sr)); S.st_k1 = load8<TIn>(ROW(Kp, k0, 32 + sr)); } while (0)
#define SWRITE_HK(bf) do { *(bf16x8*)(K_lds + (bf) * SHM_K + kws) = S.st_k0; *(bf16x8*)(K_lds + (bf) * SHM_K + kws + 32 * 256) = S.st_k1; } while (0)
#define SWRITE_HV(bf) do { *(bf16x8*)(V_lds + (bf) * SHM_V + vst0) = S.st_v0; *(bf16x8*)(V_lds + (bf) * SHM_V + vst1) = S.st_v1; } while (0)
#define SWRITE_H(bf) do { SWRITE_HV(bf); SWRITE_HK(bf); } while (0)
#define SLOAD_F(p, k0) do { S.sf0 = *(const f32x4*)ROW(p, k0, sr); S.sf1 = *(const f32x4*)(ROW(p, k0, sr) + 4);                \
                            S.sf2 = *(const f32x4*)ROW(p, k0, 32 + sr); S.sf3 = *(const f32x4*)(ROW(p, k0, 32 + sr) + 4); } while (0)
#define SWRITE_KF(bf) do { *(bf16x8*)(K_lds + (bf) * SHM_K + kws) = pack8(S.sf0, S.sf1); *(bf16x8*)(K_lds + (bf) * SHM_K + kws + 32 * 256) = pack8(S.sf2, S.sf3); } while (0)
#define SWRITE_VF(bf) do { *(bf16x8*)(V_lds + (bf) * SHM_V + vst0) = pack8(S.sf0, S.sf1); *(bf16x8*)(V_lds + (bf) * SHM_V + vst1) = pack8(S.sf2, S.sf3); } while (0)
template <class TIn, class TOut>
__device__ __forceinline__ void causal_swa_prime(const BlockRef<TIn, TOut>& cur, int W, char* lds, Seam<TIn>& S) {
    constexpr bool F32 = same_t<TIn, float>::v;
    int tid_ = threadIdx.x; asm volatile("" : "+v"(tid_));
    const int tid = tid_, wid = __builtin_amdgcn_readfirstlane(tid >> 6), lane = tid & 63, r32 = lane & 31, hi = lane >> 5;
    const int sr = tid >> 4, sc = (tid & 15) * 8, kws = KSWZ(sr, sc * 2); char* K_lds = lds + 2 * SHM_V;
    const int kb0 = swa_jlo(cur.P0, W) * KVBLK;
    for (int d0 = 0; d0 < 8; ++d0) S.qr[d0] = load8<TIn>(cur.Q + (size_t)(wid * QBLK + r32) * LDP + d0 * 16 + hi * 8);
    if constexpr (F32) { SLOAD_F((const float*)cur.K, kb0); VMW(); SWRITE_KF(0); SBAR(); SLOAD_F((const float*)cur.V, kb0); }
    else { SLOAD_H(cur.K, cur.V, kb0); VMW(); SWRITE_HK(0); }
    __syncthreads();
}
template <class TIn, class TOut>
__device__ __forceinline__ void causal_swa_block(const BlockRef<TIn, TOut>& cur, const BlockRef<TIn, TOut>& nxt, int skv, int W, char* lds, Seam<TIn>& S) {
    constexpr bool F32 = same_t<TIn, float>::v;
    int tid_ = threadIdx.x; asm volatile("" : "+v"(tid_));
    const int tid = tid_, wid = __builtin_amdgcn_readfirstlane(tid >> 6), lane = tid & 63, r32 = lane & 31, hi = lane >> 5;
    const int j_lo = swa_jlo(cur.P0, W);
    int j_hi = (cur.P0 + QB - 1) / KVBLK + 1; if (j_hi > skv / KVBLK) j_hi = skv / KVBLK;
    const int NT = j_hi - j_lo;
    const int kbn = swa_jlo(nxt.P0, W) * KVBLK;
    const int qlo = cur.P0 + wid * QBLK, qm = qlo + r32 - 4 * hi;
    char* V_lds = lds; char* K_lds = lds + 2 * SHM_V;
    float* ws = (float*)(lds + 2 * SHM_V + 2 * SHM_K) + wid * 64; float* li_l = ws, * al_l = ws + 32;
    float m_reg = -1e30f, l_reg = 0; f32x16 o[4] = {};
    const int sr = tid >> 4, sc = (tid & 15) * 8, vst0 = v_st(sr, sc), vst1 = v_st(32 + sr, sc), kws = KSWZ(sr, sc * 2);
    const int vb0 = (int)(uintptr_t)V_lds + v_rd_base(lane);
    const TIn* Kh = cur.K; const TIn* Vh = cur.V;
#define RESC(a) do { if (__any((a) < 1.f)) { if (hi == 0) al_l[r32] = (a); asm volatile("s_waitcnt lgkmcnt(0)" ::: "memory");              \
                     for (int d_ = 0; d_ < 4; ++d_) for (int r = 0; r < 16; ++r) o[d_][r] *= al_l[crow(r, hi)]; } } while (0)
#define KBASE(t) ((j_lo + (t)) * KVBLK)
#define ACT(t) (KBASE(t) <= qlo + QBLK - 1 && KBASE(t) + KVBLK - 1 >= qlo - W + 1)
#define MASKT(P0_, P1_, t) do { const int kb_ = KBASE(t); if ((!SK || ACT(t)) && (kb_ + KVBLK - 1 > qlo || kb_ <= qlo + QBLK - 1 - W)) mask_tile(P0_, P1_, qm - kb_, (unsigned)W); } while (0)
    constexpr int NQL = F32 ? 16 : 8;
    constexpr bool SK = WSKIP && !F32;
#define SEAM_K0() do { VMWN(NQL); if constexpr (F32) { SWRITE_KF(0); SBAR(); SLOAD_F((const float*)nxt.V, kbn); } else { SWRITE_HK(0); } SBAR(); } while (0)
    f32x16 pA0, pA1, pB0, pB1; float mnA, mnB, alA, alB; bf16x8 pa0, pa1, pa2, pa3;
    if constexpr (F32) { VMW(); SWRITE_VF(0); SBAR(); } else { SWRITE_HV(0); SBAR(); }
    if (NT > 1) { if constexpr (F32) SLOAD_F((const float*)Kh, KBASE(1)); else SLOAD_H(Kh, Vh, KBASE(1)); }
    SBAR(); qkt<0, SK>(pA0, pA1, K_lds, r32, hi, S.qr, ACT(0));
    if constexpr (F32) { if (NT > 1) { VMW(); SWRITE_KF(1); SBAR(); SLOAD_F((const float*)Vh, KBASE(1)); } }
    MASKT(pA0, pA1, 0); partialSM(pA0, pA1, m_reg, mnA, alA);
    if (NT > 1) { VMW(); if constexpr (F32) { SWRITE_VF(1); SBAR(); if (NT > 2) SLOAD_F((const float*)Kh, KBASE(2)); } else SWRITE_H(1); }
    __syncthreads();
#define HALF_STEP(PX0, PX1, mnX, alX, PY0, PY1, alY, t, KB, VB, SB) do {                                                      \
        SBAR(); qkt<KB, SK>(PX0, PX1, K_lds, r32, hi, S.qr, ACT(t));                                             \
        finishSM(PY0, PY1, alY, l_reg, pa0, pa1, pa2, pa3); SBAR();                                                           \
        if ((t) + 1 < NT) { if constexpr (F32) { VMW(); SWRITE_KF(SB); SBAR(); SLOAD_F((const float*)Vh, KBASE((t) + 1)); }  \
                            else { SLOAD_H(Kh, Vh, KBASE((t) + 1)); } SBAR(); }                                               \
        pv_tile<VB, SK>(o, vb0, pa0, pa1, pa2, pa3, ACT((t) - 1)); MASKT(PX0, PX1, (t)); partialSM(PX0, PX1, m_reg, mnX, alX);                                        \
        __syncthreads();                                                                                                      \
        if ((t) + 1 < NT) { VMW(); if constexpr (F32) { SWRITE_VF(SB); SBAR(); if ((t) + 2 < NT) SLOAD_F((const float*)Kh, KBASE((t) + 2)); } \
                            else { SWRITE_H(SB); } }                                                                          \
        RESC(alX); __syncthreads(); } while (0)
    for (int t = 1; t + 1 < NT; t += 2) {
        HALF_STEP(pB0, pB1, mnB, alB, pA0, pA1, alA, t, 1, 0, 0);
        HALF_STEP(pA0, pA1, mnA, alA, pB0, pB1, alB, t + 1, 0, 1, 1);
    }
    const bool even = (NT & 1) == 0;
    if (even) { SBAR(); qkt<1, SK>(pB0, pB1, K_lds, r32, hi, S.qr, ACT(NT - 1)); SBAR(); }
#define QROW(e) (nxt.Q + (size_t)(wid * QBLK + r32) * LDP + ((e) >> 1) * 16 + hi * 8 + ((e) & 1) * 4)
    if constexpr (F32) { SLOAD_F((const float*)nxt.K, kbn); SBAR();
#pragma unroll
        for (int e = 0; e < 8; ++e) S.tq[e] = *(const f32x4*)QROW(e); }
    else { SLOAD_H(nxt.K, nxt.V, kbn); SBAR();
#pragma unroll
        for (int d0 = 0; d0 < 8; ++d0) S.qr[d0] = load8<TIn>(nxt.Q + (size_t)(wid * QBLK + r32) * LDP + d0 * 16 + hi * 8); }
    SBAR();
    finishSM(pA0, pA1, alA, l_reg, pa0, pa1, pa2, pa3); SBAR();
    if constexpr (F32) {
#pragma unroll
        for (int e = 8; e < 16; ++e) S.tq[e] = *(const f32x4*)QROW(e); SBAR(); }
#undef QROW
    pv_tile<0, SK>(o, vb0, pa0, pa1, pa2, pa3, ACT(even ? NT - 2 : NT - 1));
    if (even) { MASKT(pB0, pB1, NT - 1); partialSM(pB0, pB1, m_reg, mnB, alB); __syncthreads(); RESC(alB);
        finishSM(pB0, pB1, alB, l_reg, pa0, pa1, pa2, pa3); SBAR(); pv_tile<1, SK>(o, vb0, pa0, pa1, pa2, pa3, ACT(NT - 1)); }
    SBAR(); SEAM_K0();
    if (hi == 0) li_l[r32] = l_reg; asm volatile("s_waitcnt lgkmcnt(0)" ::: "memory");
    float rli[16];
#pragma unroll
    for (int r = 0; r < 16; ++r) rli[r] = __builtin_amdgcn_rcpf(li_l[crow(r, hi)]);
    TOut* Ow = cur.O + (size_t)(wid * QBLK) * LDO;
#pragma unroll
    for (int r = 0; r < 16; ++r) { const int orow = crow(r, hi);
#pragma unroll
        for (int d0 = 0; d0 < 4; ++d0) { const float v = o[d0][r] * rli[r];
            if constexpr (same_t<TOut, float>::v) { Ow[(size_t)orow * LDO + d0 * 32 + r32] = v; }
            else { const float vn = __shfl_xor(v, 1);
                   if ((r32 & 1) == 0) *(unsigned*)(Ow + (size_t)orow * LDO + d0 * 32 + r32) = cvtpk(v, vn); } } }
    if constexpr (F32) {
#pragma unroll
        for (int d0 = 0; d0 < 8; ++d0) S.qr[d0] = pack8(S.tq[2 * d0], S.tq[2 * d0 + 1]); }
    __syncthreads();
#undef RESC
#undef KBASE
#undef ACT
#undef MASKT
#undef SEAM_K0
#undef HALF_STEP
}
#undef ROW
#undef VMW
#undef VMWN
#undef SLOAD_H
#undef SWRITE_HK
#undef SWRITE_HV
#undef SWRITE_H
#undef SLOAD_F
#undef SWRITE_KF
#undef SWRITE_VF

}
namespace da {
using namespace swa;
constexpr int SEQ_LEN = 8192, ATT_LD = 4096;
constexpr int STAGE_B = 65536, OFF_K = 0, OFF_V = 32768, QROWS = 128;
typedef __attribute__((address_space(3))) unsigned lds_u32;
typedef float f32x4v __attribute__((ext_vector_type(4)));
__device__ __forceinline__ void dma16(const bf16* g, char* lds_dst_uniform) { __builtin_amdgcn_global_load_lds((const unsigned*)g, (lds_u32*)lds_dst_uniform, 16, 0, 0); }
__device__ __forceinline__ f32x4v mfma16(bf16x8 a, bf16x8 b, f32x4v c) { return __builtin_amdgcn_mfma_f32_16x16x32_bf16(a, b, c, 0, 0, 0); }
__device__ __forceinline__ float bpx(float v, int lane, int mask) { return __int_as_float(__builtin_amdgcn_ds_bpermute((lane ^ mask) << 2, __float_as_int(v))); }
struct Ctx { const bf16* proj; bf16* att; const float* subln_g; float lam; };
__device__ __forceinline__ void issue_tile(const bf16* Kg, const bf16* Vg, int k0, char* stage, int wid, int lane_) {
    const bf16* kb = Kg + (size_t)k0 * LDP;
    int lane = lane_; asm volatile("" : "+v"(lane));
#pragma unroll
    for (int i = 0; i < 2; ++i) { const int c = 2 * wid + i, row = 4 * c + (lane >> 4), gch = (lane & 15) ^ (row & 7), ko = row * LDP + gch * 8;
        char* dst = stage + (2 * wid + i) * 1024; dma16(kb + ko, dst + OFF_K); dma16(kb + 128 + ko, dst + OFF_K + 16384); }
    const int ks = wid >> 2;
#pragma unroll
    for (int i = 0; i < 4; ++i) { const int c = (4 * wid + i) & 7, row = 8 * (c >> 1) + ((lane >> 2) & 7), ch = 4 * (2 * (c & 1) + (lane >> 5)) + ((lane & 3) ^ ((row >> 2) & 3));
        const bf16* src = (Vg + (size_t)(k0 + 32 * ks) * LDP + 128 * ((wid >> 1) & 1)) + (row * LDP + 8 * ch);
        dma16(src, stage + OFF_V + (4 * wid + i) * 1024); }
}
#define DA16_TR(dst, addr, off) asm volatile("ds_read_b64_tr_b16 %0, %1 offset:%2" : "=&v"(dst) : "v"(addr), "i"(off) : "memory")
#define DA16_FR(l, h) (bf16x8){l[0], l[1], l[2], l[3], h[0], h[1], h[2], h[3]}
__device__ __forceinline__ void p_swap16(bf16x8 x, bf16x8 y, bf16x8& lo, bf16x8& hi16) {
    u32x4 xv = *reinterpret_cast<u32x4*>(&x), yv = *reinterpret_cast<u32x4*>(&y), l, h;
#pragma unroll
    for (int j = 0; j < 4; ++j) { auto r = __builtin_amdgcn_permlane16_swap(xv[j], yv[j], false, false); l[j] = r[0]; h[j] = r[1]; }
    lo = *reinterpret_cast<bf16x8*>(&l); hi16 = *reinterpret_cast<bf16x8*>(&h);
}
__device__ __forceinline__ void qkt6(f32x16& p0, f32x16& p1, const char* K_lds, int r32, int hi, const bf16x8 (&qr)[6], const char* qsp_l) {
    p0 = f32x16{}; p1 = f32x16{};
    const char* kb[4];
#pragma unroll
    for (int dd = 0; dd < 4; ++dd) kb[dd] = K_lds + KSWZ(r32, (dd * 16 + hi * 8) * 2);
#pragma unroll
    for (int d0 = 0; d0 < 8; ++d0) { const char* a = kb[d0 & 3] + (d0 >> 2) * 128;
        bf16x8 b0 = *reinterpret_cast<const bf16x8*>(a);
        bf16x8 b1 = *reinterpret_cast<const bf16x8*>(a + 32 * 256);
        bf16x8 q; if (d0 < 6) q = qr[d0 < 6 ? d0 : 0]; else q = *reinterpret_cast<const bf16x8*>(qsp_l + (d0 - 6) * 1024);
        p0 = __builtin_amdgcn_mfma_f32_32x32x16_bf16(b0, q, p0, 0, 0, 0);
        p1 = __builtin_amdgcn_mfma_f32_32x32x16_bf16(b1, q, p1, 0, 0, 0); }
}
__device__ __forceinline__ void finishSM16(f32x16& p0, f32x16& p1, float alpha, float& l_reg, bf16x8& P00, bf16x8& P10, bf16x8& P01, bf16x8& P11) {
    for (int r = 0; r < 16; ++r) p1[r] = __builtin_amdgcn_exp2f(p1[r]);
    float ps = 0; for (int r = 0; r < 16; ++r) ps += p0[r]; for (int r = 0; r < 16; ++r) ps += p1[r];
    { auto rr = __builtin_amdgcn_permlane32_swap(__float_as_uint(ps), __float_as_uint(ps), false, false);
      ps = __uint_as_float(rr[0]) + __uint_as_float(rr[1]); }
    l_reg = l_reg * alpha + ps;
#define DA_PSW(P, LO, HI) do { u32x4 l_, h_; _Pragma("unroll") for (int j = 0; j < 4; ++j) { \
        auto r_ = __builtin_amdgcn_permlane16_swap(cvtpk(P[2 * j], P[2 * j + 1]), cvtpk(P[8 + 2 * j], P[8 + 2 * j + 1]), false, false); l_[j] = r_[0]; h_[j] = r_[1]; } \
        LO = *reinterpret_cast<bf16x8*>(&l_); HI = *reinterpret_cast<bf16x8*>(&h_); } while (0)
    DA_PSW(p0, P00, P10); DA_PSW(p1, P01, P11);
#undef DA_PSW
}
template <int ST>
__device__ __forceinline__ void step(f32x4v (&o)[2][16], const bf16x8 (&qr)[6], const char* qsp_w, float& m_reg, float& l_reg, char* lds, float* al_l, int map,
                                     bool need_mask, int dqu  , bool more, const bf16* Kg, const bf16* Vg, int k_next, int wid) {
    asm volatile("s_waitcnt vmcnt(0)" ::: "memory"); __builtin_amdgcn_s_barrier(); asm volatile("" ::: "memory");
    int lane_; asm volatile("v_mbcnt_lo_u32_b32 %0, -1, 0\n\tv_mbcnt_hi_u32_b32 %0, -1, %0" : "=v"(lane_));
    const int r32 = lane_ & 31, hi = lane_ >> 5, dq = dqu + r32 - 4 * hi;
    if (more) issue_tile(Kg, Vg, k_next, lds + (ST ^ 1) * STAGE_B, wid, lane_);
    bf16x8 P00, P10, P01, P11;
    { f32x16 p0, p1; float mn, alpha;
      qkt6(p0, p1, lds + ST * STAGE_B + OFF_K + map * 16384, r32, hi, qr, qsp_w + lane_ * 16);
      if (need_mask) mask_tile(p0, p1, dq, 0x7fffffffu);
      partialSM(p0, p1, m_reg, mn, alpha);
      finishSM16(p0, p1, alpha, l_reg, P00, P10, P01, P11);
      if (__any(alpha < 1.f)) { if (hi == 0) al_l[r32] = alpha; asm volatile("s_waitcnt lgkmcnt(0)" ::: "memory");
          int lq = lane_; asm volatile("" : "+v"(lq)); const int fqr = lq >> 4;
#pragma unroll
          for (int qb = 0; qb < 2; ++qb) { const f32x4v a4 = *(const f32x4v*)(al_l + 16 * qb + 4 * fqr);
#pragma unroll
              for (int c = 0; c < 16; ++c) o[qb][c] *= a4; } }
    }
    int lane = lane_; asm volatile("" : "+v"(lane));
    const int fr = lane & 15, fq = lane >> 4, g0 = (fq & 1) << 1, th = fq >> 1;
    const int vq = fr >> 2, vp = fr & 3;
    const int vb00 = 2048 * g0 + 64 * (4 * th + vq) + 16 * ((vp >> 1) ^ ((2 * g0 + th) & 3)) + 8 * (vp & 1), vb10 = 2048 * (g0 + 1) + 64 * (4 * th + vq) + 16 * ((vp >> 1) ^ ((2 * (g0 + 1) + th) & 3)) + 8 * (vp & 1);
    const int vst = (int)(uintptr_t)lds + ST * STAGE_B + OFF_V;
    const int va00 = vst + vb00, va10 = vst + vb10;
    s16x4 fl0, fh0, fl1, fh1, fl2, fh2;
    asm volatile("s_waitcnt lgkmcnt(0)" ::: "memory");
    DA16_TR(fl0, va00, 0); DA16_TR(fh0, va10, 0); DA16_TR(fl1, (va00 ^ 32), 0); DA16_TR(fh1, (va10 ^ 32), 0);
    DA16_TR(fl2, va00, 512); DA16_TR(fh2, va10, 512); asm volatile("s_waitcnt lgkmcnt(4)" ::: "memory"); SBAR(); { const bf16x8 vf = DA16_FR(fl0, fh0); o[0][0] = mfma16(P00, vf, o[0][0]); o[1][0] = mfma16(P10, vf, o[1][0]); } SBAR();
    DA16_TR(fl0, (va00 ^ 32), 512); DA16_TR(fh0, (va10 ^ 32), 512); asm volatile("s_waitcnt lgkmcnt(4)" ::: "memory"); SBAR(); { const bf16x8 vf = DA16_FR(fl1, fh1); o[0][1] = mfma16(P00, vf, o[0][1]); o[1][1] = mfma16(P10, vf, o[1][1]); } SBAR();
    DA16_TR(fl1, va00, 1024); DA16_TR(fh1, va10, 1024); asm volatile("s_waitcnt lgkmcnt(4)" ::: "memory"); SBAR(); { const bf16x8 vf = DA16_FR(fl2, fh2); o[0][2] = mfma16(P00, vf, o[0][2]); o[1][2] = mfma16(P10, vf, o[1][2]); } SBAR();
    DA16_TR(fl2, (va00 ^ 32), 1024); DA16_TR(fh2, (va10 ^ 32), 1024); asm volatile("s_waitcnt lgkmcnt(4)" ::: "memory"); SBAR(); { const bf16x8 vf = DA16_FR(fl0, fh0); o[0][3] = mfma16(P00, vf, o[0][3]); o[1][3] = mfma16(P10, vf, o[1][3]); } SBAR();
    DA16_TR(fl0, va00, 1536); DA16_TR(fh0, va10, 1536); asm volatile("s_waitcnt lgkmcnt(4)" ::: "memory"); SBAR(); { const bf16x8 vf = DA16_FR(fl1, fh1); o[0][4] = mfma16(P00, vf, o[0][4]); o[1][4] = mfma16(P10, vf, o[1][4]); } SBAR();
    DA16_TR(fl1, (va00 ^ 32), 1536); DA16_TR(fh1, (va10 ^ 32), 1536); asm volatile("s_waitcnt lgkmcnt(4)" ::: "memory"); SBAR(); { const bf16x8 vf = DA16_FR(fl2, fh2); o[0][5] = mfma16(P00, vf, o[0][5]); o[1][5] = mfma16(P10, vf, o[1][5]); } SBAR();
    DA16_TR(fl2, va00, 8192); DA16_TR(fh2, va10, 8192); asm volatile("s_waitcnt lgkmcnt(4)" ::: "memory"); SBAR(); { const bf16x8 vf = DA16_FR(fl0, fh0); o[0][6] = mfma16(P00, vf, o[0][6]); o[1][6] = mfma16(P10, vf, o[1][6]); } SBAR();
    DA16_TR(fl0, (va00 ^ 32), 8192); DA16_TR(fh0, (va10 ^ 32), 8192); asm volatile("s_waitcnt lgkmcnt(4)" ::: "memory"); SBAR(); { const bf16x8 vf = DA16_FR(fl1, fh1); o[0][7] = mfma16(P00, vf, o[0][7]); o[1][7] = mfma16(P10, vf, o[1][7]); } SBAR();
    DA16_TR(fl1, va00, 8704); DA16_TR(fh1, va10, 8704); asm volatile("s_waitcnt lgkmcnt(4)" ::: "memory"); SBAR(); { const bf16x8 vf = DA16_FR(fl2, fh2); o[0][8] = mfma16(P00, vf, o[0][8]); o[1][8] = mfma16(P10, vf, o[1][8]); } SBAR();
    DA16_TR(fl2, (va00 ^ 32), 8704); DA16_TR(fh2, (va10 ^ 32), 8704); asm volatile("s_waitcnt lgkmcnt(4)" ::: "memory"); SBAR(); { const bf16x8 vf = DA16_FR(fl0, fh0); o[0][9] = mfma16(P00, vf, o[0][9]); o[1][9] = mfma16(P10, vf, o[1][9]); } SBAR();
    DA16_TR(fl0, va00, 9216); DA16_TR(fh0, va10, 9216); asm volatile("s_waitcnt lgkmcnt(4)" ::: "memory"); SBAR(); { const bf16x8 vf = DA16_FR(fl1, fh1); o[0][10] = mfma16(P00, vf, o[0][10]); o[1][10] = mfma16(P10, vf, o[1][10]); } SBAR();
    DA16_TR(fl1, (va00 ^ 32), 9216); DA16_TR(fh1, (va10 ^ 32), 9216); asm volatile("s_waitcnt lgkmcnt(4)" ::: "memory"); SBAR(); { const bf16x8 vf = DA16_FR(fl2, fh2); o[0][11] = mfma16(P00, vf, o[0][11]); o[1][11] = mfma16(P10, vf, o[1][11]); } SBAR();
    DA16_TR(fl2, va00, 9728); DA16_TR(fh2, va10, 9728); asm volatile("s_waitcnt lgkmcnt(4)" ::: "memory"); SBAR(); { const bf16x8 vf = DA16_FR(fl0, fh0); o[0][12] = mfma16(P00, vf, o[0][12]); o[1][12] = mfma16(P10, vf, o[1][12]); } SBAR();
    DA16_TR(fl0, (va00 ^ 32), 9728); DA16_TR(fh0, (va10 ^ 32), 9728); asm volatile("s_waitcnt lgkmcnt(4)" ::: "memory"); SBAR(); { const bf16x8 vf = DA16_FR(fl1, fh1); o[0][13] = mfma16(P00, vf, o[0][13]); o[1][13] = mfma16(P10, vf, o[1][13]); } SBAR();
    DA16_TR(fl1, va00, 16384); DA16_TR(fh1, va10, 16384); asm volatile("s_waitcnt lgkmcnt(4)" ::: "memory"); SBAR(); { const bf16x8 vf = DA16_FR(fl2, fh2); o[0][14] = mfma16(P00, vf, o[0][14]); o[1][14] = mfma16(P10, vf, o[1][14]); } SBAR();
    DA16_TR(fl2, (va00 ^ 32), 16384); DA16_TR(fh2, (va10 ^ 32), 16384); asm volatile("s_waitcnt lgkmcnt(4)" ::: "memory"); SBAR(); { const bf16x8 vf = DA16_FR(fl0, fh0); o[0][15] = mfma16(P00, vf, o[0][15]); o[1][15] = mfma16(P10, vf, o[1][15]); } SBAR();
    DA16_TR(fl0, va00, 16896); DA16_TR(fh0, va10, 16896); asm volatile("s_waitcnt lgkmcnt(4)" ::: "memory"); SBAR(); { const bf16x8 vf = DA16_FR(fl1, fh1); o[0][0] = mfma16(P01, vf, o[0][0]); o[1][0] = mfma16(P11, vf, o[1][0]); } SBAR();
    DA16_TR(fl1, (va00 ^ 32), 16896); DA16_TR(fh1, (va10 ^ 32), 16896); asm volatile("s_waitcnt lgkmcnt(4)" ::: "memory"); SBAR(); { const bf16x8 vf = DA16_FR(fl2, fh2); o[0][1] = mfma16(P01, vf, o[0][1]); o[1][1] = mfma16(P11, vf, o[1][1]); } SBAR();
    DA16_TR(fl2, va00, 17408); DA16_TR(fh2, va10, 17408); asm volatile("s_waitcnt lgkmcnt(4)" ::: "memory"); SBAR(); { const bf16x8 vf = DA16_FR(fl0, fh0); o[0][2] = mfma16(P01, vf, o[0][2]); o[1][2] = mfma16(P11, vf, o[1][2]); } SBAR();
    DA16_TR(fl0, (va00 ^ 32), 17408); DA16_TR(fh0, (va10 ^ 32), 17408); asm volatile("s_waitcnt lgkmcnt(4)" ::: "memory"); SBAR(); { const bf16x8 vf = DA16_FR(fl1, fh1); o[0][3] = mfma16(P01, vf, o[0][3]); o[1][3] = mfma16(P11, vf, o[1][3]); } SBAR();
    DA16_TR(fl1, va00, 17920); DA16_TR(fh1, va10, 17920); asm volatile("s_waitcnt lgkmcnt(4)" ::: "memory"); SBAR(); { const bf16x8 vf = DA16_FR(fl2, fh2); o[0][4] = mfma16(P01, vf, o[0][4]); o[1][4] = mfma16(P11, vf, o[1][4]); } SBAR();
    DA16_TR(fl2, (va00 ^ 32), 17920); DA16_TR(fh2, (va10 ^ 32), 17920); asm volatile("s_waitcnt lgkmcnt(4)" ::: "memory"); SBAR(); { const bf16x8 vf = DA16_FR(fl0, fh0); o[0][5] = mfma16(P01, vf, o[0][5]); o[1][5] = mfma16(P11, vf, o[1][5]); } SBAR();
    DA16_TR(fl0, va00, 24576); DA16_TR(fh0, va10, 24576); asm volatile("s_waitcnt lgkmcnt(4)" ::: "memory"); SBAR(); { const bf16x8 vf = DA16_FR(fl1, fh1); o[0][6] = mfma16(P01, vf, o[0][6]); o[1][6] = mfma16(P11, vf, o[1][6]); } SBAR();
    DA16_TR(fl1, (va00 ^ 32), 24576); DA16_TR(fh1, (va10 ^ 32), 24576); asm volatile("s_waitcnt lgkmcnt(4)" ::: "memory"); SBAR(); { const bf16x8 vf = DA16_FR(fl2, fh2); o[0][7] = mfma16(P01, vf, o[0][7]); o[1][7] = mfma16(P11, vf, o[1][7]); } SBAR();
    DA16_TR(fl2, va00, 25088); DA16_TR(fh2, va10, 25088); asm volatile("s_waitcnt lgkmcnt(4)" ::: "memory"); SBAR(); { const bf16x8 vf = DA16_FR(fl0, fh0); o[0][8] = mfma16(P01, vf, o[0][8]); o[1][8] = mfma16(P11, vf, o[1][8]); } SBAR();
    DA16_TR(fl0, (va00 ^ 32), 25088); DA16_TR(fh0, (va10 ^ 32), 25088); asm volatile("s_waitcnt lgkmcnt(4)" ::: "memory"); SBAR(); { const bf16x8 vf = DA16_FR(fl1, fh1); o[0][9] = mfma16(P01, vf, o[0][9]); o[1][9] = mfma16(P11, vf, o[1][9]); } SBAR();
    DA16_TR(fl1, va00, 25600); DA16_TR(fh1, va10, 25600); asm volatile("s_waitcnt lgkmcnt(4)" ::: "memory"); SBAR(); { const bf16x8 vf = DA16_FR(fl2, fh2); o[0][10] = mfma16(P01, vf, o[0][10]); o[1][10] = mfma16(P11, vf, o[1][10]); } SBAR();
    DA16_TR(fl2, (va00 ^ 32), 25600); DA16_TR(fh2, (va10 ^ 32), 25600); asm volatile("s_waitcnt lgkmcnt(4)" ::: "memory"); SBAR(); { const bf16x8 vf = DA16_FR(fl0, fh0); o[0][11] = mfma16(P01, vf, o[0][11]); o[1][11] = mfma16(P11, vf, o[1][11]); } SBAR();
    DA16_TR(fl0, va00, 26112); DA16_TR(fh0, va10, 26112); asm volatile("s_waitcnt lgkmcnt(4)" ::: "memory"); SBAR(); { const bf16x8 vf = DA16_FR(fl1, fh1); o[0][12] = mfma16(P01, vf, o[0][12]); o[1][12] = mfma16(P11, vf, o[1][12]); } SBAR();
    DA16_TR(fl1, (va00 ^ 32), 26112); DA16_TR(fh1, (va10 ^ 32), 26112); asm volatile("s_waitcnt lgkmcnt(4)" ::: "memory"); SBAR(); { const bf16x8 vf = DA16_FR(fl2, fh2); o[0][13] = mfma16(P01, vf, o[0][13]); o[1][13] = mfma16(P11, vf, o[1][13]); } SBAR();
    asm volatile("s_waitcnt lgkmcnt(2)" ::: "memory"); SBAR(); { const bf16x8 vf = DA16_FR(fl0, fh0); o[0][14] = mfma16(P01, vf, o[0][14]); o[1][14] = mfma16(P11, vf, o[1][14]); } SBAR();
    asm volatile("s_waitcnt lgkmcnt(0)" ::: "memory"); SBAR(); { const bf16x8 vf = DA16_FR(fl1, fh1); o[0][15] = mfma16(P01, vf, o[0][15]); o[1][15] = mfma16(P11, vf, o[1][15]); } SBAR();
}
__device__ __forceinline__ void unit(const Ctx& C, int b, int h, int qi, char* lds, float* wsf, char* qsp) {
    int tid_ = threadIdx.x; asm volatile("" : "+v"(tid_));
    const int tid = tid_, wid = __builtin_amdgcn_readfirstlane(tid >> 6), lane = tid & 63, r32 = lane & 31, hi = lane >> 5;
    const int map = wid >> 2, wq = wid & 3, q0 = qi * QROWS, NT = 2 * qi + 2;
    const size_t row0 = (size_t)b * SEQ_LEN;
    const bf16* Kg = C.proj + row0 * LDP + 2048 + h * 256;
    const bf16* Vg = C.proj + row0 * LDP + 4096 + h * 256;
    const bf16* Qg = C.proj + (row0 + q0 + wq * 32) * LDP + h * 256 + map * 128;
    float* al_l = wsf + wid * 64; float* li_l = al_l + 32;
    issue_tile(Kg, Vg, 0, lds, wid, lane);
    bf16x8 qr[6]; const char* qsp_w = qsp + wid * 2048;
#pragma unroll
    for (int d0 = 0; d0 < 6; ++d0) qr[d0] = load8<bf16>(Qg + (size_t)r32 * LDP + d0 * 16 + hi * 8);
#pragma unroll
    for (int d0 = 6; d0 < 8; ++d0) *(bf16x8*)(qsp + wid * 2048 + (d0 - 6) * 1024 + lane * 16) = load8<bf16>(Qg + (size_t)r32 * LDP + d0 * 16 + hi * 8);
    f32x4v o[2][16];
#pragma unroll
    for (int qb = 0; qb < 2; ++qb)
#pragma unroll
        for (int c = 0; c < 16; ++c) { float z0, z1, z2, z3; asm volatile("v_mov_b32 %0, 0\n\tv_mov_b32 %1, 0\n\tv_mov_b32 %2, 0\n\tv_mov_b32 %3, 0" : "=v"(z0), "=v"(z1), "=v"(z2), "=v"(z3)); o[qb][c] = (f32x4v){z0, z1, z2, z3}; }
    float m_reg = -1e30f, l_reg = 0.f;
    const int qlo = q0 + wq * 32;
    for (int t = 0; t < NT; t += 2) {
        { const int kb = t * 64;       step<0>(o, qr, qsp_w, m_reg, l_reg, lds, al_l, map, kb + 63 > qlo, qlo - kb, true,       Kg, Vg, kb + 64, wid); }
        { const int kb = (t + 1) * 64; step<1>(o, qr, qsp_w, m_reg, l_reg, lds, al_l, map, kb + 63 > qlo, qlo - kb, t + 2 < NT, Kg, Vg, kb + 64, wid); }
    }
    int laneE; asm volatile("v_mbcnt_lo_u32_b32 %0, -1, 0\n\tv_mbcnt_hi_u32_b32 %0, -1, %0" : "=v"(laneE)); const int frE = laneE & 15, fqE = laneE >> 4;
    if (laneE < 32) li_l[laneE] = l_reg; asm volatile("s_waitcnt lgkmcnt(0)" ::: "memory");
#pragma unroll
    for (int qb = 0; qb < 2; ++qb) { const f32x4v l4 = *(const f32x4v*)(li_l + 16 * qb + 4 * fqE); const f32x4v r4 = {__builtin_amdgcn_rcpf(l4[0]), __builtin_amdgcn_rcpf(l4[1]), __builtin_amdgcn_rcpf(l4[2]), __builtin_amdgcn_rcpf(l4[3])};
#pragma unroll
        for (int c = 0; c < 16; ++c) o[qb][c] *= r4; }
    asm volatile("s_waitcnt lgkmcnt(0)" ::: "memory"); __builtin_amdgcn_s_barrier(); asm volatile("" ::: "memory");
    char* xch = lds + wq * 32768 + laneE * 16;
    if (map == 1) {
#pragma unroll
        for (int qb = 0; qb < 2; ++qb)
#pragma unroll
            for (int c = 0; c < 16; ++c) *(f32x4v*)(xch + (qb * 16 + c) * 1024) = o[qb][c];
    }
    asm volatile("s_waitcnt lgkmcnt(0)" ::: "memory"); __builtin_amdgcn_s_barrier(); asm volatile("" ::: "memory");
    if (map == 0) {
        const float lam = wsf[512 + wid];
        bf16* Ow = C.att + (row0 + q0 + wq * 32) * ATT_LD + h * 256;
#pragma unroll
        for (int qb = 0; qb < 2; ++qb) { f32x4v ss = {0.f, 0.f, 0.f, 0.f};
#pragma unroll
            for (int c = 0; c < 16; ++c) { const f32x4v v2 = *(const f32x4v*)(xch + (qb * 16 + c) * 1024); const f32x4v dd = o[qb][c] - v2 * lam; o[qb][c] = dd; ss += dd * dd; }
#pragma unroll
            for (int e = 0; e < 4; ++e) { float s = ss[e]; s += bpx(s, laneE, 1); s += bpx(s, laneE, 2); s += bpx(s, laneE, 4); s += bpx(s, laneE, 8); ss[e] = 1.0f / sqrtf(s * (1.0f / 256.0f) + 1e-5f); }
#pragma unroll
            for (int c = 0; c < 16; ++c) { const float gl = C.subln_g[16 * c + frE] * 0.8f;
#pragma unroll
                for (int e = 0; e < 4; ++e) { const float v = o[qb][c][e] * ss[e] * gl; const float vn = bpx(v, laneE, 1);
                    if ((frE & 1) == 0) *(unsigned*)((Ow + (16 * qb + e) * ATT_LD + 16 * c) + (4 * fqE * ATT_LD + frE)) = cvtpk(v, vn); } } }
    }
    asm volatile("s_waitcnt lgkmcnt(0)" ::: "memory"); __builtin_amdgcn_s_barrier(); asm volatile("" ::: "memory");
}
#undef DA16_TR
#undef DA16_FR
__device__ __forceinline__ void phase(const Ctx& C, char* lds, float* wsf, char* qsp, int vcu, int G) {
    { const int wid = __builtin_amdgcn_readfirstlane((int)threadIdx.x >> 6); wsf[512 + wid] = C.lam; asm volatile("s_waitcnt lgkmcnt(0)" ::: "memory"); }
    const int npair = (512 - vcu + G - 1) / G;
    for (int u = 0; u < 2 * npair; ++u) { const int p = vcu + (u >> 1) * G, bh = p >> 5, x = p & 31;
        unit(C, bh >> 3, bh & 7, (u & 1) ? 63 - x : x, lds, wsf, qsp); }
}
}

constexpr int NWAVES = 8;
#ifndef MK_PER_PHASE
#define MK_PER_PHASE 0
#endif
constexpr int NPH = 12;

constexpr int BATCH = 2, SEQ = 8192, DM = 4096, M = BATCH * SEQ;
constexpr int NHEADS = 8;
constexpr int NIN = 20480, CWID = 2048, DFF = 11008, NUP = 2 * DFF;
constexpr int OFF_Q = 0, OFF_K = 2048, OFF_V = 4096, OFF_U = 6144, OFF_GB = 8192, OFF_GC = 10240, OFF_GA = 12288, OFF_GCV = 16384;
constexpr float LN_EPS = 1e-5f, RMS_EPS = 1e-5f;
constexpr float ALPHA = 1.189207115002721f;
constexpr float LAM_INIT = 0.2f;

constexpr size_t MiB = 1u << 20;
constexpr size_t WS_CTL = 0, CTL_ZERO_BYTES = 32768;
constexpr size_t WS_WA = 1 * MiB, WS_WC = 17 * MiB, WS_WO = 33 * MiB, WS_WIN = 65 * MiB, WS_WDN = 225 * MiB, WS_HALO = 311 * MiB, WS_PROJ = 353 * MiB, WS_ATTN = 993 * MiB, WS_YC = 1057 * MiB, WS_WUP = 1121 * MiB;
constexpr size_t WS_MERGED = 65 * MiB;
constexpr size_t WS_H1B = 353 * MiB;
constexpr size_t WS_G = 481 * MiB;
constexpr size_t WS_END = 1293 * MiB;
constexpr size_t DO_XB = 0, DO_O1 = 0, DO_O2 = 128 * MiB;
static_assert(WS_WIN + (size_t)NIN * DM * 2 <= WS_WDN && WS_WDN + (size_t)DM * DFF * 2 <= WS_HALO && WS_HALO + (size_t)(M / 256) * (NUP / 256) * 1024 * 4 <= WS_PROJ, "ws map (weights)");
static_assert(WS_PROJ + (size_t)M * NIN * 2 <= WS_ATTN && WS_G + (size_t)M * DFF * 2 <= WS_ATTN && WS_WUP + (size_t)NUP * DM * 2 <= WS_END && WS_H1B + (size_t)M * DM * 2 <= WS_G, "ws map");
constexpr int CW_BAR = 4096;

constexpr int RING_OFF = 0, RING_BYTES = 131072;
constexpr int LDSCTL_OFF = RING_BYTES, MISC_OFF = LDSCTL_OFF + 320, HALO_LDS_OFF = LDSCTL_OFF + 1024;
constexpr int QSP_LDS_OFF = HALO_LDS_OFF + 8192;
constexpr int LDS_BYTES = 163840;
static_assert(MISC_OFF + 128 <= HALO_LDS_OFF && QSP_LDS_OFF + 16384 <= LDS_BYTES, "LDS map");

#define GAS __attribute__((address_space(1)))
#define LAS __attribute__((address_space(3)))
typedef unsigned short bf16;
typedef unsigned v4u __attribute__((ext_vector_type(4)));
typedef float f32x4 __attribute__((ext_vector_type(4)));
typedef short bf16x8 __attribute__((ext_vector_type(8)));
typedef GAS unsigned gu32;
typedef GAS unsigned long long gu64;
#define RLX_AGENT __ATOMIC_RELAXED, __HIP_MEMORY_SCOPE_AGENT
#define LDS_WAIT() asm volatile("s_waitcnt lgkmcnt(0)" ::: "memory")
#define VM_WAIT() asm volatile("s_waitcnt vmcnt(0)" ::: "memory")
__device__ __forceinline__ unsigned long long rt() { return __builtin_amdgcn_s_memrealtime(); }
__device__ __forceinline__ unsigned f2bf(float f) { unsigned u = __builtin_bit_cast(unsigned, f); return (u + 0x7fffu + ((u >> 16) & 1u)) >> 16; }
__device__ __forceinline__ unsigned pk2(float lo, float hi) { return f2bf(lo) | (f2bf(hi) << 16); }

#define XB_TMO      128
#define XB_XCNT(j)  (256  + 64 * (j))
#define XB_XSUB(j)  (1280 + 64 * (j))
#define XB_XGEN(j)  (2304 + 64 * (j))
#define XB_TOP      3328
#define XB_TOPGEN   3392
#define XCD_BAR_WORDS 3456
#define XB_SPIN_CAP (1u << 18)

__device__ __forceinline__ unsigned xb_ld(unsigned* p)              { return __hip_atomic_load(p, __ATOMIC_RELAXED, __HIP_MEMORY_SCOPE_AGENT); }
__device__ __forceinline__ unsigned xb_add(unsigned* p, unsigned v) { return __hip_atomic_fetch_add(p, v, __ATOMIC_RELAXED, __HIP_MEMORY_SCOPE_AGENT); }
__device__ __forceinline__ unsigned xb_xcc_id() { return (unsigned)__builtin_amdgcn_s_getreg((3 << 11) | 20) & 0xFu; }
#define XB_SPIN(cond, bar) do { unsigned _sp = 0; while (cond) { __builtin_amdgcn_s_sleep(1); \
    if ((++_sp & 255u) == 0u) { if (xb_ld(&(bar)[XB_TMO])) break; if (_sp > XB_SPIN_CAP) { atomicAdd(&(bar)[XB_TMO], 1u); break; } } } } while (0)

struct XcdBarrier {
    unsigned* bar; unsigned x;
    volatile LAS unsigned* st;
};

__device__ __forceinline__ XcdBarrier xcd_barrier_post(unsigned* bar, volatile LAS unsigned* st) {
    XcdBarrier b; b.bar = bar; b.x = xb_xcc_id(); b.st = st;
    if (threadIdx.x == 0) (void)xb_add(&bar[XB_XCNT(b.x)], 1u);
    return b;
}
__device__ __forceinline__ void xcd_barrier_complete(unsigned* bar, unsigned x, unsigned& nloc, unsigned& nx) {
    const unsigned G = gridDim.x * gridDim.y * gridDim.z;
    unsigned sum, cnt, mine, sp = 0u;
    for (;;) {
        sum = 0u; cnt = 0u; mine = 0u;
#pragma unroll
        for (unsigned j = 0; j < 16; ++j) { const unsigned c = xb_ld(&bar[XB_XCNT(j)]); sum += c; cnt += (c > 0u) ? 1u : 0u; mine = (j == x) ? c : mine; }
        if (sum == G) break;
        __builtin_amdgcn_s_sleep(1);
        if ((++sp & 255u) == 0u) { if (xb_ld(&bar[XB_TMO])) break; if (sp > XB_SPIN_CAP) { atomicAdd(&bar[XB_TMO], 1u); break; } }
    }
    nloc = mine > 0u ? mine : 1u; nx = cnt > 0u ? cnt : 1u;
}

__device__ __forceinline__ void xcd_barrier(const XcdBarrier& b) {
    asm volatile("s_waitcnt vmcnt(0)" ::: "memory");
    __syncthreads();
    if (threadIdx.x == 0) {
        unsigned* bar = b.bar;
        __builtin_amdgcn_s_waitcnt(0);
        unsigned nloc = b.st[0], nx = b.st[1];
        if (nloc == 0u) { xcd_barrier_complete(bar, b.x, nloc, nx); b.st[0] = nloc; b.st[1] = nx; }
        const unsigned old = xb_add(&bar[XB_XSUB(b.x)], 1u);
        const unsigned gen = old / nloc;
        if (old + 1u == (gen + 1u) * nloc) {
            __builtin_amdgcn_fence(__ATOMIC_RELEASE, "agent");
            asm volatile("s_waitcnt vmcnt(0)" ::: "memory");
            const unsigned og = xb_add(&bar[XB_TOP], 1u);
            const unsigned tg = og / nx;
            if (og + 1u == (tg + 1u) * nx) xb_add(&bar[XB_TOPGEN], 1u);
            else XB_SPIN(xb_ld(&bar[XB_TOPGEN]) == tg, bar);
            __builtin_amdgcn_fence(__ATOMIC_ACQUIRE, "agent");
            xb_add(&bar[XB_XGEN(b.x)], 1u);
            asm volatile("s_waitcnt vmcnt(0)" ::: "memory");
        } else {
            XB_SPIN(xb_ld(&bar[XB_XGEN(b.x)]) == gen, bar);
            __builtin_amdgcn_fence(__ATOMIC_ACQUIRE, "agent");
            asm volatile("s_waitcnt vmcnt(0)" ::: "memory");
        }
    }
    __syncthreads();
}

struct Frame {
    LAS unsigned char* lds;
    volatile LAS unsigned* MISC;
    gu32* ctl;
    int wave;
    int vcu, G;
};
__device__ __forceinline__ unsigned pkbf(float lo, float hi) { return pg8::cvt_pk_bf16(lo, hi); }
__device__ __forceinline__ float rnd6(float v) { return __uint_as_float((__float_as_uint(v) + 0x10000u) & 0xfffe0000u); }
__device__ __forceinline__ unsigned pkw(float lo, float hi) { return pg8::cvt_pk_bf16(rnd6(lo), rnd6(hi)); }
__device__ __forceinline__ float shfl_xor_l(float v, int mask, int lane) { return __int_as_float(__builtin_amdgcn_ds_bpermute((lane ^ mask) << 2, __float_as_int(v))); }
__device__ __forceinline__ float wave_sum(float v, int lane) {
#pragma unroll
    for (int o = 1; o < 64; o <<= 1) v += shfl_xor_l(v, o, lane);
    return v;
}
template <int ILV = 0, bool HF = false> __device__ __forceinline__ void transpose_item(const float* W, int K, int N, bf16* WT, LAS float* scr, int item, int lane, int ldk = 0, int kofs = 0) {
    if (ldk == 0) ldk = K;
    const int nblk = N / 32, kb = item / nblk, nb = item % nblk, k0 = 64 * kb, n0 = 32 * nb;
    const int d0 = ILV == 1 ? ((n0 < DFF) ? (n0 / 128) * 256 + (n0 % 128) : ((n0 - DFF) / 128) * 256 + 128 + ((n0 - DFF) % 128))
                 : ILV == 2 ? ((n0 < OFF_GA) ? n0 : (n0 < OFF_GCV) ? OFF_GA + ((n0 - OFF_GA) / 128) * 256 + ((n0 - OFF_GA) % 128) : OFF_GA + ((n0 - OFF_GCV) / 128) * 256 + 128 + ((n0 - OFF_GCV) % 128)) : n0;
#pragma unroll 8
    for (int i = 0; i < 32; ++i) { const int kk = 2 * i + (lane >> 5); scr[kk * 33 + (lane & 31)] = W[(size_t)(k0 + kk) * N + n0 + (lane & 31)]; }
    LDS_WAIT(); asm volatile("" ::: "memory");
    const int c = lane & 7;
#pragma unroll
    for (int j = 0; j < 4; ++j) { const int n = (lane >> 3) + 8 * j; const LAS float* s = scr + (8 * c) * 33 + n;
        v4u o;
        if constexpr (HF) { o.x = pg8::pk_h2(s[0 * 33], s[1 * 33]); o.y = pg8::pk_h2(s[2 * 33], s[3 * 33]); o.z = pg8::pk_h2(s[4 * 33], s[5 * 33]); o.w = pg8::pk_h2(s[6 * 33], s[7 * 33]); }
        else { o.x = pkw(s[0 * 33], s[1 * 33]); o.y = pkw(s[2 * 33], s[3 * 33]); o.z = pkw(s[4 * 33], s[5 * 33]); o.w = pkw(s[6 * 33], s[7 * 33]); }
        *(GAS v4u*)(WT + (size_t)(d0 + n) * ldk + kofs + k0 + 8 * c) = o; }
    LDS_WAIT(); asm volatile("" ::: "memory");
}
template <bool FOUT> __device__ __forceinline__ void ln_row_h(bf16* hrow, const float* g, const float* b, float* orow_f, int lane, bool poison, bf16* brow = nullptr) {
    GAS v4u* xr = (GAS v4u*)hrow + lane;
    float v[8][8]; float s = 0.f;
#pragma unroll
    for (int j = 0; j < 8; ++j) { const v4u w = xr[64 * j];
        v[j][0] = pg8::h_lo(w.x); v[j][1] = pg8::h_hi(w.x); v[j][2] = pg8::h_lo(w.y); v[j][3] = pg8::h_hi(w.y); v[j][4] = pg8::h_lo(w.z); v[j][5] = pg8::h_hi(w.z); v[j][6] = pg8::h_lo(w.w); v[j][7] = pg8::h_hi(w.w);
#pragma unroll
        for (int i = 0; i < 8; ++i) s += v[j][i]; }
    const float mean = wave_sum(s, lane) * (1.f / DM); float s2 = 0.f;
#pragma unroll
    for (int j = 0; j < 8; ++j)
#pragma unroll
        for (int i = 0; i < 8; ++i) { v[j][i] -= mean; s2 += v[j][i] * v[j][i]; }
    float rstd = 1.f / sqrtf(wave_sum(s2, lane) * (1.f / DM) + LN_EPS);
    if (poison) rstd = __builtin_nanf("");
#pragma unroll
    for (int j = 0; j < 8; ++j) { const int e0 = 8 * (lane + 64 * j); const f32x4 g0 = *(const GAS f32x4*)(g + e0), g1 = *(const GAS f32x4*)(g + e0 + 4), b0 = *(const GAS f32x4*)(b + e0), b1 = *(const GAS f32x4*)(b + e0 + 4);
        const f32x4 o0 = (f32x4){v[j][0], v[j][1], v[j][2], v[j][3]} * rstd * g0 + b0, o1 = (f32x4){v[j][4], v[j][5], v[j][6], v[j][7]} * rstd * g1 + b1;
        if constexpr (FOUT) { *(GAS f32x4*)(orow_f + e0) = o0; *(GAS f32x4*)(orow_f + e0 + 4) = o1; }
        else { v4u w; w.x = pg8::pk_h2(o0[0], o0[1]); w.y = pg8::pk_h2(o0[2], o0[3]); w.z = pg8::pk_h2(o1[0], o1[1]); w.w = pg8::pk_h2(o1[2], o1[3]); xr[64 * j] = w;
               v4u wb; wb.x = pkbf(o0[0], o0[1]); wb.y = pkbf(o0[2], o0[3]); wb.z = pkbf(o1[0], o1[1]); wb.w = pkbf(o1[2], o1[3]); ((GAS v4u*)brow)[lane + 64 * j] = wb; } }
}
__device__ __forceinline__ void unpack8(const v4u w, float (&f)[8]) {
    f[0] = __uint_as_float(w.x << 16); f[1] = __uint_as_float(w.x & 0xffff0000u); f[2] = __uint_as_float(w.y << 16); f[3] = __uint_as_float(w.y & 0xffff0000u);
    f[4] = __uint_as_float(w.z << 16); f[5] = __uint_as_float(w.z & 0xffff0000u); f[6] = __uint_as_float(w.w << 16); f[7] = __uint_as_float(w.w & 0xffff0000u);
}
__device__ __forceinline__ v4u pack8f(const float (&f)[8]) { v4u o; o.x = pkbf(f[0], f[1]); o.y = pkbf(f[2], f[3]); o.z = pkbf(f[4], f[5]); o.w = pkbf(f[6], f[7]); return o; }

typedef const void __attribute__((address_space(4)))* karg_ptr_t;
template <int OFF> __device__ __forceinline__ unsigned long long karg_u64() {
    unsigned long long v; karg_ptr_t kp = (karg_ptr_t)__builtin_amdgcn_kernarg_segment_ptr();
    asm volatile("s_load_dwordx2 %0, %1, %2\n\ts_waitcnt lgkmcnt(0)" : "=s"(v) : "s"(kp), "i"(OFF)); return v; }
template <int OFF> __device__ __forceinline__ int karg_i32() {
    int v; karg_ptr_t kp = (karg_ptr_t)__builtin_amdgcn_kernarg_segment_ptr();
    asm volatile("s_load_dword %0, %1, %2\n\ts_waitcnt lgkmcnt(0)" : "=s"(v) : "s"(kp), "i"(OFF)); return v; }
#define KARG_F(k) ((const float*)(const GAS float*)karg_u64<8 * (k)>())
#define KARG_OUT() ((float*)(GAS float*)karg_u64<144>())
#define KARG_WS() ((unsigned char*)(GAS unsigned char*)karg_u64<152>())
__device__ __forceinline__ int lane_id() { int l; asm volatile("v_mbcnt_lo_u32_b32 %0, -1, 0\n\tv_mbcnt_hi_u32_b32 %0, -1, %0" : "=v"(l)); return l; }

struct RevOrder : pg8::StaticOrder {
    __device__ bool next(int i, pg8::Unit& u) const { if (!pg8::StaticOrder::next(i, u)) return false; u.pn = nN - 1 - u.pn; return true; } };
struct Order4 : pg8::StaticOrder {
    __device__ bool next(int i, pg8::Unit& u) const {
        const long L = (long)i * G + c; if (L >= nwg) return false;
        int wgid = (int)L; { const int q = nwg / pg8::NXCD, r = nwg % pg8::NXCD, xcd = wgid % pg8::NXCD, off = wgid / pg8::NXCD; wgid = (xcd < r ? xcd * (q + 1) : r * (q + 1) + (xcd - r) * q) + off; }
        constexpr int W4 = 4; const int nig = W4 * nN, gid = wgid / nig, fm = gid * W4, gsz = (nM - fm) < W4 ? (nM - fm) : W4;
        u.pm = fm + ((wgid % nig) % gsz); u.pn = (wgid % nig) / gsz; return true;
    } };
struct Args { const float* in[18]; float* out; unsigned char* ws; int ph_lo, ph_hi, li, pad; };
__global__ void __launch_bounds__(NWAVES * 64, 2) fwd(Args  ) {
    extern __shared__ __attribute__((aligned(16))) unsigned char lds[];
    Frame F;
    F.lds = (LAS unsigned char*)lds;
    F.MISC = (volatile LAS unsigned*)(F.lds + MISC_OFF);
    F.wave = __builtin_amdgcn_readfirstlane((int)threadIdx.x >> 6);
    F.G = gridDim.x; { const int bx = blockIdx.x; F.vcu = (F.G % 8 == 0) ? (bx % 8) * (F.G / 8) + bx / 8 : bx; }
    F.ctl = (gu32*)(KARG_WS() + WS_CTL);
    for (int u = threadIdx.x; u < (LDS_BYTES - LDSCTL_OFF) / 4; u += NWAVES * 64) ((LAS unsigned*)(F.lds + LDSCTL_OFF))[u] = 0u;
    __syncthreads();
    XcdBarrier bar; bar.bar = (unsigned*)(F.ctl + CW_BAR); bar.x = 0; bar.st = nullptr;
    if (!MK_PER_PHASE) bar = xcd_barrier_post((unsigned*)(F.ctl + CW_BAR), F.MISC + 8);
#define GRID_BAR() do { if (!MK_PER_PHASE) xcd_barrier(bar); } while (0)
#if MK_PER_PHASE
    const int lo = karg_i32<160>(), hi = karg_i32<164>();
#else
    constexpr int lo = 0, hi = NPH;
#endif
#define IN(k) (lo <= (k) && (k) < hi)
#define BOTH(k) (IN(k) && IN((k) + 1))
    const int gw = F.vcu * NWAVES + F.wave, NGW = F.G * NWAVES;
    LAS float* scr = (LAS float*)(F.lds + RING_OFF + F.wave * 16384);

    if (IN(0)) {
        const int lane = lane_id();
        unsigned char* const ws = KARG_WS(); bf16* const XB = (bf16*)((unsigned char*)KARG_OUT() + DO_XB);
        constexpr int I_IN = (DM / 64) * (NIN / 32), I_A = (CWID / 64) * (DM / 32), I_O = (DM / 64) * (DM / 32), I_UP = (DM / 64) * (NUP / 32), I_DN = (DFF / 64) * (DM / 32);
        constexpr int NIT = I_IN + 2 * I_A + I_O + I_UP + I_DN;
        const float* const w_in = KARG_F(1); const float* const w_ao = KARG_F(8); const float* const w_co = KARG_F(9); const float* const w_o = KARG_F(10); const float* const xin = KARG_F(0);
        const float* const w_up = KARG_F(13); const float* const w_dn = KARG_F(15);
        for (int it = gw; it < NIT; it += NGW) {
            int r = it;
            if (r < I_IN) { transpose_item<2>(w_in, DM, NIN, (bf16*)(ws + WS_WIN), scr, r, lane); continue; } r -= I_IN;
            if (r < I_A) { transpose_item(w_ao, CWID, DM, (bf16*)(ws + WS_WA), scr, r, lane, 2 * CWID, 0); continue; } r -= I_A;
            if (r < I_A) { transpose_item(w_co, CWID, DM, (bf16*)(ws + WS_WA), scr, r, lane, 2 * CWID, CWID); continue; } r -= I_A;
            if (r < I_O) { transpose_item(w_o, DM, DM, (bf16*)(ws + WS_WO), scr, r, lane); continue; } r -= I_O;
            if (r < I_UP) { transpose_item<1>(w_up, DM, NUP, (bf16*)(ws + WS_WUP), scr, r, lane); continue; } r -= I_UP;
            transpose_item(w_dn, DFF, DM, (bf16*)(ws + WS_WDN), scr, r, lane);
        }
        const size_t n8 = (size_t)M * DM / 8;
        for (size_t i = (size_t)blockIdx.x * (NWAVES * 64) + F.wave * 64 + lane; i < n8; i += (size_t)F.G * (NWAVES * 64)) {
            const f32x4 a = ((const GAS f32x4*)xin)[2 * i], b = ((const GAS f32x4*)xin)[2 * i + 1];
            v4u o; o.x = pkbf(a.x, a.y); o.y = pkbf(a.z, a.w); o.z = pkbf(b.x, b.y); o.w = pkbf(b.z, b.w);
            ((GAS v4u*)XB)[i] = o;
        }
        if (BOTH(0)) GRID_BAR();
    }
    if (IN(1)) {
        unsigned char* const ws = KARG_WS(); bf16* const Win_t = (bf16*)(ws + WS_WIN); bf16* const XB = (bf16*)((unsigned char*)KARG_OUT() + DO_XB); bf16* const PROJ = (bf16*)(ws + WS_PROJ);
        pg8::Gemm g{XB, Win_t, M, NIN, DM}; RevOrder S; S.init(M, NIN, F.G, (int)blockIdx.x);
        pg8::EpiProj E{PROJ, NIN, OFF_GA, OFF_GCV};
        pg8::gemm_phase<pg8::EpiProj, RevOrder, true, true>(F.lds + RING_OFF, g, S, E);
        if (BOTH(1)) GRID_BAR();
    }
    if (IN(2)) {
        const int lane = lane_id();
        unsigned char* const ws = KARG_WS();
        float s1, s2; { const float* const q1 = KARG_F(2); const float* const k1 = KARG_F(3); const float* const q2 = KARG_F(4); const float* const k2 = KARG_F(5);
          s1 = q1[lane] * k1[lane] + q1[lane + 64] * k1[lane + 64]; s1 = wave_sum(s1, lane); s2 = q2[lane] * k2[lane] + q2[lane + 64] * k2[lane + 64]; s2 = wave_sum(s2, lane); }
        const da::Ctx C{(const swa::bf16*)(ws + WS_PROJ), (swa::bf16*)(ws + WS_ATTN), KARG_F(6), expf(s1) - expf(s2) + LAM_INIT};
        da::phase(C, (char*)lds + RING_OFF, (float*)((char*)lds + HALO_LDS_OFF), (char*)lds + QSP_LDS_OFF, F.vcu, F.G);
        if (MK_PER_PHASE == 0) { asm volatile("s_waitcnt vmcnt(0)" ::: "memory"); __syncthreads(); }
    }
    if (IN(3)) {
        const int lane = lane_id();
        unsigned char* const ws = KARG_WS(); bf16* const PROJ = (bf16*)(ws + WS_PROJ); float* const O1 = (float*)((unsigned char*)KARG_OUT() + DO_O1); float* const O2 = (float*)((unsigned char*)KARG_OUT() + DO_O2); bf16* const YC = (bf16*)(ws + WS_ATTN) + CWID;
        const float* const conv_w = KARG_F(7);
        for (int it = gw; it < (M / 32) * 4; it += NGW) {
            const int run = it >> 2, c = (it & 3) * 512 + lane * 8, t0 = run * 32;
            float w0[8], w1[8], w2[8], p1[8], p2[8];
            { const GAS f32x4* cw = (const GAS f32x4*)(conv_w + c);
              const f32x4 a = cw[0], b = cw[1], c1 = cw[CWID / 4], d1 = cw[CWID / 4 + 1], e = cw[2 * CWID / 4], f = cw[2 * CWID / 4 + 1];
              w0[0] = a.x; w0[1] = a.y; w0[2] = a.z; w0[3] = a.w; w0[4] = b.x; w0[5] = b.y; w0[6] = b.z; w0[7] = b.w;
              w1[0] = c1.x; w1[1] = c1.y; w1[2] = c1.z; w1[3] = c1.w; w1[4] = d1.x; w1[5] = d1.y; w1[6] = d1.z; w1[7] = d1.w;
              w2[0] = e.x; w2[1] = e.y; w2[2] = e.z; w2[3] = e.w; w2[4] = f.x; w2[5] = f.y; w2[6] = f.z; w2[7] = f.w; }
            if ((t0 & (SEQ - 1)) == 0) {
#pragma unroll
                for (int j = 0; j < 8; ++j) { p1[j] = 0.f; p2[j] = 0.f; }
            } else {
                float ua[8], ga[8], ub[8], gb2[8];
                unpack8(*(const GAS v4u*)(PROJ + (size_t)(t0 - 1) * NIN + OFF_U + c), ua); unpack8(*(const GAS v4u*)(PROJ + (size_t)(t0 - 1) * NIN + OFF_GC + c), ga);
                unpack8(*(const GAS v4u*)(PROJ + (size_t)(t0 - 2) * NIN + OFF_U + c), ub); unpack8(*(const GAS v4u*)(PROJ + (size_t)(t0 - 2) * NIN + OFF_GC + c), gb2);
#pragma unroll
                for (int j = 0; j < 8; ++j) { p1[j] = ua[j] * ga[j]; p2[j] = ub[j] * gb2[j]; }
            }
#pragma unroll 4
            for (int i = 0; i < 32; ++i) {
                const size_t rowo = (size_t)(t0 + i) * NIN + c;
                float uu[8], gc[8], gbv[8], y[8];
                unpack8(*(const GAS v4u*)(PROJ + rowo + OFF_U), uu); unpack8(*(const GAS v4u*)(PROJ + rowo + OFF_GC), gc); unpack8(*(const GAS v4u*)(PROJ + rowo + OFF_GB), gbv);
#pragma unroll
                for (int j = 0; j < 8; ++j) { const float p0 = uu[j] * gc[j]; y[j] = gbv[j] * (w0[j] * p2[j] + w1[j] * p1[j] + w2[j] * p0); p2[j] = p1[j]; p1[j] = p0; }
                *(GAS v4u*)(YC + (size_t)(t0 + i) * (2 * CWID) + c) = pack8f(y);
            }
        }
        if (BOTH(3)) GRID_BAR();
    }
    if (IN(4)) {
        unsigned char* const ws = KARG_WS(); bf16* const PROJ = (bf16*)(ws + WS_PROJ);
        pg8::Gemm g{(bf16*)(ws + WS_ATTN), (bf16*)(ws + WS_WA), M, DM, 2 * CWID}; pg8::StaticOrder S; S.init(M, DM, F.G, (int)blockIdx.x);
        pg8::EpiGateMerge E{(bf16*)(ws + WS_MERGED), DM, PROJ + OFF_GA, PROJ + OFF_GCV, NIN};
        pg8::gemm_phase<pg8::EpiGateMerge, pg8::StaticOrder, true, true, true>(F.lds + RING_OFF, g, S, E);
        if (BOTH(4)) GRID_BAR();
    }
    if (IN(6)) {
        unsigned char* const ws = KARG_WS(); float* const out = KARG_OUT(); bf16* const Wo_t = (bf16*)(ws + WS_WO); bf16* const MERGED = (bf16*)(ws + WS_MERGED);
        pg8::Gemm g{MERGED, Wo_t, M, DM, DM}; pg8::StaticOrder S; S.init(M, DM, F.G, (int)blockIdx.x);
        pg8::EpiResidH<false> E{KARG_F(0), (bf16*)out};
        pg8::gemm_phase<pg8::EpiResidH<false>, pg8::StaticOrder, true, true>(F.lds + RING_OFF, g, S, E);
        if (BOTH(6)) GRID_BAR();
    }
    if (IN(7)) {
        const int lane = lane_id();
        unsigned char* const ws = KARG_WS(); float* const out = KARG_OUT(); bf16* const H1B = (bf16*)(ws + WS_H1B);
        { const float* const g1 = KARG_F(11); const float* const b1 = KARG_F(12);
          for (int t = gw; t < M; t += NGW) ln_row_h<false>((bf16*)out + (size_t)t * DM, g1, b1, nullptr, lane, false, H1B + (size_t)t * DM); }
        if (BOTH(7)) GRID_BAR();
    }
    if (IN(8)) {
        unsigned char* const ws = KARG_WS(); bf16* const H1B = (bf16*)(ws + WS_H1B); bf16* const Wup_t = (bf16*)(ws + WS_WUP); bf16* const GB = (bf16*)(ws + WS_G);
        pg8::Gemm g{H1B, Wup_t, M, NUP, DM}; pg8::StaticOrder S; S.init(M, NUP, F.G, (int)blockIdx.x);
        pg8::EpiConvSilu E{GB, DFF, KARG_F(14), NUP, DFF, (float*)(ws + WS_HALO), NUP / 256, (LAS float*)(F.lds + HALO_LDS_OFF)};
        pg8::gemm_phase<pg8::EpiConvSilu, pg8::StaticOrder, true, true>(F.lds + RING_OFF, g, S, E);
        if (BOTH(8)) GRID_BAR();
    }
    if (IN(9)) {
        const int lane = lane_id();
        unsigned char* const ws = KARG_WS(); const float* const halo = (const float*)(ws + WS_HALO); bf16* const GB = (bf16*)(ws + WS_G); const float* const ffn_cw = KARG_F(14);
        constexpr int NPN = NUP / 256, NITEM = (M / 256) * NPN * 32;
        for (int it = blockIdx.x * (NWAVES * 64) + F.wave * 64 + lane; it < NITEM; it += F.G * (NWAVES * 64)) {
            const int q = it & 31, t = it >> 5, pn = t % NPN, pm = t / NPN, lc = q * 4, ch = pn * 128 + lc;
            const GAS float* hc = (const GAS float*)halo + ((size_t)pm * NPN + pn) * 1024;
            const f32x4 g0 = *(const GAS f32x4*)(hc + lc), g1 = *(const GAS f32x4*)(hc + 256 + lc), v0 = *(const GAS f32x4*)(hc + 128 + lc), v1 = *(const GAS f32x4*)(hc + 256 + 128 + lc);
            f32x4 gp2 = {0.f, 0.f, 0.f, 0.f}, gp1 = gp2, vp2 = gp2, vp1 = gp2;
            if ((pm & 31) != 0) { const GAS float* hp = hc - (size_t)NPN * 1024; gp2 = *(const GAS f32x4*)(hp + 512 + lc); gp1 = *(const GAS f32x4*)(hp + 768 + lc); vp2 = *(const GAS f32x4*)(hp + 512 + 128 + lc); vp1 = *(const GAS f32x4*)(hp + 768 + 128 + lc); }
            f32x4 wg[3], wv[3];
#pragma unroll
            for (int k = 0; k < 3; ++k) { wg[k] = *(const GAS f32x4*)(ffn_cw + (size_t)k * NUP + ch); wv[k] = *(const GAS f32x4*)(ffn_cw + (size_t)k * NUP + DFF + ch); }
            const f32x4 cg0 = wg[0] * gp2 + wg[1] * gp1 + wg[2] * g0, cv0 = wv[0] * vp2 + wv[1] * vp1 + wv[2] * v0;
            const f32x4 cg1 = wg[0] * gp1 + wg[1] * g0 + wg[2] * g1, cv1 = wv[0] * vp1 + wv[1] * v0 + wv[2] * v1;
            float y0[4], y1[4];
#pragma unroll
            for (int i = 0; i < 4; ++i) { y0[i] = cg0[i] * pg8::sigm(cg0[i]) * cv0[i]; y1[i] = cg1[i] * pg8::sigm(cg1[i]) * cv1[i]; }
            *(GAS unsigned long long*)(GB + (size_t)(pm * 256) * DFF + ch) = (unsigned long long)pkbf(y0[0], y0[1]) | ((unsigned long long)pkbf(y0[2], y0[3]) << 32);
            *(GAS unsigned long long*)(GB + (size_t)(pm * 256 + 1) * DFF + ch) = (unsigned long long)pkbf(y1[0], y1[1]) | ((unsigned long long)pkbf(y1[2], y1[3]) << 32);
        }
        if (BOTH(9)) GRID_BAR();
    }
    if (IN(10)) {
        unsigned char* const ws = KARG_WS(); float* const out = KARG_OUT(); bf16* const GB = (bf16*)(ws + WS_G); bf16* const Wdn_t = (bf16*)(ws + WS_WDN);
        pg8::Gemm g{GB, Wdn_t, M, DM, DFF}; Order4 S; S.init(M, DM, F.G, (int)blockIdx.x);
        pg8::EpiResidH<true> E{(const void*)out, (bf16*)(ws + WS_H1B)};
        pg8::gemm_phase<pg8::EpiResidH<true>, Order4, true, true>(F.lds + RING_OFF, g, S, E);
        if (BOTH(10)) GRID_BAR();
    }
    if (IN(11)) {
        const int lane = lane_id();
        float* const out = KARG_OUT();
        const bool poison = (!MK_PER_PHASE) && (__hip_atomic_load((gu32*)((unsigned*)(F.ctl + CW_BAR) + XB_TMO), RLX_AGENT) != 0u);
        const float* const g2 = KARG_F(16); const float* const b2 = KARG_F(17);
        bf16* const pre2 = (bf16*)(KARG_WS() + WS_H1B);
        for (int t = gw; t < M; t += NGW) ln_row_h<true>(pre2 + (size_t)t * DM, g2, b2, out + (size_t)t * DM, lane, poison);
    }
#undef IN
#undef BOTH
}

extern "C" void kernel_launch(void* const* d_in, const int* in_sizes, int n_in, void* d_out, int out_size, void* d_ws, size_t ws_size, hipStream_t stream) {
    static int grid = 0;
    if (grid == 0) {
        if (n_in != 18 || in_sizes[0] != M * DM || out_size != M * DM || ws_size < WS_END) { fprintf(stderr, "kernel_launch: unexpected shapes (n_in %d, in0 %d, out %d, ws %zu < %zu)\n", n_in, n_in > 0 ? in_sizes[0] : -1, out_size, ws_size, (size_t)WS_END); grid = -1; return; }
        int dev = 0, cus = 0, per_cu = 0;
        if (hipGetDevice(&dev) != hipSuccess || hipDeviceGetAttribute(&cus, hipDeviceAttributeMultiprocessorCount, dev) != hipSuccess) { grid = -1; return; }
        if (hipFuncSetAttribute((const void*)fwd, hipFuncAttributeMaxDynamicSharedMemorySize, LDS_BYTES) != hipSuccess) { fprintf(stderr, "kernel_launch: hipFuncSetAttribute failed\n"); grid = -1; return; }
        if (hipOccupancyMaxActiveBlocksPerMultiprocessor(&per_cu, (const void*)fwd, NWAVES * 64, LDS_BYTES) != hipSuccess || per_cu < 1) { fprintf(stderr, "kernel_launch: occupancy query reports %d\n", per_cu); }
        (void)hipGetLastError();
        grid = cus;
    }
    if (grid < 0) return;
    if (hipMemsetAsync((char*)d_ws + WS_CTL, 0, CTL_ZERO_BYTES, stream) != hipSuccess) return;
    Args a{};
    for (int i = 0; i < 18; ++i) a.in[i] = (const float*)d_in[i];
    a.out = (float*)d_out; a.ws = (unsigned char*)d_ws;
#if MK_PER_PHASE
    for (int p = 0; p < NPH; ++p) { a.ph_lo = p; a.ph_hi = p + 1; a.li = p; hipLaunchKernelGGL(fwd, dim3(grid), dim3(NWAVES * 64), LDS_BYTES, stream, a); }
#else
    a.ph_lo = 0; a.ph_hi = NPH; a.li = 0;
    hipLaunchKernelGGL(fwd, dim3(grid), dim3(NWAVES * 64), LDS_BYTES, stream, a);
#endif
}
```

```cpp
#include <hip/hip_runtime.h>
#include <hip/hip_bf16.h>
#include <cstdio>
#include <cstdint>
namespace pg8 {
#define PG8_LAS __attribute__((address_space(3)))
typedef unsigned short bf16_t;
typedef short bf16x8 __attribute__((ext_vector_type(8)));
typedef float f32x4 __attribute__((ext_vector_type(4)));
typedef unsigned u32x4 __attribute__((ext_vector_type(4)));
constexpr int BM = 256, BK = 64, HALF = 128, HTB = HALF * BK * 2  , STAGE_BYTES = 8 * HTB, NXCD = 8, WGM = 8;

__host__ __device__ __forceinline__ int lds_byte(int r, int c) { const int st = (r >> 4) * 2 + (c >> 5), rr = r & 15, cc = c & 31, ob = rr * 64 + cc * 2; return st * 1024 + (ob ^ (((ob >> 9) & 1) << 5)); }
__host__ __device__ __forceinline__ void stage_rc(int b, int& R, int& C) { const int st = b / 1024, sb = b % 1024, swz = sb ^ (((sb >> 9) & 1) << 5); R = (st >> 1) * 16 + swz / 64; C = (st & 1) * 32 + (swz % 64) / 2; }
__host__ __device__ __forceinline__ int perm32(int rho) { const int n = rho >> 4, i = rho & 15; return 8 * (i >> 2) + 4 * n + (i & 3); }

struct Unit { int pm, pn; };
struct Gemm { const bf16_t* A; const bf16_t* Bt; int M, N, K; };

struct StaticOrder {
    int nM, nN, nwg, G, c;
    __host__ __device__ void init(int M, int N, int G_, int c_) { nM = M / BM; nN = N / BM; nwg = nM * nN; G = G_; c = c_; }
    __host__ __device__ bool next(int i, Unit& u) const {
        const long L = (long)i * G + c; if (L >= nwg) return false;
        int wgid = (int)L; { const int q = nwg / NXCD, r = nwg % NXCD, xcd = wgid % NXCD, off = wgid / NXCD; wgid = (xcd < r ? xcd * (q + 1) : r * (q + 1) + (xcd - r) * q) + off; }
        const int nig = WGM * nN, gid = wgid / nig, fm = gid * WGM, gsz = (nM - fm) < WGM ? (nM - fm) : WGM;
        u.pm = fm + ((wgid % nig) % gsz); u.pn = (wgid % nig) / gsz; return true;
    }
    __device__ __forceinline__ void a_ready(const Unit&) const {}
    __device__ __forceinline__ void done(const Unit&) const {}
};

__device__ __forceinline__ unsigned cvt_pk_bf16(float lo, float hi) { unsigned r; asm volatile("v_cvt_pk_bf16_f32 %0, %1, %2" : "=v"(r) : "v"(lo), "v"(hi)); return r; }
typedef float f32x2 __attribute__((ext_vector_type(2)));
typedef unsigned u32x2 __attribute__((ext_vector_type(2)));
__device__ __forceinline__ float sigm(float v) { return __builtin_amdgcn_rcpf(1.0f + __builtin_amdgcn_exp2f(-1.4426950408889634f * v)); }
__device__ __forceinline__ float bflo(unsigned w) { return __uint_as_float(w << 16); }
__device__ __forceinline__ float bfhi(unsigned w) { return __uint_as_float(w & 0xffff0000u); }
struct EpiProj {
    static constexpr bool PERM = true, AFTER_DRAIN = false;
    bf16_t* O; int ldc; int sig_from; int gc_at;
    __device__ __forceinline__ void operator()(const f32x4 (&acc)[2][2][4][2], const Unit& u, int wr, int wc, int fr, int fq) const {
        const int row0 = u.pm * BM + wr * 64 + fr, col0 = u.pn * BM + wc * 32 + 8 * fq; const bool sg = (u.pn * BM) >= sig_from;
        if (sg) {
            const int ch = ((u.pn * BM - sig_from) >> 1) + wc * 32 + 8 * fq;
#pragma unroll
            for (int ai = 0; ai < 2; ++ai)
#pragma unroll
                for (int m = 0; m < 4; ++m) { bf16_t* rowp = O + (size_t)(row0 + ai * HALF + m * 16) * ldc + ch; float r[8], s[8];
#pragma unroll
                    for (int n = 0; n < 2; ++n)
#pragma unroll
                        for (int i = 0; i < 4; ++i) { const float ea = __builtin_amdgcn_exp2f(-1.4426950408889634f * acc[ai][0][m][n][i]), ec1 = 1.0f + __builtin_amdgcn_exp2f(-1.4426950408889634f * acc[ai][1][m][n][i]);
                            s[4 * n + i] = __builtin_amdgcn_rcpf(ec1); r[4 * n + i] = ec1 * __builtin_amdgcn_rcpf(1.0f + ea); }
                    u32x4 w; w.x = cvt_pk_bf16(r[0], r[1]); w.y = cvt_pk_bf16(r[2], r[3]); w.z = cvt_pk_bf16(r[4], r[5]); w.w = cvt_pk_bf16(r[6], r[7]);
                    *(u32x4*)(rowp + sig_from) = w;
                    w.x = cvt_pk_bf16(s[0], s[1]); w.y = cvt_pk_bf16(s[2], s[3]); w.z = cvt_pk_bf16(s[4], s[5]); w.w = cvt_pk_bf16(s[6], s[7]);
                    *(u32x4*)(rowp + gc_at) = w; }
            return; }
#pragma unroll
        for (int ai = 0; ai < 2; ++ai)
#pragma unroll
            for (int m = 0; m < 4; ++m) { bf16_t* rowp = O + (size_t)(row0 + ai * HALF + m * 16) * ldc + col0;
#pragma unroll
                for (int bj = 0; bj < 2; ++bj) { const f32x4 v0 = acc[ai][bj][m][0], v1 = acc[ai][bj][m][1];
                    u32x4 w; w.x = cvt_pk_bf16(v0[0], v0[1]); w.y = cvt_pk_bf16(v0[2], v0[3]); w.z = cvt_pk_bf16(v1[0], v1[1]); w.w = cvt_pk_bf16(v1[2], v1[3]);
                    *(u32x4*)(rowp + bj * HALF) = w; } }
    }
};
struct EpiPlain {
    static constexpr bool PERM = true, AFTER_DRAIN = false;
    bf16_t* O; int ldc;
    __device__ __forceinline__ void operator()(const f32x4 (&acc)[2][2][4][2], const Unit& u, int wr, int wc, int fr, int fq) const {
        const int row0 = u.pm * BM + wr * 64 + fr, col0 = u.pn * BM + wc * 32 + 8 * fq;
#pragma unroll
        for (int ai = 0; ai < 2; ++ai)
#pragma unroll
            for (int m = 0; m < 4; ++m) { bf16_t* rowp = O + (size_t)(row0 + ai * HALF + m * 16) * ldc + col0;
#pragma unroll
                for (int bj = 0; bj < 2; ++bj) { const f32x4 v0 = acc[ai][bj][m][0], v1 = acc[ai][bj][m][1];
                    u32x4 w; w.x = cvt_pk_bf16(v0[0], v0[1]); w.y = cvt_pk_bf16(v0[2], v0[3]); w.z = cvt_pk_bf16(v1[0], v1[1]); w.w = cvt_pk_bf16(v1[2], v1[3]);
                    *(u32x4*)(rowp + bj * HALF) = w; } }
    }
};
struct EpiGateA {
    static constexpr bool PERM = false, AFTER_DRAIN = false;
    float* P; int ldc; const bf16_t* gate; int ldg;
    __device__ __forceinline__ void operator()(const f32x4 (&acc)[2][2][4][2], const Unit& u, int wr, int wc, int fr, int fq) const {
        const int row0 = u.pm * BM + wr * 64 + fr, col0 = u.pn * BM + wc * 32 + 4 * fq;
#pragma unroll
        for (int ai = 0; ai < 2; ++ai)
#pragma unroll
            for (int m = 0; m < 4; ++m) { const size_t row = (size_t)(row0 + ai * HALF + m * 16);
#pragma unroll
                for (int bj = 0; bj < 2; ++bj)
#pragma unroll
                    for (int n = 0; n < 2; ++n) { const int col = col0 + bj * HALF + n * 16;
                        const u32x2 gw = *(const u32x2*)(gate + row * ldg + col); const f32x4 a = acc[ai][bj][m][n];
                        *(f32x4*)(P + row * ldc + col) = (f32x4){a[0] * bflo(gw.x), a[1] * bfhi(gw.x), a[2] * bflo(gw.y), a[3] * bfhi(gw.y)}; }
                if (m & 1) asm volatile("" ::: "memory"); }
    }
};
struct EpiGateC {
    static constexpr bool PERM = true, AFTER_DRAIN = false;
    const float* P; bf16_t* O; int ldc; const bf16_t* gate; int ldg;
    __device__ __forceinline__ void operator()(const f32x4 (&acc)[2][2][4][2], const Unit& u, int wr, int wc, int fr, int fq) const {
        const int row0 = u.pm * BM + wr * 64 + fr, col0 = u.pn * BM + wc * 32 + 8 * fq;
#pragma unroll
        for (int ai = 0; ai < 2; ++ai)
#pragma unroll
            for (int m = 0; m < 4; ++m) { const size_t row = (size_t)(row0 + ai * HALF + m * 16);
#pragma unroll
                for (int bj = 0; bj < 2; ++bj) { const int col = col0 + bj * HALF;
                    const u32x4 gw = *(const u32x4*)(gate + row * ldg + col); const f32x4 p0 = *(const f32x4*)(P + row * ldc + col), p1 = *(const f32x4*)(P + row * ldc + col + 4);
                    const f32x4 a0 = acc[ai][bj][m][0], a1 = acc[ai][bj][m][1];
                    const float r0 = p0[0] + a0[0] * bflo(gw.x), r1 = p0[1] + a0[1] * bfhi(gw.x), r2 = p0[2] + a0[2] * bflo(gw.y), r3 = p0[3] + a0[3] * bfhi(gw.y);
                    const float r4 = p1[0] + a1[0] * bflo(gw.z), r5 = p1[1] + a1[1] * bfhi(gw.z), r6 = p1[2] + a1[2] * bflo(gw.w), r7 = p1[3] + a1[3] * bfhi(gw.w);
                    u32x4 w; w.x = cvt_pk_bf16(r0, r1); w.y = cvt_pk_bf16(r2, r3); w.z = cvt_pk_bf16(r4, r5); w.w = cvt_pk_bf16(r6, r7);
                    *(u32x4*)(O + row * ldc + col) = w; }
                if (m & 1) asm volatile("" ::: "memory"); }
    }
};
struct EpiResid {
    static constexpr bool PERM = false, AFTER_DRAIN = false;
    const float* base; float* out; int ldc; float alpha;
    __device__ __forceinline__ void operator()(const f32x4 (&acc)[2][2][4][2], const Unit& u, int wr, int wc, int fr, int fq) const {
        const int row0 = u.pm * BM + wr * 64 + fr, col0 = u.pn * BM + wc * 32 + 4 * fq;
#pragma unroll
        for (int ai = 0; ai < 2; ++ai)
#pragma unroll
            for (int m = 0; m < 4; ++m) { const size_t off = (size_t)(row0 + ai * HALF + m * 16) * ldc + col0;
#pragma unroll
                for (int bj = 0; bj < 2; ++bj)
#pragma unroll
                    for (int n = 0; n < 2; ++n) { const f32x4 b = *(const f32x4*)(base + off + bj * HALF + n * 16);
                        *(f32x4*)(out + off + bj * HALF + n * 16) = b * alpha + acc[ai][bj][m][n]; }
                if (m & 1) asm volatile("" ::: "memory"); }
    }
};

struct EpiGateMerge {
    static constexpr bool PERM = true, AFTER_DRAIN = false;
    bf16_t* O; int ldc; const bf16_t* ga; const bf16_t* gc; int ldg;
    __device__ __forceinline__ void mid(f32x4 (&acc)[2][2][4][2], const Unit& u, int wr, int wc, int fr, int fq) const {
        int row0 = u.pm * BM + wr * 64 + fr, col0 = u.pn * BM + wc * 32 + 8 * fq;
        asm volatile("" : "+v"(row0), "+v"(col0));
#pragma unroll
        for (int ai = 0; ai < 2; ++ai) { u32x4 av[4][2];
#pragma unroll
            for (int m = 0; m < 4; ++m)
#pragma unroll
                for (int bj = 0; bj < 2; ++bj) av[m][bj] = *(const u32x4*)(ga + (size_t)(row0 + ai * HALF + m * 16) * ldg + col0 + bj * HALF);
            asm volatile("" ::: "memory");
#pragma unroll
            for (int m = 0; m < 4; ++m)
#pragma unroll
                for (int bj = 0; bj < 2; ++bj) { const u32x4 a = av[m][bj]; f32x4& v0 = acc[ai][bj][m][0]; f32x4& v1 = acc[ai][bj][m][1];
                    v0[0] *= bflo(a.x); v0[1] *= bfhi(a.x); v0[2] *= bflo(a.y); v0[3] *= bfhi(a.y); v1[0] *= bflo(a.z); v1[1] *= bfhi(a.z); v1[2] *= bflo(a.w); v1[3] *= bfhi(a.w); }
            asm volatile("" ::: "memory"); }
    }
    __device__ __forceinline__ void operator()(const f32x4 (&acc)[2][2][4][2], const Unit& u, int wr, int wc, int fr, int fq) const {
        const int row0 = u.pm * BM + wr * 64 + fr, col0 = u.pn * BM + wc * 32 + 8 * fq;
        u32x4 cv[2][4][2];
#pragma unroll
        for (int ai = 0; ai < 2; ++ai)
#pragma unroll
            for (int m = 0; m < 4; ++m)
#pragma unroll
                for (int bj = 0; bj < 2; ++bj) cv[ai][m][bj] = *(const u32x4*)(gc + (size_t)(row0 + ai * HALF + m * 16) * ldg + col0 + bj * HALF);
        asm volatile("" ::: "memory");
#pragma unroll
        for (int ai = 0; ai < 2; ++ai)
#pragma unroll
            for (int m = 0; m < 4; ++m)
#pragma unroll
                for (int bj = 0; bj < 2; ++bj) { const u32x4 c = cv[ai][m][bj]; const f32x4 a0 = acc[ai][bj][m][0], a1 = acc[ai][bj][m][1];
                    u32x4 w; w.x = cvt_pk_bf16(a0[0] * bflo(c.x), a0[1] * bfhi(c.x)); w.y = cvt_pk_bf16(a0[2] * bflo(c.y), a0[3] * bfhi(c.y));
                    w.z = cvt_pk_bf16(a1[0] * bflo(c.z), a1[1] * bfhi(c.z)); w.w = cvt_pk_bf16(a1[2] * bflo(c.w), a1[3] * bfhi(c.w));
                    *(u32x4*)(O + (size_t)(row0 + ai * HALF + m * 16) * ldc + col0 + bj * HALF) = w; }
    }
};

typedef _Float16 h16x2 __attribute__((ext_vector_type(2)));
__device__ __forceinline__ unsigned pk_h2(float lo, float hi) { const h16x2 v = {(_Float16)lo, (_Float16)hi}; return __builtin_bit_cast(unsigned, v); }
__device__ __forceinline__ float h_lo(unsigned w) { return (float)__builtin_bit_cast(h16x2, w)[0]; }
__device__ __forceinline__ float h_hi(unsigned w) { return (float)__builtin_bit_cast(h16x2, w)[1]; }
template <bool BH> struct EpiResidH {
    static constexpr bool PERM = true, AFTER_DRAIN = false;
    const void* base; bf16_t* O;
    static constexpr int ldc = 4096; static constexpr float alpha = 1.189207115002721f;
    __device__ __forceinline__ void operator()(const f32x4 (&acc)[2][2][4][2], const Unit& u, int wr, int wc, int fr, int fq) const {
        const int row0 = u.pm * BM + wr * 64 + fr, col0 = u.pn * BM + wc * 32 + 8 * fq;
#pragma unroll
        for (int ai = 0; ai < 2; ++ai) {
            u32x4 hw[4][2]; f32x4 fw[4][2][2];
#pragma unroll
            for (int m = 0; m < 4; ++m)
#pragma unroll
                for (int bj = 0; bj < 2; ++bj) { const size_t off = (size_t)(row0 + ai * HALF + m * 16) * ldc + col0 + bj * HALF;
                    if constexpr (BH) hw[m][bj] = *(const u32x4*)((const bf16_t*)base + off);
                    else { fw[m][bj][0] = *(const f32x4*)((const float*)base + off); fw[m][bj][1] = *(const f32x4*)((const float*)base + off + 4); } }
            asm volatile("" ::: "memory");
#pragma unroll
            for (int m = 0; m < 4; ++m)
#pragma unroll
                for (int bj = 0; bj < 2; ++bj) { const size_t off = (size_t)(row0 + ai * HALF + m * 16) * ldc + col0 + bj * HALF; f32x4 b0, b1;
                    if constexpr (BH) { const u32x4 h = hw[m][bj]; b0 = (f32x4){h_lo(h.x), h_hi(h.x), h_lo(h.y), h_hi(h.y)}; b1 = (f32x4){h_lo(h.z), h_hi(h.z), h_lo(h.w), h_hi(h.w)}; }
                    else { b0 = fw[m][bj][0]; b1 = fw[m][bj][1]; }
                    const f32x4 v0 = b0 * alpha + acc[ai][bj][m][0], v1 = b1 * alpha + acc[ai][bj][m][1];
                    u32x4 w; w.x = pk_h2(v0[0], v0[1]); w.y = pk_h2(v0[2], v0[3]); w.z = pk_h2(v1[0], v1[1]); w.w = pk_h2(v1[2], v1[3]);
                    *(u32x4*)(O + off) = w; }
            asm volatile("" ::: "memory"); }
    }
};

template <int CTRL> __device__ __forceinline__ float dppf(float old, float src) { return __int_as_float(__builtin_amdgcn_update_dpp(__float_as_int(old), __float_as_int(src), CTRL, 0xf, 0xf, false)); }
#define PG8_CONV2(c0, c1, x0, x1, p0, p1, wc0, wc1, wb0, wb1, wbz0, wbz1, wa0, wa1, waz0, waz1) \
    asm volatile("v_mul_f32 %0, %6, %2\n\tv_mul_f32 %1, %7, %3\n\t" \
                 "v_fmac_f32_dpp %0, %2, %8 row_shr:1 row_mask:0xf bank_mask:0xf\n\tv_fmac_f32_dpp %1, %3, %9 row_shr:1 row_mask:0xf bank_mask:0xf\n\t" \
                 "v_fmac_f32_dpp %0, %4, %10 row_ror:1 row_mask:0xf bank_mask:0xf\n\tv_fmac_f32_dpp %1, %5, %11 row_ror:1 row_mask:0xf bank_mask:0xf\n\t" \
                 "v_fmac_f32_dpp %0, %2, %12 row_shr:2 row_mask:0xf bank_mask:0xf\n\tv_fmac_f32_dpp %1, %3, %13 row_shr:2 row_mask:0xf bank_mask:0xf\n\t" \
                 "v_fmac_f32_dpp %0, %4, %14 row_ror:2 row_mask:0xf bank_mask:0xf\n\tv_fmac_f32_dpp %1, %5, %15 row_ror:2 row_mask:0xf bank_mask:0xf" \
                 : "=&v"(c0), "=&v"(c1) : "v"(x0), "v"(x1), "v"(p0), "v"(p1), "v"(wc0), "v"(wc1), "v"(wb0), "v"(wb1), "v"(wbz0), "v"(wbz1), "v"(wa0), "v"(wa1), "v"(waz0), "v"(waz1))
struct EpiConvSilu {
    static constexpr bool PERM = true, AFTER_DRAIN = false;
    bf16_t* G; int ldg; const float* cw; int nup, dff; float* halo; int nN; PG8_LAS float* H;
    __device__ __forceinline__ void operator()(const f32x4 (&acc)[2][2][4][2], const Unit& u, int wr, int wc, int fr, int fq) const {
        const int lc = wc * 32 + 8 * fq, ch = u.pn * 128 + lc;
#pragma unroll
        for (int ai = 0; ai < 2; ++ai) { const int blk = 2 * ai + wr;
            if (fr >= 14) {
#pragma unroll
                for (int bj = 0; bj < 2; ++bj)
#pragma unroll
                    for (int n = 0; n < 2; ++n) *(PG8_LAS f32x4*)(H + (blk * 2 + (fr - 14)) * 256 + bj * 128 + lc + 4 * n) = acc[ai][bj][3][n]; } }
        float* hg = halo + ((size_t)u.pm * nN + u.pn) * 1024;
        if (wr == 0 && fr < 2) {
#pragma unroll
            for (int bj = 0; bj < 2; ++bj)
#pragma unroll
                for (int n = 0; n < 2; ++n) *(f32x4*)(hg + fr * 256 + bj * 128 + lc + 4 * n) = acc[0][bj][0][n]; }
        if (wr == 1 && fr >= 14) {
#pragma unroll
            for (int bj = 0; bj < 2; ++bj)
#pragma unroll
                for (int n = 0; n < 2; ++n) *(f32x4*)(hg + (2 + fr - 14) * 256 + bj * 128 + lc + 4 * n) = acc[1][bj][3][n]; }
        asm volatile("s_waitcnt lgkmcnt(0)" ::: "memory"); __builtin_amdgcn_s_barrier(); asm volatile("" ::: "memory");
        f32x4 sg[2][4][2];
#pragma unroll
        for (int bj = 0; bj < 2; ++bj) {
            f32x4 wgt[3][2], wbz[2], waz[2];
#pragma unroll
            for (int k = 0; k < 3; ++k)
#pragma unroll
                for (int n = 0; n < 2; ++n) wgt[k][n] = *(const f32x4*)(cw + (size_t)k * nup + bj * dff + ch + 4 * n);
#pragma unroll
            for (int n = 0; n < 2; ++n)
#pragma unroll
                for (int i = 0; i < 4; ++i) { wbz[n][i] = fr == 0 ? wgt[1][n][i] : 0.f; waz[n][i] = fr < 2 ? wgt[0][n][i] : 0.f; }
#pragma unroll
            for (int ai = 0; ai < 2; ++ai) { const int blk = 2 * ai + wr;
                f32x4 pv[2];
#pragma unroll
                for (int n = 0; n < 2; ++n) { pv[n] = (f32x4){0.f, 0.f, 0.f, 0.f};
                    if (blk >= 1 && fr >= 14) pv[n] = *(const PG8_LAS f32x4*)(H + ((blk - 1) * 2 + (fr - 14)) * 256 + bj * 128 + lc + 4 * n); }
#pragma unroll
                for (int mm = 0; mm < 4; ++mm) { const int m = 3 - mm; f32x4 c[2];
#pragma unroll
                    for (int n = 0; n < 2; ++n) { const f32x4 cur = acc[ai][bj][m][n]; const f32x4 prv = (m == 0) ? pv[n] : acc[ai][bj][m == 0 ? 0 : m - 1][n];
#pragma unroll
                        for (int i = 0; i < 4; i += 2) { float c0, c1;
                            PG8_CONV2(c0, c1, cur[i], cur[i + 1], prv[i], prv[i + 1], wgt[2][n][i], wgt[2][n][i + 1], wgt[1][n][i], wgt[1][n][i + 1], wbz[n][i], wbz[n][i + 1],
                                      wgt[0][n][i], wgt[0][n][i + 1], waz[n][i], waz[n][i + 1]);
                            c[n][i] = c0; c[n][i + 1] = c1; } }
                    if (bj == 0) {
#pragma unroll
                        for (int n = 0; n < 2; ++n)
#pragma unroll
                            for (int i = 0; i < 4; ++i) sg[ai][m][n][i] = c[n][i] * sigm(c[n][i]);
                    } else {
                        float y[8];
#pragma unroll
                        for (int n = 0; n < 2; ++n)
#pragma unroll
                            for (int i = 0; i < 4; ++i) y[4 * n + i] = sg[ai][m][n][i] * c[n][i];
                        u32x4 w; w.x = cvt_pk_bf16(y[0], y[1]); w.y = cvt_pk_bf16(y[2], y[3]); w.z = cvt_pk_bf16(y[4], y[5]); w.w = cvt_pk_bf16(y[6], y[7]);
                        *(u32x4*)(G + (size_t)(u.pm * BM + ai * HALF + wr * 64 + m * 16 + fr) * ldg + ch) = w; } } } }
    }
};
typedef _Float16 f16x8 __attribute__((ext_vector_type(8)));
template <bool F16> __device__ __forceinline__ f32x4 mma16(bf16x8 a, bf16x8 b, f32x4 c) {
    if constexpr (F16) return __builtin_amdgcn_mfma_f32_16x16x32_f16(__builtin_bit_cast(f16x8, a), __builtin_bit_cast(f16x8, b), c, 0, 0, 0);
    else return __builtin_amdgcn_mfma_f32_16x16x32_bf16(a, b, c, 0, 0, 0); }
template <class Epi, class Sched, bool ALIGN_EPI = false, bool SP2 = false, bool MID = false, bool F16 = false>
__device__ __forceinline__ void gemm_phase(PG8_LAS unsigned char* lds, const Gemm g, const Sched& S, const Epi& E) {
    int tid_ = threadIdx.x; asm volatile("" : "+v"(tid_));
    const int tid = tid_, wid = __builtin_amdgcn_readfirstlane(tid >> 6), lane = tid & 63, wr = wid >> 2, wc = wid & 3, fr = lane & 15, fq = lane >> 4;
    const int K = g.K, nt = K / BK;
    unsigned voffA[2], voffB[2];
#pragma unroll
    for (int i = 0; i < 2; ++i) { int R, C; stage_rc(tid * 16 + i * 8192, R, C); const int Rb = Epi::PERM ? ((R & ~31) + perm32(R & 31)) : R;
        voffA[i] = (unsigned)(R * K + C) * 2u; voffB[i] = (unsigned)(Rb * K + C) * 2u; }
    const size_t kstep = (size_t)(BK * 2);
    const size_t hstep = (size_t)HALF * K * 2;
    const size_t tstep = 2 * hstep;
    const unsigned ldsw = (unsigned)wid * 1024u;
    const int aoff = lds_byte(wr * 64 + fr, fq * 8), boff = lds_byte(wc * 32 + fr, fq * 8);
#define PG8_SA(b, h) (((b) * 2 + (h)) * HTB)
#define PG8_SB(b, h) ((4 + (b) * 2 + (h)) * HTB)
#define PG8_STAGE(bufoff, gbase, voff) do { _Pragma("unroll") for (int _i = 0; _i < 2; ++_i) \
        __builtin_amdgcn_global_load_lds((const unsigned*)((const char*)(gbase) + (voff)[_i]), (PG8_LAS unsigned*)(lds + (bufoff) + ldsw + _i * 8192), 16, 0, 0); } while (0)
#define PG8_LDA(dst, b, h) do { _Pragma("unroll") for (int m = 0; m < 4; ++m) _Pragma("unroll") for (int k = 0; k < 2; ++k) dst[m][k] = *(const PG8_LAS bf16x8*)(lds + PG8_SA(b, h) + aoff + m * 2048 + k * 1024); } while (0)
#define PG8_LDB(dst, b, h) do { _Pragma("unroll") for (int n = 0; n < 2; ++n) _Pragma("unroll") for (int k = 0; k < 2; ++k) dst[n][k] = *(const PG8_LAS bf16x8*)(lds + PG8_SB(b, h) + boff + n * 2048 + k * 1024); } while (0)
#define PG8_MMA(ai, bj, At, Bt) do { __builtin_amdgcn_s_setprio(1); _Pragma("unroll") for (int m = 0; m < 4; ++m) _Pragma("unroll") for (int n = 0; n < 2; ++n) _Pragma("unroll") for (int k = 0; k < 2; ++k) \
        acc[ai][bj][m][n] = mma16<F16>(Bt[n][k], At[m][k], acc[ai][bj][m][n]); __builtin_amdgcn_s_setprio(0); } while (0)
#define PG8_WAIT_V(n) asm volatile("s_waitcnt vmcnt(" #n ")" ::: "memory")
#define PG8_WAIT_L(n) asm volatile("s_waitcnt lgkmcnt(" #n ")" ::: "memory")
#define PG8_BAR __builtin_amdgcn_s_barrier()
#define PG8_SCHED __builtin_amdgcn_sched_barrier(0)
    Unit cur, nxt; int ui = 0;
    if (!S.next(0, cur)) return;
    f32x4 acc[2][2][4][2];
#pragma unroll
    for (int a = 0; a < 2; ++a)
#pragma unroll
        for (int b = 0; b < 2; ++b)
#pragma unroll
            for (int m = 0; m < 4; ++m)
#pragma unroll
                for (int n = 0; n < 2; ++n) acc[a][b][m][n] = (f32x4){0.f, 0.f, 0.f, 0.f};
    bf16x8 At[4][2], B0[2][2], B1[2][2];
    const char* cA = (const char*)g.A + (size_t)cur.pm * tstep; const char* cB = (const char*)g.Bt + (size_t)cur.pn * tstep;
    S.a_ready(cur);
    if constexpr (SP2) {
        PG8_STAGE(PG8_SB(0, 0), cB, voffB); PG8_STAGE(PG8_SB(0, 1), cB + hstep, voffB); PG8_STAGE(PG8_SA(0, 0), cA, voffA); PG8_STAGE(PG8_SA(0, 1), cA + hstep, voffA);
        if (wr == 1) PG8_BAR;
        PG8_WAIT_V(2); PG8_BAR;
        PG8_STAGE(PG8_SB(1, 0), cB + kstep, voffB); PG8_STAGE(PG8_SA(1, 0), cA + kstep, voffA); PG8_STAGE(PG8_SB(1, 1), cB + hstep + kstep, voffB);
        PG8_WAIT_V(6); PG8_BAR;
    } else {
        PG8_STAGE(PG8_SB(0, 0), cB, voffB); PG8_STAGE(PG8_SA(0, 0), cA, voffA); PG8_STAGE(PG8_SB(0, 1), cB + hstep, voffB); PG8_STAGE(PG8_SA(0, 1), cA + hstep, voffA);
        if (wr == 1) PG8_BAR;
        PG8_WAIT_V(4); PG8_BAR;
        PG8_STAGE(PG8_SB(1, 0), cB + kstep, voffB); PG8_STAGE(PG8_SA(1, 0), cA + kstep, voffA); PG8_STAGE(PG8_SB(1, 1), cB + hstep + kstep, voffB);
        PG8_WAIT_V(6); PG8_BAR;
    }
    for (;;) {
        const bool has_next = S.next(ui + 1, nxt);
        const char* nA = has_next ? (const char*)g.A + (size_t)nxt.pm * tstep : cA; const char* nB = has_next ? (const char*)g.Bt + (size_t)nxt.pn * tstep : cB;
        for (int t = 0; t < nt; t += 2) {
            if constexpr (MID) { if (t == (nt >> 1)) E.mid(acc, cur, wr, wc, fr, fq); }
            const bool last = (t == nt - 2);
            const char* a1 = cA + (size_t)(t + 1) * kstep;
            const char* a2 = last ? nA : cA + (size_t)(t + 2) * kstep; const char* b2 = last ? nB : cB + (size_t)(t + 2) * kstep;
            const char* a3 = a2 + kstep; const char* b3 = b2 + kstep;
            if (last && has_next) S.a_ready(nxt);
            if constexpr (SP2) {
            PG8_LDB(B0, 0, 0); PG8_LDB(B1, 0, 1); PG8_SCHED; PG8_LDA(At, 0, 0); PG8_STAGE(PG8_SA(1, 1), a1 + hstep, voffA);
            PG8_WAIT_V(8); PG8_WAIT_L(0); PG8_BAR; PG8_MMA(0, 0, At, B0); PG8_MMA(0, 1, At, B1); PG8_BAR; PG8_SCHED;
            PG8_LDA(At, 0, 1); PG8_STAGE(PG8_SB(0, 0), b2, voffB); PG8_STAGE(PG8_SB(0, 1), b2 + hstep, voffB); PG8_STAGE(PG8_SA(0, 0), a2, voffA);
            PG8_WAIT_V(8); PG8_WAIT_L(0); PG8_BAR; PG8_MMA(1, 0, At, B0); PG8_MMA(1, 1, At, B1); PG8_BAR; PG8_SCHED;
            PG8_LDB(B0, 1, 0); PG8_LDB(B1, 1, 1); PG8_SCHED; PG8_LDA(At, 1, 0); PG8_STAGE(PG8_SA(0, 1), a2 + hstep, voffA);
            PG8_WAIT_V(8); PG8_WAIT_L(0); PG8_BAR; PG8_MMA(0, 0, At, B0); PG8_MMA(0, 1, At, B1); PG8_BAR; PG8_SCHED;
            PG8_LDA(At, 1, 1); PG8_STAGE(PG8_SB(1, 0), b3, voffB); PG8_STAGE(PG8_SB(1, 1), b3 + hstep, voffB); PG8_STAGE(PG8_SA(1, 0), a3, voffA);
            PG8_WAIT_V(8); PG8_WAIT_L(0); PG8_BAR; PG8_MMA(1, 0, At, B0); PG8_MMA(1, 1, At, B1); PG8_BAR; PG8_SCHED;
            } else {
            PG8_LDB(B0, 0, 0); PG8_SCHED; PG8_LDA(At, 0, 0); PG8_STAGE(PG8_SA(1, 1), a1 + hstep, voffA);
            PG8_WAIT_L(8); PG8_BAR; PG8_WAIT_L(0); PG8_MMA(0, 0, At, B0); PG8_BAR; PG8_SCHED;
            PG8_LDB(B1, 0, 1); PG8_STAGE(PG8_SB(0, 0), b2, voffB);
            PG8_BAR; PG8_WAIT_L(0); PG8_MMA(0, 1, At, B1); PG8_BAR;
            PG8_LDA(At, 0, 1); PG8_STAGE(PG8_SA(0, 0), a2, voffA);
            PG8_BAR; PG8_WAIT_L(0); PG8_MMA(1, 0, At, B0); PG8_BAR; PG8_SCHED;
            PG8_STAGE(PG8_SB(0, 1), b2 + hstep, voffB);
            PG8_WAIT_V(6); PG8_BAR; PG8_MMA(1, 1, At, B1); PG8_BAR;
            PG8_LDB(B0, 1, 0); PG8_SCHED; PG8_LDA(At, 1, 0); PG8_STAGE(PG8_SA(0, 1), a2 + hstep, voffA);
            PG8_WAIT_L(8); PG8_BAR; PG8_WAIT_L(0); PG8_MMA(0, 0, At, B0); PG8_BAR; PG8_SCHED;
            PG8_LDB(B1, 1, 1); PG8_STAGE(PG8_SB(1, 0), b3, voffB);
            PG8_BAR; PG8_WAIT_L(0); PG8_MMA(0, 1, At, B1); PG8_BAR;
            PG8_LDA(At, 1, 1); PG8_STAGE(PG8_SA(1, 0), a3, voffA);
            PG8_BAR; PG8_WAIT_L(0); PG8_MMA(1, 0, At, B0); PG8_BAR; PG8_SCHED;
            PG8_STAGE(PG8_SB(1, 1), b3 + hstep, voffB);
            PG8_WAIT_V(6); PG8_BAR; PG8_MMA(1, 1, At, B1); PG8_BAR;
            }
        }
        if constexpr (ALIGN_EPI) { if (wr == 0) PG8_BAR; }
        if constexpr (!Epi::AFTER_DRAIN) { E(acc, cur, wr, wc, fr, fq); S.done(cur); }
        if (!has_next) break;
#pragma unroll
        for (int a = 0; a < 2; ++a)
#pragma unroll
            for (int b = 0; b < 2; ++b)
#pragma unroll
                for (int m = 0; m < 4; ++m)
#pragma unroll
                    for (int n = 0; n < 2; ++n) acc[a][b][m][n] = (f32x4){0.f, 0.f, 0.f, 0.f};
        cur = nxt; cA = nA; cB = nB; ++ui;
        if constexpr (ALIGN_EPI) { if (wr == 1) PG8_BAR; }
    }
    PG8_WAIT_V(0);
    if constexpr (!ALIGN_EPI) { if (wr == 0) PG8_BAR; }
    PG8_BAR;
    if constexpr (Epi::AFTER_DRAIN) { E.fused(acc, cur, wr, wc, fr, fq, lds, wid, lane); S.done(cur); }
#undef PG8_SA
#undef PG8_SB
#undef PG8_STAGE
#undef PG8_LDA
#undef PG8_LDB
#undef PG8_MMA
#undef PG8_WAIT_V
#undef PG8_WAIT_L
#undef PG8_BAR
#undef PG8_SCHED
}
}
namespace swa {
constexpr int D = 128;
constexpr int LDP = 20480;
constexpr int LDO = 2048;
constexpr float THR = 8.f;
constexpr bool WSKIP = false;
constexpr float SCALE = 0.08838834764831845f;
constexpr int NW = 8, QBLK = 32, KVBLK = 64, QB = NW * QBLK;
constexpr int SHM_V = KVBLK * D * 2, SHM_K = KVBLK * D * 2;
constexpr int LDS_BYTES = 2 * SHM_V + 2 * SHM_K + NW * 64 * 4;
static_assert(D == 128, "geometry");

using bf16 = __hip_bfloat16;
typedef short bf16x8 __attribute__((ext_vector_type(8)));
typedef short s16x4 __attribute__((ext_vector_type(4)));
typedef float f32x16 __attribute__((ext_vector_type(16)));
typedef float f32x4 __attribute__((ext_vector_type(4)));
typedef unsigned u32x4 __attribute__((ext_vector_type(4)));
template <class A, class Bt> struct same_t { static constexpr bool v = false; };
template <class A> struct same_t<A, A> { static constexpr bool v = true; };

#define KSWZ(row, colB) ((row) * 256 + ((colB) ^ (((row) & 7) << 4)))
#define SBAR() __builtin_amdgcn_sched_barrier(0)
__device__ __forceinline__ int v_st(int k, int c) { const int kk = (k & ~0xC) | ((k & 4) << 1) | ((k & 8) >> 1); return ((kk >> 3) * 4 + (c >> 5)) * 512 + ((kk & 7) * 32 + (c & 31)) * 2; }
__device__ __forceinline__ int v_rd_base(int lane) { return ((lane & 3) << 3) | (((lane >> 2) & 3) << 6) | (((lane >> 4) & 1) << 5) | (((lane >> 5) & 1) << 8); }
constexpr int v_rd_off(int d0, int ks, int half) { return d0 * 512 + ks * 4096 + half * 2048; }
__device__ __forceinline__ int crow(int r, int hi) { return (r & 3) + 8 * (r >> 2) + 4 * hi; }
__device__ __forceinline__ unsigned cvtpk(float lo, float hi) {
    unsigned r; asm volatile("v_cvt_pk_bf16_f32 %0, %1, %2" : "=v"(r) : "v"(lo), "v"(hi)); return r;
}
__device__ __forceinline__ bf16x8 pack8(f32x4 a, f32x4 b) {
    u32x4 w = {cvtpk(a[0], a[1]), cvtpk(a[2], a[3]), cvtpk(b[0], b[1]), cvtpk(b[2], b[3])};
    return *reinterpret_cast<bf16x8*>(&w);
}
template <class T> __device__ __forceinline__ bf16x8 load8(const T* p) {
    if constexpr (same_t<T, float>::v) { return pack8(*(const f32x4*)p, *(const f32x4*)(p + 4)); }
    else { return *reinterpret_cast<const bf16x8*>(p); }
}
__device__ __forceinline__ void mask_tile(f32x16& p0, f32x16& p1, int dq, unsigned W) {
    const float NEG = -__builtin_inff();
#pragma unroll
    for (int r = 0; r < 16; ++r) {
        const int c = (r & 3) + 8 * (r >> 2);
        if ((unsigned)(dq - c) >= W) p0[r] = NEG;
        if ((unsigned)(dq - c - 32) >= W) p1[r] = NEG;
    }
}
__device__ __forceinline__ void partialSM(f32x16& p0, f32x16& p1, float& m_reg, float& mn, float& alpha) {
    float pmax = p0[0]; for (int r = 1; r < 16; ++r) pmax = fmaxf(pmax, p0[r]); for (int r = 0; r < 16; ++r) pmax = fmaxf(pmax, p1[r]);
    { auto rr = __builtin_amdgcn_permlane32_swap(__float_as_uint(pmax), __float_as_uint(pmax), false, false);
      pmax = fmaxf(__uint_as_float(rr[0]), __uint_as_float(rr[1])); }
    constexpr float C2 = 1.4426950408889634f * SCALE;
    if (__builtin_expect(__all((pmax - m_reg) * SCALE <= THR), 1)) { mn = m_reg; alpha = 1.f; }
    else { mn = fmaxf(m_reg, pmax); alpha = __builtin_amdgcn_exp2f((m_reg - mn) * C2); m_reg = mn; }
    const float mnL = -mn * C2;
    for (int r = 0; r < 16; ++r) p0[r] = fmaf(p0[r], C2, mnL); for (int r = 0; r < 16; ++r) p1[r] = fmaf(p1[r], C2, mnL);
    for (int r = 0; r < 16; ++r) p0[r] = __builtin_amdgcn_exp2f(p0[r]);
}
__device__ __forceinline__ void finishSM(f32x16& p0, f32x16& p1, float alpha, float& l_reg, bf16x8& pa0, bf16x8& pa1, bf16x8& pa2, bf16x8& pa3) {
    for (int r = 0; r < 16; ++r) p1[r] = __builtin_amdgcn_exp2f(p1[r]);
    float ps = 0; for (int r = 0; r < 16; ++r) ps += p0[r]; for (int r = 0; r < 16; ++r) ps += p1[r];
    { auto rr = __builtin_amdgcn_permlane32_swap(__float_as_uint(ps), __float_as_uint(ps), false, false);
      ps = __uint_as_float(rr[0]) + __uint_as_float(rr[1]); }
    l_reg = l_reg * alpha + ps;
#define PK4(P, B_, OUT) do { unsigned a0 = cvtpk(P[B_+0], P[B_+1]), a1 = cvtpk(P[B_+2], P[B_+3]);                          \
        unsigned b0 = cvtpk(P[B_+4], P[B_+5]), b1 = cvtpk(P[B_+6], P[B_+7]);                                             \
        auto r0 = __builtin_amdgcn_permlane32_swap(a0, b0, false, false); auto r1 = __builtin_amdgcn_permlane32_swap(a1, b1, false, false); \
        u32x4 w = {r0[0], r1[0], r0[1], r1[1]}; OUT = *reinterpret_cast<bf16x8*>(&w); } while (0)
    PK4(p0, 0, pa0); PK4(p0, 8, pa1); PK4(p1, 0, pa2); PK4(p1, 8, pa3);
#undef PK4
}
template <int KB, bool SK>
__device__ __forceinline__ void qkt(f32x16& p0, f32x16& p1, const char* K_lds, int r32, int hi, const bf16x8* qr, bool act) {
    if (SK && !act) { const float NEG = -__builtin_inff();
#pragma unroll
        for (int r = 0; r < 16; ++r) { p0[r] = NEG; p1[r] = NEG; } return; }
    p0 = f32x16{}; p1 = f32x16{};
    const char* kb[4];
#pragma unroll
    for (int dd = 0; dd < 4; ++dd) kb[dd] = K_lds + KB * SHM_K + KSWZ(r32, (dd * 16 + hi * 8) * 2);
#pragma unroll
    for (int d0 = 0; d0 < 8; ++d0) { const char* a = kb[d0 & 3] + (d0 >> 2) * 128;
        bf16x8 b0 = *reinterpret_cast<const bf16x8*>(a);
        bf16x8 b1 = *reinterpret_cast<const bf16x8*>(a + 32 * 256);
        p0 = __builtin_amdgcn_mfma_f32_32x32x16_bf16(b0, qr[d0], p0, 0, 0, 0);
        p1 = __builtin_amdgcn_mfma_f32_32x32x16_bf16(b1, qr[d0], p1, 0, 0, 0); }
}
template <int VB, bool SK>
__device__ __forceinline__ void pv_tile(f32x16* o, int vb0, bf16x8 pa0, bf16x8 pa1, bf16x8 pa2, bf16x8 pa3, bool act) {
    if (SK && !act) return;
#define TRRD(dst, off) asm volatile("ds_read_b64_tr_b16 %0, %1 offset:%2" : "=&v"(dst) : "v"(vb0), "i"(off) : "memory")
#define PV_D0(d0) do { s16x4 l0, l1, l2, l3, h0, h1, h2, h3; constexpr int b_ = VB * SHM_V + v_rd_off(d0, 0, 0);     \
        TRRD(l0, b_); TRRD(h0, b_ + 2048); TRRD(l1, b_ + 4096); TRRD(h1, b_ + 6144); TRRD(l2, b_ + 8192); TRRD(h2, b_ + 10240); TRRD(l3, b_ + 12288); TRRD(h3, b_ + 14336); \
        asm volatile("s_waitcnt lgkmcnt(0)" ::: "memory"); SBAR();                 \
        o[d0] = __builtin_amdgcn_mfma_f32_32x32x16_bf16(pa0, (bf16x8){l0[0], l0[1], l0[2], l0[3], h0[0], h0[1], h0[2], h0[3]}, o[d0], 0, 0, 0);   \
        o[d0] = __builtin_amdgcn_mfma_f32_32x32x16_bf16(pa1, (bf16x8){l1[0], l1[1], l1[2], l1[3], h1[0], h1[1], h1[2], h1[3]}, o[d0], 0, 0, 0);   \
        o[d0] = __builtin_amdgcn_mfma_f32_32x32x16_bf16(pa2, (bf16x8){l2[0], l2[1], l2[2], l2[3], h2[0], h2[1], h2[2], h2[3]}, o[d0], 0, 0, 0);   \
        o[d0] = __builtin_amdgcn_mfma_f32_32x32x16_bf16(pa3, (bf16x8){l3[0], l3[1], l3[2], l3[3], h3[0], h3[1], h3[2], h3[3]}, o[d0], 0, 0, 0); } while (0)
    PV_D0(0); PV_D0(1); PV_D0(2); PV_D0(3);
#undef PV_D0
#undef TRRD
}

template <class TIn, class TOut> struct BlockRef { const TIn* Q; const TIn* K; const TIn* V; TOut* O; int P0; };
template <class TIn> struct Seam {
    bf16x8 qr[8];
    bf16x8 st_v0, st_v1, st_k0, st_k1; f32x4 sf0, sf1, sf2, sf3;
    f32x4 tq[16];
};
__device__ __forceinline__ int swa_jlo(int P0, int W) { const int lowk = P0 - W + 1; return lowk > 0 ? lowk / KVBLK : 0; }
#define ROW(p, k0, rr) ((p) + (size_t)((k0) + (rr)) * LDP + sc)
#define VMW() asm volatile("s_waitcnt vmcnt(0)" ::: "memory")
#define VMWN(n) asm volatile("s_waitcnt vmcnt(%0)" :: "i"(n) : "memory")
#define SLOAD_H(Kp, Vp, k0) do { S.st_v0 = load8<TIn>(ROW(Vp, k0, sr)); S.st_v1 = load8<TIn>(ROW(Vp, k0, 32 + sr));              \
                         S.st_k0 = load8<TIn>(ROW(Kp, k0, sr)); S.st_k1 = load8<TIn>(ROW(Kp, k0, 32 + sr)); } while (0)
#define SWRITE_HK(bf) do { *(bf16x8*)(K_lds + (bf) * SHM_K + kws) = S.st_k0; *(bf16x8*)(K_lds + (bf) * SHM_K + kws + 32 * 256) = S.st_k1; } while (0)
#define SWRITE_HV(bf) do { *(bf16x8*)(V_lds + (bf) * SHM_V + vst0) = S.st_v0; *(bf16x8*)(V_lds + (bf) * SHM_V + vst1) = S.st_v1; } while (0)
#define SWRITE_H(bf) do { SWRITE_HV(bf); SWRITE_HK(bf); } while (0)
#define SLOAD_F(p, k0) do { S.sf0 = *(const f32x4*)ROW(p, k0, sr); S.sf1 = *(const f32x4*)(ROW(p, k0, sr) + 4);                \
                            S.sf2 = *(const f32x4*)ROW(p, k0, 32 + sr); S.sf3 = *(const f32x4*)(ROW(p, k0, 32 + sr) + 4); } while (0)
#define SWRITE_KF(bf) do { *(bf16x8*)(K_lds + (bf) * SHM_K + kws) = pack8(S.sf0, S.sf1); *(bf16x8*)(K_lds + (bf) * SHM_K + kws + 32 * 256) = pack8(S.sf2, S.sf3); } while (0)
#define SWRITE_VF(bf) do { *(bf16x8*)(V_lds + (bf) * SHM_V + vst0) = pack8(S.sf0, S.sf1); *(bf16x8*)(V_lds + (bf) * SHM_V + vst1) = pack8(S.sf2, S.sf3); } while (0)
template <class TIn, class TOut>
__device__ __forceinline__ void causal_swa_prime(const BlockRef<TIn, TOut>& cur, int W, char* lds, Seam<TIn>& S) {
    constexpr bool F32 = same_t<TIn, float>::v;
    int tid_ = threadIdx.x; asm volatile("" : "+v"(tid_));
    const int tid = tid_, wid = __builtin_amdgcn_readfirstlane(tid >> 6), lane = tid & 63, r32 = lane & 31, hi = lane >> 5;
    const int sr = tid >> 4, sc = (tid & 15) * 8, kws = KSWZ(sr, sc * 2); char* K_lds = lds + 2 * SHM_V;
    const int kb0 = swa_jlo(cur.P0, W) * KVBLK;
    for (int d0 = 0; d0 < 8; ++d0) S.qr[d0] = load8<TIn>(cur.Q + (size_t)(wid * QBLK + r32) * LDP + d0 * 16 + hi * 8);
    if constexpr (F32) { SLOAD_F((const float*)cur.K, kb0); VMW(); SWRITE_KF(0); SBAR(); SLOAD_F((const float*)cur.V, kb0); }
    else { SLOAD_H(cur.K, cur.V, kb0); VMW(); SWRITE_HK(0); }
    __syncthreads();
}
template <class TIn, class TOut>
__device__ __forceinline__ void causal_swa_block(const BlockRef<TIn, TOut>& cur, const BlockRef<TIn, TOut>& nxt, int skv, int W, char* lds, Seam<TIn>& S) {
    constexpr bool F32 = same_t<TIn, float>::v;
    int tid_ = threadIdx.x; asm volatile("" : "+v"(tid_));
    const int tid = tid_, wid = __builtin_amdgcn_readfirstlane(tid >> 6), lane = tid & 63, r32 = lane & 31, hi = lane >> 5;
    const int j_lo = swa_jlo(cur.P0, W);
    int j_hi = (cur.P0 + QB - 1) / KVBLK + 1; if (j_hi > skv / KVBLK) j_hi = skv / KVBLK;
    const int NT = j_hi - j_lo;
    const int kbn = swa_jlo(nxt.P0, W) * KVBLK;
    const int qlo = cur.P0 + wid * QBLK, qm = qlo + r32 - 4 * hi;
    char* V_lds = lds; char* K_lds = lds + 2 * SHM_V;
    float* ws = (float*)(lds + 2 * SHM_V + 2 * SHM_K) + wid * 64; float* li_l = ws, * al_l = ws + 32;
    float m_reg = -1e30f, l_reg = 0; f32x16 o[4] = {};
    const int sr = tid >> 4, sc = (tid & 15) * 8, vst0 = v_st(sr, sc), vst1 = v_st(32 + sr, sc), kws = KSWZ(sr, sc * 2);
    const int vb0 = (int)(uintptr_t)V_lds + v_rd_base(lane);
    const TIn* Kh = cur.K; const TIn* Vh = cur.V;
#define RESC(a) do { if (__any((a) < 1.f)) { if (hi == 0) al_l[r32] = (a); asm volatile("s_waitcnt lgkmcnt(0)" ::: "memory");              \
                     for (int d_ = 0; d_ < 4; ++d_) for (int r = 0; r < 16; ++r) o[d_][r] *= al_l[crow(r, hi)]; } } while (0)
#define KBASE(t) ((j_lo + (t)) * KVBLK)
#define ACT(t) (KBASE(t) <= qlo + QBLK - 1 && KBASE(t) + KVBLK - 1 >= qlo - W + 1)
#define MASKT(P0_, P1_, t) do { const int kb_ = KBASE(t); if ((!SK || ACT(t)) && (kb_ + KVBLK - 1 > qlo || kb_ <= qlo + QBLK - 1 - W)) mask_tile(P0_, P1_, qm - kb_, (unsigned)W); } while (0)
    constexpr int NQL = F32 ? 16 : 8;
    constexpr bool SK = WSKIP && !F32;
#define SEAM_K0() do { VMWN(NQL); if constexpr (F32) { SWRITE_KF(0); SBAR(); SLOAD_F((const float*)nxt.V, kbn); } else { SWRITE_HK(0); } SBAR(); } while (0)
    f32x16 pA0, pA1, pB0, pB1; float mnA, mnB, alA, alB; bf16x8 pa0, pa1, pa2, pa3;
    if constexpr (F32) { VMW(); SWRITE_VF(0); SBAR(); } else { SWRITE_HV(0); SBAR(); }
    if (NT > 1) { if constexpr (F32) SLOAD_F((const float*)Kh, KBASE(1)); else SLOAD_H(Kh, Vh, KBASE(1)); }
    SBAR(); qkt<0, SK>(pA0, pA1, K_lds, r32, hi, S.qr, ACT(0));
    if constexpr (F32) { if (NT > 1) { VMW(); SWRITE_KF(1); SBAR(); SLOAD_F((const float*)Vh, KBASE(1)); } }
    MASKT(pA0, pA1, 0); partialSM(pA0, pA1, m_reg, mnA, alA);
    if (NT > 1) { VMW(); if constexpr (F32) { SWRITE_VF(1); SBAR(); if (NT > 2) SLOAD_F((const float*)Kh, KBASE(2)); } else SWRITE_H(1); }
    __syncthreads();
#define HALF_STEP(PX0, PX1, mnX, alX, PY0, PY1, alY, t, KB, VB, SB) do {                                                      \
        SBAR(); qkt<KB, SK>(PX0, PX1, K_lds, r32, hi, S.qr, ACT(t));                                             \
        finishSM(PY0, PY1, alY, l_reg, pa0, pa1, pa2, pa3); SBAR();                                                           \
        if ((t) + 1 < NT) { if constexpr (F32) { VMW(); SWRITE_KF(SB); SBAR(); SLOAD_F((const float*)Vh, KBASE((t) + 1)); }  \
                            else { SLOAD_H(Kh, Vh, KBASE((t) + 1)); } SBAR(); }                                               \
        pv_tile<VB, SK>(o, vb0, pa0, pa1, pa2, pa3, ACT((t) - 1)); MASKT(PX0, PX1, (t)); partialSM(PX0, PX1, m_reg, mnX, alX);                                        \
        __syncthreads();                                                                                                      \
        if ((t) + 1 < NT) { VMW(); if constexpr (F32) { SWRITE_VF(SB); SBAR(); if ((t) + 2 < NT) SLOAD_F((const float*)Kh, KBASE((t) + 2)); } \
                            else { SWRITE_H(SB); } }                                                                          \
        RESC(alX); __syncthreads(); } while (0)
    for (int t = 1; t + 1 < NT; t += 2) {
        HALF_STEP(pB0, pB1, mnB, alB, pA0, pA1, alA, t, 1, 0, 0);
        HALF_STEP(pA0, pA1, mnA, alA, pB0, pB1, alB, t + 1, 0, 1, 1);
    }
    const bool even = (NT & 1) == 0;
    if (even) { SBAR(); qkt<1, SK>(pB0, pB1, K_lds, r32, hi, S.qr, ACT(NT - 1)); SBAR(); }
#define QROW(e) (nxt.Q + (size_t)(wid * QBLK + r32) * LDP + ((e) >> 1) * 16 + hi * 8 + ((e) & 1) * 4)
    if constexpr (F32) { SLOAD_F((const float*)nxt.K, kbn); SBAR();
#pragma unroll
        for (int e = 0; e < 8; ++e) S.tq[e] = *(const f32x4*)QROW(e); }
    else { SLOAD_H(nxt.K, nxt.V, kbn); SBAR();
#pragma unroll
        for (int d0 = 0; d0 < 8; ++d0) S.qr[d0] = load8<TIn>(nxt.Q + (size_t)(wid * QBLK + r32) * LDP + d0 * 16 + hi * 8); }
    SBAR();
    finishSM(pA0, pA1, alA, l_reg, pa0, pa1, pa2, pa3); SBAR();
    if constexpr (F32) {
#pragma unroll
        for (int e = 8; e < 16; ++e) S.tq[e] = *(const f32x4*)QROW(e); SBAR(); }
#undef QROW
    pv_tile<0, SK>(o, vb0, pa0, pa1, pa2, pa3, ACT(even ? NT - 2 : NT - 1));
    if (even) { MASKT(pB0, pB1, NT - 1); partialSM(pB0, pB1, m_reg, mnB, alB); __syncthreads(); RESC(alB);
        finishSM(pB0, pB1, alB, l_reg, pa0, pa1, pa2, pa3); SBAR(); pv_tile<1, SK>(o, vb0, pa0, pa1, pa2, pa3, ACT(NT - 1)); }
    SBAR(); SEAM_K0();
    if (hi == 0) li_l[r32] = l_reg; asm volatile("s_waitcnt lgkmcnt(0)" ::: "memory");
    float rli[16];
#pragma unroll
    for (int r = 0; r < 16; ++r) rli[r] = __builtin_amdgcn_rcpf(li_l[crow(r, hi)]);
    TOut* Ow = cur.O + (size_t)(wid * QBLK) * LDO;
#pragma unroll
    for (int r = 0; r < 16; ++r) { const int orow = crow(r, hi);
#pragma unroll
        for (int d0 = 0; d0 < 4; ++d0) { const float v = o[d0][r] * rli[r];
            if constexpr (same_t<TOut, float>::v) { Ow[(size_t)orow * LDO + d0 * 32 + r32] = v; }
            else { const float vn = __shfl_xor(v, 1);
                   if ((r32 & 1) == 0) *(unsigned*)(Ow + (size_t)orow * LDO + d0 * 32 + r32) = cvtpk(v, vn); } } }
    if constexpr (F32) {
#pragma unroll
        for (int d0 = 0; d0 < 8; ++d0) S.qr[d0] = pack8(S.tq[2 * d0], S.tq[2 * d0 + 1]); }
    __syncthreads();
#undef RESC
#undef KBASE
#undef ACT
#undef MASKT
#undef SEAM_K0
#undef HALF_STEP
}
#undef ROW
#undef VMW
#undef VMWN
#undef SLOAD_H
#undef SWRITE_HK
#undef SWRITE_HV
#undef SWRITE_H
#undef SLOAD_F
#undef SWRITE_KF
#undef SWRITE_VF

}
namespace da {
using namespace swa;
constexpr int SEQ_LEN = 8192, ATT_LD = 4096;
constexpr int STAGE_B = 65536, OFF_K = 0, OFF_V = 32768, QROWS = 128;
typedef __attribute__((address_space(3))) unsigned lds_u32;
typedef float f32x4v __attribute__((ext_vector_type(4)));
__device__ __forceinline__ void dma16(const bf16* g, char* lds_dst_uniform) { __builtin_amdgcn_global_load_lds((const unsigned*)g, (lds_u32*)lds_dst_uniform, 16, 0, 0); }
__device__ __forceinline__ f32x4v mfma16(bf16x8 a, bf16x8 b, f32x4v c) { return __builtin_amdgcn_mfma_f32_16x16x32_bf16(a, b, c, 0, 0, 0); }
__device__ __forceinline__ float bpx(float v, int lane, int mask) { return __int_as_float(__builtin_amdgcn_ds_bpermute((lane ^ mask) << 2, __float_as_int(v))); }
struct Ctx { const bf16* proj; bf16* att; const float* subln_g; float lam; };
__device__ __forceinline__ void issue_tile(const bf16* Kg, const bf16* Vg, int k0, char* stage, int wid, int lane_) {
    const bf16* kb = Kg + (size_t)k0 * LDP;
    int lane = lane_; asm volatile("" : "+v"(lane));
#pragma unroll
    for (int i = 0; i < 2; ++i) { const int c = 2 * wid + i, row = 4 * c + (lane >> 4), gch = (lane & 15) ^ (row & 7), ko = row * LDP + gch * 8;
        char* dst = stage + (2 * wid + i) * 1024; dma16(kb + ko, dst + OFF_K); dma16(kb + 128 + ko, dst + OFF_K + 16384); }
    const int ks = wid >> 2;
#pragma unroll
    for (int i = 0; i < 4; ++i) { const int c = (4 * wid + i) & 7, row = 8 * (c >> 1) + ((lane >> 2) & 7), ch = 4 * (2 * (c & 1) + (lane >> 5)) + ((lane & 3) ^ ((row >> 2) & 3));
        const bf16* src = (Vg + (size_t)(k0 + 32 * ks) * LDP + 128 * ((wid >> 1) & 1)) + (row * LDP + 8 * ch);
        dma16(src, stage + OFF_V + (4 * wid + i) * 1024); }
}
#define DA16_TR(dst, addr, off) asm volatile("ds_read_b64_tr_b16 %0, %1 offset:%2" : "=&v"(dst) : "v"(addr), "i"(off) : "memory")
#define DA16_FR(l, h) (bf16x8){l[0], l[1], l[2], l[3], h[0], h[1], h[2], h[3]}
__device__ __forceinline__ void p_swap16(bf16x8 x, bf16x8 y, bf16x8& lo, bf16x8& hi16) {
    u32x4 xv = *reinterpret_cast<u32x4*>(&x), yv = *reinterpret_cast<u32x4*>(&y), l, h;
#pragma unroll
    for (int j = 0; j < 4; ++j) { auto r = __builtin_amdgcn_permlane16_swap(xv[j], yv[j], false, false); l[j] = r[0]; h[j] = r[1]; }
    lo = *reinterpret_cast<bf16x8*>(&l); hi16 = *reinterpret_cast<bf16x8*>(&h);
}
__device__ __forceinline__ void qkt6(f32x16& p0, f32x16& p1, const char* K_lds, int r32, int hi, const bf16x8 (&qr)[6], const char* qsp_l) {
    p0 = f32x16{}; p1 = f32x16{};
    const char* kb[4];
#pragma unroll
    for (int dd = 0; dd < 4; ++dd) kb[dd] = K_lds + KSWZ(r32, (dd * 16 + hi * 8) * 2);
#pragma unroll
    for (int d0 = 0; d0 < 8; ++d0) { const char* a = kb[d0 & 3] + (d0 >> 2) * 128;
        bf16x8 b0 = *reinterpret_cast<const bf16x8*>(a);
        bf16x8 b1 = *reinterpret_cast<const bf16x8*>(a + 32 * 256);
        bf16x8 q; if (d0 < 6) q = qr[d0 < 6 ? d0 : 0]; else q = *reinterpret_cast<const bf16x8*>(qsp_l + (d0 - 6) * 1024);
        p0 = __builtin_amdgcn_mfma_f32_32x32x16_bf16(b0, q, p0, 0, 0, 0);
        p1 = __builtin_amdgcn_mfma_f32_32x32x16_bf16(b1, q, p1, 0, 0, 0); }
}
template <int ST>
__device__ __forceinline__ void step(f32x4v (&o)[2][16], const bf16x8 (&qr)[6], const char* qsp_w, float& m_reg, float& l_reg, char* lds, float* al_l, int map,
                                     bool need_mask, int dqu  , bool more, const bf16* Kg, const bf16* Vg, int k_next, int wid) {
    asm volatile("s_waitcnt vmcnt(0)" ::: "memory"); __builtin_amdgcn_s_barrier(); asm volatile("" ::: "memory");
    int lane_; asm volatile("v_mbcnt_lo_u32_b32 %0, -1, 0\n\tv_mbcnt_hi_u32_b32 %0, -1, %0" : "=v"(lane_));
    const int r32 = lane_ & 31, hi = lane_ >> 5, dq = dqu + r32 - 4 * hi;
    if (more) issue_tile(Kg, Vg, k_next, lds + (ST ^ 1) * STAGE_B, wid, lane_);
    bf16x8 P00, P10, P01, P11;
    { f32x16 p0, p1; float mn, alpha; bf16x8 pa0, pa1, pa2, pa3;
      qkt6(p0, p1, lds + ST * STAGE_B + OFF_K + map * 16384, r32, hi, qr, qsp_w + lane_ * 16);
      if (need_mask) mask_tile(p0, p1, dq, 0x7fffffffu);
      partialSM(p0, p1, m_reg, mn, alpha);
      finishSM(p0, p1, alpha, l_reg, pa0, pa1, pa2, pa3);
      if (__any(alpha < 1.f)) { if (hi == 0) al_l[r32] = alpha; asm volatile("s_waitcnt lgkmcnt(0)" ::: "memory");
          int lq = lane_; asm volatile("" : "+v"(lq)); const int fqr = lq >> 4;
#pragma unroll
          for (int qb = 0; qb < 2; ++qb) { const f32x4v a4 = *(const f32x4v*)(al_l + 16 * qb + 4 * fqr);
#pragma unroll
              for (int c = 0; c < 16; ++c) o[qb][c] *= a4; } }
      p_swap16(pa0, pa1, P00, P10); p_swap16(pa2, pa3, P01, P11); }
    int lane = lane_; asm volatile("" : "+v"(lane));
    const int fr = lane & 15, fq = lane >> 4, fqv = ((fq & 1) << 1) | (fq >> 1);
    const int vq = fr >> 2, vp = fr & 3;
    const int vb00 = 2048 * fqv + 64 * vq + 16 * ((vp >> 1) ^ ((2 * fqv) & 3)) + 8 * (vp & 1), vb10 = 2048 * fqv + 64 * (4 + vq) + 16 * ((vp >> 1) ^ ((2 * fqv + 1) & 3)) + 8 * (vp & 1);
    const int vst = (int)(uintptr_t)lds + ST * STAGE_B + OFF_V;
    const int va00 = vst + vb00, va10 = vst + vb10;
    s16x4 fl0, fh0, fl1, fh1, fl2, fh2;
    asm volatile("s_waitcnt lgkmcnt(0)" ::: "memory");
    DA16_TR(fl0, va00, 0); DA16_TR(fh0, va10, 0); DA16_TR(fl1, (va00 ^ 32), 0); DA16_TR(fh1, (va10 ^ 32), 0);
    DA16_TR(fl2, va00, 512); DA16_TR(fh2, va10, 512); asm volatile("s_waitcnt lgkmcnt(4)" ::: "memory"); SBAR(); { const bf16x8 vf = DA16_FR(fl0, fh0); o[0][0] = mfma16(P00, vf, o[0][0]); o[1][0] = mfma16(P10, vf, o[1][0]); } SBAR();
    DA16_TR(fl0, (va00 ^ 32), 512); DA16_TR(fh0, (va10 ^ 32), 512); asm volatile("s_waitcnt lgkmcnt(4)" ::: "memory"); SBAR(); { const bf16x8 vf = DA16_FR(fl1, fh1); o[0][1] = mfma16(P00, vf, o[0][1]); o[1][1] = mfma16(P10, vf, o[1][1]); } SBAR();
    DA16_TR(fl1, va00, 1024); DA16_TR(fh1, va10, 1024); asm volatile("s_waitcnt lgkmcnt(4)" ::: "memory"); SBAR(); { const bf16x8 vf = DA16_FR(fl2, fh2); o[0][2] = mfma16(P00, vf, o[0][2]); o[1][2] = mfma16(P10, vf, o[1][2]); } SBAR();
    DA16_TR(fl2, (va00 ^ 32), 1024); DA16_TR(fh2, (va10 ^ 32), 1024); asm volatile("s_waitcnt lgkmcnt(4)" ::: "memory"); SBAR(); { const bf16x8 vf = DA16_FR(fl0, fh0); o[0][3] = mfma16(P00, vf, o[0][3]); o[1][3] = mfma16(P10, vf, o[1][3]); } SBAR();
    DA16_TR(fl0, va00, 1536); DA16_TR(fh0, va10, 1536); asm volatile("s_waitcnt lgkmcnt(4)" ::: "memory"); SBAR(); { const bf16x8 vf = DA16_FR(fl1, fh1); o[0][4] = mfma16(P00, vf, o[0][4]); o[1][4] = mfma16(P10, vf, o[1][4]); } SBAR();
    DA16_TR(fl1, (va00 ^ 32), 1536); DA16_TR(fh1, (va10 ^ 32), 1536); asm volatile("s_waitcnt lgkmcnt(4)" ::: "memory"); SBAR(); { const bf16x8 vf = DA16_FR(fl2, fh2); o[0][5] = mfma16(P00, vf, o[0][5]); o[1][5] = mfma16(P10, vf, o[1][5]); } SBAR();
    DA16_TR(fl2, va00, 8192); DA16_TR(fh2, va10, 8192); asm volatile("s_waitcnt lgkmcnt(4)" ::: "memory"); SBAR(); { const bf16x8 vf = DA16_FR(fl0, fh0); o[0][6] = mfma16(P00, vf, o[0][6]); o[1][6] = mfma16(P10, vf, o[1][6]); } SBAR();
    DA16_TR(fl0, (va00 ^ 32), 8192); DA16_TR(fh0, (va10 ^ 32), 8192); asm volatile("s_waitcnt lgkmcnt(4)" ::: "memory"); SBAR(); { const bf16x8 vf = DA16_FR(fl1, fh1); o[0][7] = mfma16(P00, vf, o[0][7]); o[1][7] = mfma16(P10, vf, o[1][7]); } SBAR();
    DA16_TR(fl1, va00, 8704); DA16_TR(fh1, va10, 8704); asm volatile("s_waitcnt lgkmcnt(4)" ::: "memory"); SBAR(); { const bf16x8 vf = DA16_FR(fl2, fh2); o[0][8] = mfma16(P00, vf, o[0][8]); o[1][8] = mfma16(P10, vf, o[1][8]); } SBAR();
    DA16_TR(fl2, (va00 ^ 32), 8704); DA16_TR(fh2, (va10 ^ 32), 8704); asm volatile("s_waitcnt lgkmcnt(4)" ::: "memory"); SBAR(); { const bf16x8 vf = DA16_FR(fl0, fh0); o[0][9] = mfma16(P00, vf, o[0][9]); o[1][9] = mfma16(P10, vf, o[1][9]); } SBAR();
    DA16_TR(fl0, va00, 9216); DA16_TR(fh0, va10, 9216); asm volatile("s_waitcnt lgkmcnt(4)" ::: "memory"); SBAR(); { const bf16x8 vf = DA16_FR(fl1, fh1); o[0][10] = mfma16(P00, vf, o[0][10]); o[1][10] = mfma16(P10, vf, o[1][10]); } SBAR();
    DA16_TR(fl1, (va00 ^ 32), 9216); DA16_TR(fh1, (va10 ^ 32), 9216); asm volatile("s_waitcnt lgkmcnt(4)" ::: "memory"); SBAR(); { const bf16x8 vf = DA16_FR(fl2, fh2); o[0][11] = mfma16(P00, vf, o[0][11]); o[1][11] = mfma16(P10, vf, o[1][11]); } SBAR();
    DA16_TR(fl2, va00, 9728); DA16_TR(fh2, va10, 9728); asm volatile("s_waitcnt lgkmcnt(4)" ::: "memory"); SBAR(); { const bf16x8 vf = DA16_FR(fl0, fh0); o[0][12] = mfma16(P00, vf, o[0][12]); o[1][12] = mfma16(P10, vf, o[1][12]); } SBAR();
    DA16_TR(fl0, (va00 ^ 32), 9728); DA16_TR(fh0, (va10 ^ 32), 9728); asm volatile("s_waitcnt lgkmcnt(4)" ::: "memory"); SBAR(); { const bf16x8 vf = DA16_FR(fl1, fh1); o[0][13] = mfma16(P00, vf, o[0][13]); o[1][13] = mfma16(P10, vf, o[1][13]); } SBAR();
    DA16_TR(fl1, va00, 16384); DA16_TR(fh1, va10, 16384); asm volatile("s_waitcnt lgkmcnt(4)" ::: "memory"); SBAR(); { const bf16x8 vf = DA16_FR(fl2, fh2); o[0][14] = mfma16(P00, vf, o[0][14]); o[1][14] = mfma16(P10, vf, o[1][14]); } SBAR();
    DA16_TR(fl2, (va00 ^ 32), 16384); DA16_TR(fh2, (va10 ^ 32), 16384); asm volatile("s_waitcnt lgkmcnt(4)" ::: "memory"); SBAR(); { const bf16x8 vf = DA16_FR(fl0, fh0); o[0][15] = mfma16(P00, vf, o[0][15]); o[1][15] = mfma16(P10, vf, o[1][15]); } SBAR();
    DA16_TR(fl0, va00, 16896); DA16_TR(fh0, va10, 16896); asm volatile("s_waitcnt lgkmcnt(4)" ::: "memory"); SBAR(); { const bf16x8 vf = DA16_FR(fl1, fh1); o[0][0] = mfma16(P01, vf, o[0][0]); o[1][0] = mfma16(P11, vf, o[1][0]); } SBAR();
    DA16_TR(fl1, (va00 ^ 32), 16896); DA16_TR(fh1, (va10 ^ 32), 16896); asm volatile("s_waitcnt lgkmcnt(4)" ::: "memory"); SBAR(); { const bf16x8 vf = DA16_FR(fl2, fh2); o[0][1] = mfma16(P01, vf, o[0][1]); o[1][1] = mfma16(P11, vf, o[1][1]); } SBAR();
    DA16_TR(fl2, va00, 17408); DA16_TR(fh2, va10, 17408); asm volatile("s_waitcnt lgkmcnt(4)" ::: "memory"); SBAR(); { const bf16x8 vf = DA16_FR(fl0, fh0); o[0][2] = mfma16(P01, vf, o[0][2]); o[1][2] = mfma16(P11, vf, o[1][2]); } SBAR();
    DA16_TR(fl0, (va00 ^ 32), 17408); DA16_TR(fh0, (va10 ^ 32), 17408); asm volatile("s_waitcnt lgkmcnt(4)" ::: "memory"); SBAR(); { const bf16x8 vf = DA16_FR(fl1, fh1); o[0][3] = mfma16(P01, vf, o[0][3]); o[1][3] = mfma16(P11, vf, o[1][3]); } SBAR();
    DA16_TR(fl1, va00, 17920); DA16_TR(fh1, va10, 17920); asm volatile("s_waitcnt lgkmcnt(4)" ::: "memory"); SBAR(); { const bf16x8 vf = DA16_FR(fl2, fh2); o[0][4] = mfma16(P01, vf, o[0][4]); o[1][4] = mfma16(P11, vf, o[1][4]); } SBAR();
    DA16_TR(fl2, (va00 ^ 32), 17920); DA16_TR(fh2, (va10 ^ 32), 17920); asm volatile("s_waitcnt lgkmcnt(4)" ::: "memory"); SBAR(); { const bf16x8 vf = DA16_FR(fl0, fh0); o[0][5] = mfma16(P01, vf, o[0][5]); o[1][5] = mfma16(P11, vf, o[1][5]); } SBAR();
    DA16_TR(fl0, va00, 24576); DA16_TR(fh0, va10, 24576); asm volatile("s_waitcnt lgkmcnt(4)" ::: "memory"); SBAR(); { const bf16x8 vf = DA16_FR(fl1, fh1); o[0][6] = mfma16(P01, vf, o[0][6]); o[1][6] = mfma16(P11, vf, o[1][6]); } SBAR();
    DA16_TR(fl1, (va00 ^ 32), 24576); DA16_TR(fh1, (va10 ^ 32), 24576); asm volatile("s_waitcnt lgkmcnt(4)" ::: "memory"); SBAR(); { const bf16x8 vf = DA16_FR(fl2, fh2); o[0][7] = mfma16(P01, vf, o[0][7]); o[1][7] = mfma16(P11, vf, o[1][7]); } SBAR();
    DA16_TR(fl2, va00, 25088); DA16_TR(fh2, va10, 25088); asm volatile("s_waitcnt lgkmcnt(4)" ::: "memory"); SBAR(); { const bf16x8 vf = DA16_FR(fl0, fh0); o[0][8] = mfma16(P01, vf, o[0][8]); o[1][8] = mfma16(P11, vf, o[1][8]); } SBAR();
    DA16_TR(fl0, (va00 ^ 32), 25088); DA16_TR(fh0, (va10 ^ 32), 25088); asm volatile("s_waitcnt lgkmcnt(4)" ::: "memory"); SBAR(); { const bf16x8 vf = DA16_FR(fl1, fh1); o[0][9] = mfma16(P01, vf, o[0][9]); o[1][9] = mfma16(P11, vf, o[1][9]); } SBAR();
    DA16_TR(fl1, va00, 25600); DA16_TR(fh1, va10, 25600); asm volatile("s_waitcnt lgkmcnt(4)" ::: "memory"); SBAR(); { const bf16x8 vf = DA16_FR(fl2, fh2); o[0][10] = mfma16(P01, vf, o[0][10]); o[1][10] = mfma16(P11, vf, o[1][10]); } SBAR();
    DA16_TR(fl2, (va00 ^ 32), 25600); DA16_TR(fh2, (va10 ^ 32), 25600); asm volatile("s_waitcnt lgkmcnt(4)" ::: "memory"); SBAR(); { const bf16x8 vf = DA16_FR(fl0, fh0); o[0][11] = mfma16(P01, vf, o[0][11]); o[1][11] = mfma16(P11, vf, o[1][11]); } SBAR();
    DA16_TR(fl0, va00, 26112); DA16_TR(fh0, va10, 26112); asm volatile("s_waitcnt lgkmcnt(4)" ::: "memory"); SBAR(); { const bf16x8 vf = DA16_FR(fl1, fh1); o[0][12] = mfma16(P01, vf, o[0][12]); o[1][12] = mfma16(P11, vf, o[1][12]); } SBAR();
    DA16_TR(fl1, (va00 ^ 32), 26112); DA16_TR(fh1, (va10 ^ 32), 26112); asm volatile("s_waitcnt lgkmcnt(4)" ::: "memory"); SBAR(); { const bf16x8 vf = DA16_FR(fl2, fh2); o[0][13] = mfma16(P01, vf, o[0][13]); o[1][13] = mfma16(P11, vf, o[1][13]); } SBAR();
    asm volatile("s_waitcnt lgkmcnt(2)" ::: "memory"); SBAR(); { const bf16x8 vf = DA16_FR(fl0, fh0); o[0][14] = mfma16(P01, vf, o[0][14]); o[1][14] = mfma16(P11, vf, o[1][14]); } SBAR();
    asm volatile("s_waitcnt lgkmcnt(0)" ::: "memory"); SBAR(); { const bf16x8 vf = DA16_FR(fl1, fh1); o[0][15] = mfma16(P01, vf, o[0][15]); o[1][15] = mfma16(P11, vf, o[1][15]); } SBAR();
}
__device__ __forceinline__ void unit(const Ctx& C, int b, int h, int qi, char* lds, float* wsf, char* qsp) {
    int tid_ = threadIdx.x; asm volatile("" : "+v"(tid_));
    const int tid = tid_, wid = __builtin_amdgcn_readfirstlane(tid >> 6), lane = tid & 63, r32 = lane & 31, hi = lane >> 5;
    const int map = wid >> 2, wq = wid & 3, q0 = qi * QROWS, NT = 2 * qi + 2;
    const size_t row0 = (size_t)b * SEQ_LEN;
    const bf16* Kg = C.proj + row0 * LDP + 2048 + h * 256;
    const bf16* Vg = C.proj + row0 * LDP + 4096 + h * 256;
    const bf16* Qg = C.proj + (row0 + q0 + wq * 32) * LDP + h * 256 + map * 128;
    float* al_l = wsf + wid * 64; float* li_l = al_l + 32;
    issue_tile(Kg, Vg, 0, lds, wid, lane);
    bf16x8 qr[6]; const char* qsp_w = qsp + wid * 2048;
#pragma unroll
    for (int d0 = 0; d0 < 6; ++d0) qr[d0] = load8<bf16>(Qg + (size_t)r32 * LDP + d0 * 16 + hi * 8);
#pragma unroll
    for (int d0 = 6; d0 < 8; ++d0) *(bf16x8*)(qsp + wid * 2048 + (d0 - 6) * 1024 + lane * 16) = load8<bf16>(Qg + (size_t)r32 * LDP + d0 * 16 + hi * 8);
    f32x4v o[2][16];
#pragma unroll
    for (int qb = 0; qb < 2; ++qb)
#pragma unroll
        for (int c = 0; c < 16; ++c) { float z0, z1, z2, z3; asm volatile("v_mov_b32 %0, 0\n\tv_mov_b32 %1, 0\n\tv_mov_b32 %2, 0\n\tv_mov_b32 %3, 0" : "=v"(z0), "=v"(z1), "=v"(z2), "=v"(z3)); o[qb][c] = (f32x4v){z0, z1, z2, z3}; }
    float m_reg = -1e30f, l_reg = 0.f;
    const int qlo = q0 + wq * 32;
    for (int t = 0; t < NT; t += 2) {
        { const int kb = t * 64;       step<0>(o, qr, qsp_w, m_reg, l_reg, lds, al_l, map, kb + 63 > qlo, qlo - kb, true,       Kg, Vg, kb + 64, wid); }
        { const int kb = (t + 1) * 64; step<1>(o, qr, qsp_w, m_reg, l_reg, lds, al_l, map, kb + 63 > qlo, qlo - kb, t + 2 < NT, Kg, Vg, kb + 64, wid); }
    }
    int laneE; asm volatile("v_mbcnt_lo_u32_b32 %0, -1, 0\n\tv_mbcnt_hi_u32_b32 %0, -1, %0" : "=v"(laneE)); const int frE = laneE & 15, fqE = laneE >> 4;
    if (laneE < 32) li_l[laneE] = l_reg; asm volatile("s_waitcnt lgkmcnt(0)" ::: "memory");
#pragma unroll
    for (int qb = 0; qb < 2; ++qb) { const f32x4v l4 = *(const f32x4v*)(li_l + 16 * qb + 4 * fqE); const f32x4v r4 = {__builtin_amdgcn_rcpf(l4[0]), __builtin_amdgcn_rcpf(l4[1]), __builtin_amdgcn_rcpf(l4[2]), __builtin_amdgcn_rcpf(l4[3])};
#pragma unroll
        for (int c = 0; c < 16; ++c) o[qb][c] *= r4; }
    asm volatile("s_waitcnt lgkmcnt(0)" ::: "memory"); __builtin_amdgcn_s_barrier(); asm volatile("" ::: "memory");
    char* xch = lds + wq * 32768 + laneE * 16;
    if (map == 1) {
#pragma unroll
        for (int qb = 0; qb < 2; ++qb)
#pragma unroll
            for (int c = 0; c < 16; ++c) *(f32x4v*)(xch + (qb * 16 + c) * 1024) = o[qb][c];
    }
    asm volatile("s_waitcnt lgkmcnt(0)" ::: "memory"); __builtin_amdgcn_s_barrier(); asm volatile("" ::: "memory");
    if (map == 0) {
        const float lam = wsf[512 + wid];
        bf16* Ow = C.att + (row0 + q0 + wq * 32) * ATT_LD + h * 256;
#pragma unroll
        for (int qb = 0; qb < 2; ++qb) { f32x4v ss = {0.f, 0.f, 0.f, 0.f};
#pragma unroll
            for (int c = 0; c < 16; ++c) { const f32x4v v2 = *(const f32x4v*)(xch + (qb * 16 + c) * 1024); const f32x4v dd = o[qb][c] - v2 * lam; o[qb][c] = dd; ss += dd * dd; }
#pragma unroll
            for (int e = 0; e < 4; ++e) { float s = ss[e]; s += bpx(s, laneE, 1); s += bpx(s, laneE, 2); s += bpx(s, laneE, 4); s += bpx(s, laneE, 8); ss[e] = 1.0f / sqrtf(s * (1.0f / 256.0f) + 1e-5f); }
#pragma unroll
            for (int c = 0; c < 16; ++c) { const float gl = C.subln_g[16 * c + frE] * 0.8f;
#pragma unroll
                for (int e = 0; e < 4; ++e) { const float v = o[qb][c][e] * ss[e] * gl; const float vn = bpx(v, laneE, 1);
                    if ((frE & 1) == 0) *(unsigned*)((Ow + (16 * qb + e) * ATT_LD + 16 * c) + (4 * fqE * ATT_LD + frE)) = cvtpk(v, vn); } } }
    }
    asm volatile("s_waitcnt lgkmcnt(0)" ::: "memory"); __builtin_amdgcn_s_barrier(); asm volatile("" ::: "memory");
}
#undef DA16_TR
#undef DA16_FR
__device__ __forceinline__ void phase(const Ctx& C, char* lds, float* wsf, char* qsp, int vcu, int G) {
    { const int wid = __builtin_amdgcn_readfirstlane((int)threadIdx.x >> 6); wsf[512 + wid] = C.lam; asm volatile("s_waitcnt lgkmcnt(0)" ::: "memory"); }
    const int npair = (512 - vcu + G - 1) / G;
    for (int u = 0; u < 2 * npair; ++u) { const int p = vcu + (u >> 1) * G, bh = p >> 5, x = p & 31;
        unit(C, bh >> 3, bh & 7, (u & 1) ? 63 - x : x, lds, wsf, qsp); }
}
}

constexpr int NWAVES = 8;
#ifndef MK_PER_PHASE
#define MK_PER_PHASE 0
#endif
constexpr int NPH = 12;

constexpr int BATCH = 2, SEQ = 8192, DM = 4096, M = BATCH * SEQ;
constexpr int NHEADS = 8;
constexpr int NIN = 20480, CWID = 2048, DFF = 11008, NUP = 2 * DFF;
constexpr int OFF_Q = 0, OFF_K = 2048, OFF_V = 4096, OFF_U = 6144, OFF_GB = 8192, OFF_GC = 10240, OFF_GA = 12288, OFF_GCV = 16384;
constexpr float LN_EPS = 1e-5f, RMS_EPS = 1e-5f;
constexpr float ALPHA = 1.189207115002721f;
constexpr float LAM_INIT = 0.2f;

constexpr size_t MiB = 1u << 20;
constexpr size_t WS_CTL = 0, CTL_ZERO_BYTES = 32768;
constexpr size_t WS_WA = 1 * MiB, WS_WC = 17 * MiB, WS_WO = 33 * MiB, WS_WIN = 65 * MiB, WS_WDN = 225 * MiB, WS_HALO = 311 * MiB, WS_PROJ = 353 * MiB, WS_ATTN = 993 * MiB, WS_YC = 1057 * MiB, WS_WUP = 1121 * MiB;
constexpr size_t WS_MERGED = 65 * MiB;
constexpr size_t WS_H1B = 353 * MiB;
constexpr size_t WS_G = 481 * MiB;
constexpr size_t WS_END = 1293 * MiB;
constexpr size_t DO_XB = 0, DO_O1 = 0, DO_O2 = 128 * MiB;
static_assert(WS_WIN + (size_t)NIN * DM * 2 <= WS_WDN && WS_WDN + (size_t)DM * DFF * 2 <= WS_HALO && WS_HALO + (size_t)(M / 256) * (NUP / 256) * 1024 * 4 <= WS_PROJ, "ws map (weights)");
static_assert(WS_PROJ + (size_t)M * NIN * 2 <= WS_ATTN && WS_G + (size_t)M * DFF * 2 <= WS_ATTN && WS_WUP + (size_t)NUP * DM * 2 <= WS_END && WS_H1B + (size_t)M * DM * 2 <= WS_G, "ws map");
constexpr int CW_BAR = 4096;

constexpr int RING_OFF = 0, RING_BYTES = 131072;
constexpr int LDSCTL_OFF = RING_BYTES, MISC_OFF = LDSCTL_OFF + 320, HALO_LDS_OFF = LDSCTL_OFF + 1024;
constexpr int QSP_LDS_OFF = HALO_LDS_OFF + 8192;
constexpr int LDS_BYTES = 163840;
static_assert(MISC_OFF + 128 <= HALO_LDS_OFF && QSP_LDS_OFF + 16384 <= LDS_BYTES, "LDS map");

#define GAS __attribute__((address_space(1)))
#define LAS __attribute__((address_space(3)))
typedef unsigned short bf16;
typedef unsigned v4u __attribute__((ext_vector_type(4)));
typedef float f32x4 __attribute__((ext_vector_type(4)));
typedef short bf16x8 __attribute__((ext_vector_type(8)));
typedef GAS unsigned gu32;
typedef GAS unsigned long long gu64;
#define RLX_AGENT __ATOMIC_RELAXED, __HIP_MEMORY_SCOPE_AGENT
#define LDS_WAIT() asm volatile("s_waitcnt lgkmcnt(0)" ::: "memory")
#define VM_WAIT() asm volatile("s_waitcnt vmcnt(0)" ::: "memory")
__device__ __forceinline__ unsigned long long rt() { return __builtin_amdgcn_s_memrealtime(); }
__device__ __forceinline__ unsigned f2bf(float f) { unsigned u = __builtin_bit_cast(unsigned, f); return (u + 0x7fffu + ((u >> 16) & 1u)) >> 16; }
__device__ __forceinline__ unsigned pk2(float lo, float hi) { return f2bf(lo) | (f2bf(hi) << 16); }

#define XB_TMO      128
#define XB_XCNT(j)  (256  + 64 * (j))
#define XB_XSUB(j)  (1280 + 64 * (j))
#define XB_XGEN(j)  (2304 + 64 * (j))
#define XB_TOP      3328
#define XB_TOPGEN   3392
#define XCD_BAR_WORDS 3456
#define XB_SPIN_CAP (1u << 18)

__device__ __forceinline__ unsigned xb_ld(unsigned* p)              { return __hip_atomic_load(p, __ATOMIC_RELAXED, __HIP_MEMORY_SCOPE_AGENT); }
__device__ __forceinline__ unsigned xb_add(unsigned* p, unsigned v) { return __hip_atomic_fetch_add(p, v, __ATOMIC_RELAXED, __HIP_MEMORY_SCOPE_AGENT); }
__device__ __forceinline__ unsigned xb_xcc_id() { return (unsigned)__builtin_amdgcn_s_getreg((3 << 11) | 20) & 0xFu; }
#define XB_SPIN(cond, bar) do { unsigned _sp = 0; while (cond) { __builtin_amdgcn_s_sleep(1); \
    if ((++_sp & 255u) == 0u) { if (xb_ld(&(bar)[XB_TMO])) break; if (_sp > XB_SPIN_CAP) { atomicAdd(&(bar)[XB_TMO], 1u); break; } } } } while (0)

struct XcdBarrier {
    unsigned* bar; unsigned x;
    volatile LAS unsigned* st;
};

__device__ __forceinline__ XcdBarrier xcd_barrier_post(unsigned* bar, volatile LAS unsigned* st) {
    XcdBarrier b; b.bar = bar; b.x = xb_xcc_id(); b.st = st;
    if (threadIdx.x == 0) (void)xb_add(&bar[XB_XCNT(b.x)], 1u);
    return b;
}
__device__ __forceinline__ void xcd_barrier_complete(unsigned* bar, unsigned x, unsigned& nloc, unsigned& nx) {
    const unsigned G = gridDim.x * gridDim.y * gridDim.z;
    unsigned sum, cnt, mine, sp = 0u;
    for (;;) {
        sum = 0u; cnt = 0u; mine = 0u;
#pragma unroll
        for (unsigned j = 0; j < 16; ++j) { const unsigned c = xb_ld(&bar[XB_XCNT(j)]); sum += c; cnt += (c > 0u) ? 1u : 0u; mine = (j == x) ? c : mine; }
        if (sum == G) break;
        __builtin_amdgcn_s_sleep(1);
        if ((++sp & 255u) == 0u) { if (xb_ld(&bar[XB_TMO])) break; if (sp > XB_SPIN_CAP) { atomicAdd(&bar[XB_TMO], 1u); break; } }
    }
    nloc = mine > 0u ? mine : 1u; nx = cnt > 0u ? cnt : 1u;
}

__device__ __forceinline__ void xcd_barrier(const XcdBarrier& b) {
    asm volatile("s_waitcnt vmcnt(0)" ::: "memory");
    __syncthreads();
    if (threadIdx.x == 0) {
        unsigned* bar = b.bar;
        __builtin_amdgcn_s_waitcnt(0);
        unsigned nloc = b.st[0], nx = b.st[1];
        if (nloc == 0u) { xcd_barrier_complete(bar, b.x, nloc, nx); b.st[0] = nloc; b.st[1] = nx; }
        const unsigned old = xb_add(&bar[XB_XSUB(b.x)], 1u);
        const unsigned gen = old / nloc;
        if (old + 1u == (gen + 1u) * nloc) {
            __builtin_amdgcn_fence(__ATOMIC_RELEASE, "agent");
            asm volatile("s_waitcnt vmcnt(0)" ::: "memory");
            const unsigned og = xb_add(&bar[XB_TOP], 1u);
            const unsigned tg = og / nx;
            if (og + 1u == (tg + 1u) * nx) xb_add(&bar[XB_TOPGEN], 1u);
            else XB_SPIN(xb_ld(&bar[XB_TOPGEN]) == tg, bar);
            __builtin_amdgcn_fence(__ATOMIC_ACQUIRE, "agent");
            xb_add(&bar[XB_XGEN(b.x)], 1u);
            asm volatile("s_waitcnt vmcnt(0)" ::: "memory");
        } else {
            XB_SPIN(xb_ld(&bar[XB_XGEN(b.x)]) == gen, bar);
            __builtin_amdgcn_fence(__ATOMIC_ACQUIRE, "agent");
            asm volatile("s_waitcnt vmcnt(0)" ::: "memory");
        }
    }
    __syncthreads();
}

struct Frame {
    LAS unsigned char* lds;
    volatile LAS unsigned* MISC;
    gu32* ctl;
    int wave;
    int vcu, G;
};
__device__ __forceinline__ unsigned pkbf(float lo, float hi) { return pg8::cvt_pk_bf16(lo, hi); }
__device__ __forceinline__ float rnd6(float v) { return __uint_as_float((__float_as_uint(v) + 0x10000u) & 0xfffe0000u); }
__device__ __forceinline__ unsigned pkw(float lo, float hi) { return pg8::cvt_pk_bf16(rnd6(lo), rnd6(hi)); }
__device__ __forceinline__ float shfl_xor_l(float v, int mask, int lane) { return __int_as_float(__builtin_amdgcn_ds_bpermute((lane ^ mask) << 2, __float_as_int(v))); }
__device__ __forceinline__ float wave_sum(float v, int lane) {
#pragma unroll
    for (int o = 1; o < 64; o <<= 1) v += shfl_xor_l(v, o, lane);
    return v;
}
template <int ILV = 0, bool HF = false> __device__ __forceinline__ void transpose_item(const float* W, int K, int N, bf16* WT, LAS float* scr, int item, int lane, int ldk = 0, int kofs = 0) {
    if (ldk == 0) ldk = K;
    const int nblk = N / 32, kb = item / nblk, nb = item % nblk, k0 = 64 * kb, n0 = 32 * nb;
    const int d0 = ILV == 1 ? ((n0 < DFF) ? (n0 / 128) * 256 + (n0 % 128) : ((n0 - DFF) / 128) * 256 + 128 + ((n0 - DFF) % 128))
                 : ILV == 2 ? ((n0 < OFF_GA) ? n0 : (n0 < OFF_GCV) ? OFF_GA + ((n0 - OFF_GA) / 128) * 256 + ((n0 - OFF_GA) % 128) : OFF_GA + ((n0 - OFF_GCV) / 128) * 256 + 128 + ((n0 - OFF_GCV) % 128)) : n0;
#pragma unroll 8
    for (int i = 0; i < 32; ++i) { const int kk = 2 * i + (lane >> 5); scr[kk * 33 + (lane & 31)] = W[(size_t)(k0 + kk) * N + n0 + (lane & 31)]; }
    LDS_WAIT(); asm volatile("" ::: "memory");
    const int c = lane & 7;
#pragma unroll
    for (int j = 0; j < 4; ++j) { const int n = (lane >> 3) + 8 * j; const LAS float* s = scr + (8 * c) * 33 + n;
        v4u o;
        if constexpr (HF) { o.x = pg8::pk_h2(s[0 * 33], s[1 * 33]); o.y = pg8::pk_h2(s[2 * 33], s[3 * 33]); o.z = pg8::pk_h2(s[4 * 33], s[5 * 33]); o.w = pg8::pk_h2(s[6 * 33], s[7 * 33]); }
        else { o.x = pkw(s[0 * 33], s[1 * 33]); o.y = pkw(s[2 * 33], s[3 * 33]); o.z = pkw(s[4 * 33], s[5 * 33]); o.w = pkw(s[6 * 33], s[7 * 33]); }
        *(GAS v4u*)(WT + (size_t)(d0 + n) * ldk + kofs + k0 + 8 * c) = o; }
    LDS_WAIT(); asm volatile("" ::: "memory");
}
template <bool FOUT> __device__ __forceinline__ void ln_row_h(bf16* hrow, const float* g, const float* b, float* orow_f, int lane, bool poison, bf16* brow = nullptr) {
    GAS v4u* xr = (GAS v4u*)hrow + lane;
    float v[8][8]; float s = 0.f;
#pragma unroll
    for (int j = 0; j < 8; ++j) { const v4u w = xr[64 * j];
        v[j][0] = pg8::h_lo(w.x); v[j][1] = pg8::h_hi(w.x); v[j][2] = pg8::h_lo(w.y); v[j][3] = pg8::h_hi(w.y); v[j][4] = pg8::h_lo(w.z); v[j][5] = pg8::h_hi(w.z); v[j][6] = pg8::h_lo(w.w); v[j][7] = pg8::h_hi(w.w);
#pragma unroll
        for (int i = 0; i < 8; ++i) s += v[j][i]; }
    const float mean = wave_sum(s, lane) * (1.f / DM); float s2 = 0.f;
#pragma unroll
    for (int j = 0; j < 8; ++j)
#pragma unroll
        for (int i = 0; i < 8; ++i) { v[j][i] -= mean; s2 += v[j][i] * v[j][i]; }
    float rstd = 1.f / sqrtf(wave_sum(s2, lane) * (1.f / DM) + LN_EPS);
    if (poison) rstd = __builtin_nanf("");
#pragma unroll
    for (int j = 0; j < 8; ++j) { const int e0 = 8 * (lane + 64 * j); const f32x4 g0 = *(const GAS f32x4*)(g + e0), g1 = *(const GAS f32x4*)(g + e0 + 4), b0 = *(const GAS f32x4*)(b + e0), b1 = *(const GAS f32x4*)(b + e0 + 4);
        const f32x4 o0 = (f32x4){v[j][0], v[j][1], v[j][2], v[j][3]} * rstd * g0 + b0, o1 = (f32x4){v[j][4], v[j][5], v[j][6], v[j][7]} * rstd * g1 + b1;
        if constexpr (FOUT) { *(GAS f32x4*)(orow_f + e0) = o0; *(GAS f32x4*)(orow_f + e0 + 4) = o1; }
        else { v4u w; w.x = pg8::pk_h2(o0[0], o0[1]); w.y = pg8::pk_h2(o0[2], o0[3]); w.z = pg8::pk_h2(o1[0], o1[1]); w.w = pg8::pk_h2(o1[2], o1[3]); xr[64 * j] = w;
               v4u wb; wb.x = pkw(o0[0], o0[1]); wb.y = pkw(o0[2], o0[3]); wb.z = pkw(o1[0], o1[1]); wb.w = pkw(o1[2], o1[3]); ((GAS v4u*)brow)[lane + 64 * j] = wb; } }
}
__device__ __forceinline__ void unpack8(const v4u w, float (&f)[8]) {
    f[0] = __uint_as_float(w.x << 16); f[1] = __uint_as_float(w.x & 0xffff0000u); f[2] = __uint_as_float(w.y << 16); f[3] = __uint_as_float(w.y & 0xffff0000u);
    f[4] = __uint_as_float(w.z << 16); f[5] = __uint_as_float(w.z & 0xffff0000u); f[6] = __uint_as_float(w.w << 16); f[7] = __uint_as_float(w.w & 0xffff0000u);
}
__device__ __forceinline__ v4u pack8f(const float (&f)[8]) { v4u o; o.x = pkw(f[0], f[1]); o.y = pkw(f[2], f[3]); o.z = pkw(f[4], f[5]); o.w = pkw(f[6], f[7]); return o; }

typedef const void __attribute__((address_space(4)))* karg_ptr_t;
template <int OFF> __device__ __forceinline__ unsigned long long karg_u64() {
    unsigned long long v; karg_ptr_t kp = (karg_ptr_t)__builtin_amdgcn_kernarg_segment_ptr();
    asm volatile("s_load_dwordx2 %0, %1, %2\n\ts_waitcnt lgkmcnt(0)" : "=s"(v) : "s"(kp), "i"(OFF)); return v; }
template <int OFF> __device__ __forceinline__ int karg_i32() {
    int v; karg_ptr_t kp = (karg_ptr_t)__builtin_amdgcn_kernarg_segment_ptr();
    asm volatile("s_load_dword %0, %1, %2\n\ts_waitcnt lgkmcnt(0)" : "=s"(v) : "s"(kp), "i"(OFF)); return v; }
#define KARG_F(k) ((const float*)(const GAS float*)karg_u64<8 * (k)>())
#define KARG_OUT() ((float*)(GAS float*)karg_u64<144>())
#define KARG_WS() ((unsigned char*)(GAS unsigned char*)karg_u64<152>())
__device__ __forceinline__ int lane_id() { int l; asm volatile("v_mbcnt_lo_u32_b32 %0, -1, 0\n\tv_mbcnt_hi_u32_b32 %0, -1, %0" : "=v"(l)); return l; }

struct RevOrder : pg8::StaticOrder {
    __device__ bool next(int i, pg8::Unit& u) const { if (!pg8::StaticOrder::next(i, u)) return false; u.pn = nN - 1 - u.pn; return true; } };
struct Order4 : pg8::StaticOrder {
    __device__ bool next(int i, pg8::Unit& u) const {
        const long L = (long)i * G + c; if (L >= nwg) return false;
        int wgid = (int)L; { const int q = nwg / pg8::NXCD, r = nwg % pg8::NXCD, xcd = wgid % pg8::NXCD, off = wgid / pg8::NXCD; wgid = (xcd < r ? xcd * (q + 1) : r * (q + 1) + (xcd - r) * q) + off; }
        constexpr int W4 = 4; const int nig = W4 * nN, gid = wgid / nig, fm = gid * W4, gsz = (nM - fm) < W4 ? (nM - fm) : W4;
        u.pm = fm + ((wgid % nig) % gsz); u.pn = (wgid % nig) / gsz; return true;
    } };
struct Args { const float* in[18]; float* out; unsigned char* ws; int ph_lo, ph_hi, li, pad; };
__global__ void __launch_bounds__(NWAVES * 64, 2) fwd(Args  ) {
    extern __shared__ __attribute__((aligned(16))) unsigned char lds[];
    Frame F;
    F.lds = (LAS unsigned char*)lds;
    F.MISC = (volatile LAS unsigned*)(F.lds + MISC_OFF);
    F.wave = __builtin_amdgcn_readfirstlane((int)threadIdx.x >> 6);
    F.G = gridDim.x; { const int bx = blockIdx.x; F.vcu = (F.G % 8 == 0) ? (bx % 8) * (F.G / 8) + bx / 8 : bx; }
    F.ctl = (gu32*)(KARG_WS() + WS_CTL);
    for (int u = threadIdx.x; u < (LDS_BYTES - LDSCTL_OFF) / 4; u += NWAVES * 64) ((LAS unsigned*)(F.lds + LDSCTL_OFF))[u] = 0u;
    __syncthreads();
    XcdBarrier bar; bar.bar = (unsigned*)(F.ctl + CW_BAR); bar.x = 0; bar.st = nullptr;
    if (!MK_PER_PHASE) bar = xcd_barrier_post((unsigned*)(F.ctl + CW_BAR), F.MISC + 8);
#define GRID_BAR() do { if (!MK_PER_PHASE) xcd_barrier(bar); } while (0)
#if MK_PER_PHASE
    const int lo = karg_i32<160>(), hi = karg_i32<164>();
#else
    constexpr int lo = 0, hi = NPH;
#endif
#define IN(k) (lo <= (k) && (k) < hi)
#define BOTH(k) (IN(k) && IN((k) + 1))
    const int gw = F.vcu * NWAVES + F.wave, NGW = F.G * NWAVES;
    LAS float* scr = (LAS float*)(F.lds + RING_OFF + F.wave * 16384);

    if (IN(0)) {
        const int lane = lane_id();
        unsigned char* const ws = KARG_WS(); bf16* const XB = (bf16*)((unsigned char*)KARG_OUT() + DO_XB);
        constexpr int I_IN = (DM / 64) * (NIN / 32), I_A = (CWID / 64) * (DM / 32), I_O = (DM / 64) * (DM / 32), I_UP = (DM / 64) * (NUP / 32), I_DN = (DFF / 64) * (DM / 32);
        constexpr int NIT = I_IN + 2 * I_A + I_O + I_UP + I_DN;
        const float* const w_in = KARG_F(1); const float* const w_ao = KARG_F(8); const float* const w_co = KARG_F(9); const float* const w_o = KARG_F(10); const float* const xin = KARG_F(0);
        const float* const w_up = KARG_F(13); const float* const w_dn = KARG_F(15);
        for (int it = gw; it < NIT; it += NGW) {
            int r = it;
            if (r < I_IN) { transpose_item<2>(w_in, DM, NIN, (bf16*)(ws + WS_WIN), scr, r, lane); continue; } r -= I_IN;
            if (r < I_A) { transpose_item(w_ao, CWID, DM, (bf16*)(ws + WS_WA), scr, r, lane, 2 * CWID, 0); continue; } r -= I_A;
            if (r < I_A) { transpose_item(w_co, CWID, DM, (bf16*)(ws + WS_WA), scr, r, lane, 2 * CWID, CWID); continue; } r -= I_A;
            if (r < I_O) { transpose_item(w_o, DM, DM, (bf16*)(ws + WS_WO), scr, r, lane); continue; } r -= I_O;
            if (r < I_UP) { transpose_item<1>(w_up, DM, NUP, (bf16*)(ws + WS_WUP), scr, r, lane); continue; } r -= I_UP;
            transpose_item(w_dn, DFF, DM, (bf16*)(ws + WS_WDN), scr, r, lane);
        }
        const size_t n8 = (size_t)M * DM / 8;
        for (size_t i = (size_t)blockIdx.x * (NWAVES * 64) + F.wave * 64 + lane; i < n8; i += (size_t)F.G * (NWAVES * 64)) {
            const f32x4 a = ((const GAS f32x4*)xin)[2 * i], b = ((const GAS f32x4*)xin)[2 * i + 1];
            v4u o; o.x = pkw(a.x, a.y); o.y = pkw(a.z, a.w); o.z = pkw(b.x, b.y); o.w = pkw(b.z, b.w);
            ((GAS v4u*)XB)[i] = o;
        }
        if (BOTH(0)) GRID_BAR();
    }
    if (IN(1)) {
        unsigned char* const ws = KARG_WS(); bf16* const Win_t = (bf16*)(ws + WS_WIN); bf16* const XB = (bf16*)((unsigned char*)KARG_OUT() + DO_XB); bf16* const PROJ = (bf16*)(ws + WS_PROJ);
        pg8::Gemm g{XB, Win_t, M, NIN, DM}; RevOrder S; S.init(M, NIN, F.G, (int)blockIdx.x);
        pg8::EpiProj E{PROJ, NIN, OFF_GA, OFF_GCV};
        pg8::gemm_phase<pg8::EpiProj, RevOrder, true, true>(F.lds + RING_OFF, g, S, E);
        if (BOTH(1)) GRID_BAR();
    }
    if (IN(2)) {
        const int lane = lane_id();
        unsigned char* const ws = KARG_WS();
        float s1, s2; { const float* const q1 = KARG_F(2); const float* const k1 = KARG_F(3); const float* const q2 = KARG_F(4); const float* const k2 = KARG_F(5);
          s1 = q1[lane] * k1[lane] + q1[lane + 64] * k1[lane + 64]; s1 = wave_sum(s1, lane); s2 = q2[lane] * k2[lane] + q2[lane + 64] * k2[lane + 64]; s2 = wave_sum(s2, lane); }
        const da::Ctx C{(const swa::bf16*)(ws + WS_PROJ), (swa::bf16*)(ws + WS_ATTN), KARG_F(6), expf(s1) - expf(s2) + LAM_INIT};
        da::phase(C, (char*)lds + RING_OFF, (float*)((char*)lds + HALO_LDS_OFF), (char*)lds + QSP_LDS_OFF, F.vcu, F.G);
        if (MK_PER_PHASE == 0) { asm volatile("s_waitcnt vmcnt(0)" ::: "memory"); __syncthreads(); }
    }
    if (IN(3)) {
        const int lane = lane_id();
        unsigned char* const ws = KARG_WS(); bf16* const PROJ = (bf16*)(ws + WS_PROJ); float* const O1 = (float*)((unsigned char*)KARG_OUT() + DO_O1); float* const O2 = (float*)((unsigned char*)KARG_OUT() + DO_O2); bf16* const YC = (bf16*)(ws + WS_ATTN) + CWID;
        const float* const conv_w = KARG_F(7);
        for (int it = gw; it < (M / 32) * 4; it += NGW) {
            const int run = it >> 2, c = (it & 3) * 512 + lane * 8, t0 = run * 32;
            float w0[8], w1[8], w2[8], p1[8], p2[8];
            { const GAS f32x4* cw = (const GAS f32x4*)(conv_w + c);
              const f32x4 a = cw[0], b = cw[1], c1 = cw[CWID / 4], d1 = cw[CWID / 4 + 1], e = cw[2 * CWID / 4], f = cw[2 * CWID / 4 + 1];
              w0[0] = a.x; w0[1] = a.y; w0[2] = a.z; w0[3] = a.w; w0[4] = b.x; w0[5] = b.y; w0[6] = b.z; w0[7] = b.w;
              w1[0] = c1.x; w1[1] = c1.y; w1[2] = c1.z; w1[3] = c1.w; w1[4] = d1.x; w1[5] = d1.y; w1[6] = d1.z; w1[7] = d1.w;
              w2[0] = e.x; w2[1] = e.y; w2[2] = e.z; w2[3] = e.w; w2[4] = f.x; w2[5] = f.y; w2[6] = f.z; w2[7] = f.w; }
            if ((t0 & (SEQ - 1)) == 0) {
#pragma unroll
                for (int j = 0; j < 8; ++j) { p1[j] = 0.f; p2[j] = 0.f; }
            } else {
                float ua[8], ga[8], ub[8], gb2[8];
                unpack8(*(const GAS v4u*)(PROJ + (size_t)(t0 - 1) * NIN + OFF_U + c), ua); unpack8(*(const GAS v4u*)(PROJ + (size_t)(t0 - 1) * NIN + OFF_GC + c), ga);
                unpack8(*(const GAS v4u*)(PROJ + (size_t)(t0 - 2) * NIN + OFF_U + c), ub); unpack8(*(const GAS v4u*)(PROJ + (size_t)(t0 - 2) * NIN + OFF_GC + c), gb2);
#pragma unroll
                for (int j = 0; j < 8; ++j) { p1[j] = ua[j] * ga[j]; p2[j] = ub[j] * gb2[j]; }
            }
#pragma unroll 4
            for (int i = 0; i < 32; ++i) {
                const size_t rowo = (size_t)(t0 + i) * NIN + c;
                float uu[8], gc[8], gbv[8], y[8];
                unpack8(*(const GAS v4u*)(PROJ + rowo + OFF_U), uu); unpack8(*(const GAS v4u*)(PROJ + rowo + OFF_GC), gc); unpack8(*(const GAS v4u*)(PROJ + rowo + OFF_GB), gbv);
#pragma unroll
                for (int j = 0; j < 8; ++j) { const float p0 = uu[j] * gc[j]; y[j] = gbv[j] * (w0[j] * p2[j] + w1[j] * p1[j] + w2[j] * p0); p2[j] = p1[j]; p1[j] = p0; }
                *(GAS v4u*)(YC + (size_t)(t0 + i) * (2 * CWID) + c) = pack8f(y);
            }
        }
        if (BOTH(3)) GRID_BAR();
    }
    if (IN(4)) {
        unsigned char* const ws = KARG_WS(); bf16* const PROJ = (bf16*)(ws + WS_PROJ);
        pg8::Gemm g{(bf16*)(ws + WS_ATTN), (bf16*)(ws + WS_WA), M, DM, 2 * CWID}; pg8::StaticOrder S; S.init(M, DM, F.G, (int)blockIdx.x);
        pg8::EpiGateMerge E{(bf16*)(ws + WS_MERGED), DM, PROJ + OFF_GA, PROJ + OFF_GCV, NIN};
        pg8::gemm_phase<pg8::EpiGateMerge, pg8::StaticOrder, true, true, true>(F.lds + RING_OFF, g, S, E);
        if (BOTH(4)) GRID_BAR();
    }
    if (IN(6)) {
        unsigned char* const ws = KARG_WS(); float* const out = KARG_OUT(); bf16* const Wo_t = (bf16*)(ws + WS_WO); bf16* const MERGED = (bf16*)(ws + WS_MERGED);
        pg8::Gemm g{MERGED, Wo_t, M, DM, DM}; pg8::StaticOrder S; S.init(M, DM, F.G, (int)blockIdx.x);
        pg8::EpiResidH<false> E{KARG_F(0), (bf16*)out};
        pg8::gemm_phase<pg8::EpiResidH<false>, pg8::StaticOrder, true, true>(F.lds + RING_OFF, g, S, E);
        if (BOTH(6)) GRID_BAR();
    }
    if (IN(7)) {
        const int lane = lane_id();
        unsigned char* const ws = KARG_WS(); float* const out = KARG_OUT(); bf16* const H1B = (bf16*)(ws + WS_H1B);
        { const float* const g1 = KARG_F(11); const float* const b1 = KARG_F(12);
          for (int t = gw; t < M; t += NGW) ln_row_h<false>((bf16*)out + (size_t)t * DM, g1, b1, nullptr, lane, false, H1B + (size_t)t * DM); }
        if (BOTH(7)) GRID_BAR();
    }
    if (IN(8)) {
        unsigned char* const ws = KARG_WS(); bf16* const H1B = (bf16*)(ws + WS_H1B); bf16* const Wup_t = (bf16*)(ws + WS_WUP); bf16* const GB = (bf16*)(ws + WS_G);
        pg8::Gemm g{H1B, Wup_t, M, NUP, DM}; pg8::StaticOrder S; S.init(M, NUP, F.G, (int)blockIdx.x);
        pg8::EpiConvSilu E{GB, DFF, KARG_F(14), NUP, DFF, (float*)(ws + WS_HALO), NUP / 256, (LAS float*)(F.lds + HALO_LDS_OFF)};
        pg8::gemm_phase<pg8::EpiConvSilu, pg8::StaticOrder, true, true>(F.lds + RING_OFF, g, S, E);
        if (BOTH(8)) GRID_BAR();
    }
    if (IN(9)) {
        const int lane = lane_id();
        unsigned char* const ws = KARG_WS(); const float* const halo = (const float*)(ws + WS_HALO); bf16* const GB = (bf16*)(ws + WS_G); const float* const ffn_cw = KARG_F(14);
        constexpr int NPN = NUP / 256, NITEM = (M / 256) * NPN * 32;
        for (int it = blockIdx.x * (NWAVES * 64) + F.wave * 64 + lane; it < NITEM; it += F.G * (NWAVES * 64)) {
            const int q = it & 31, t = it >> 5, pn = t % NPN, pm = t / NPN, lc = q * 4, ch = pn * 128 + lc;
            const GAS float* hc = (const GAS float*)halo + ((size_t)pm * NPN + pn) * 1024;
            const f32x4 g0 = *(const GAS f32x4*)(hc + lc), g1 = *(const GAS f32x4*)(hc + 256 + lc), v0 = *(const GAS f32x4*)(hc + 128 + lc), v1 = *(const GAS f32x4*)(hc + 256 + 128 + lc);
            f32x4 gp2 = {0.f, 0.f, 0.f, 0.f}, gp1 = gp2, vp2 = gp2, vp1 = gp2;
            if ((pm & 31) != 0) { const GAS float* hp = hc - (size_t)NPN * 1024; gp2 = *(const GAS f32x4*)(hp + 512 + lc); gp1 = *(const GAS f32x4*)(hp + 768 + lc); vp2 = *(const GAS f32x4*)(hp + 512 + 128 + lc); vp1 = *(const GAS f32x4*)(hp + 768 + 128 + lc); }
            f32x4 wg[3], wv[3];
#pragma unroll
            for (int k = 0; k < 3; ++k) { wg[k] = *(const GAS f32x4*)(ffn_cw + (size_t)k * NUP + ch); wv[k] = *(const GAS f32x4*)(ffn_cw + (size_t)k * NUP + DFF + ch); }
            const f32x4 cg0 = wg[0] * gp2 + wg[1] * gp1 + wg[2] * g0, cv0 = wv[0] * vp2 + wv[1] * vp1 + wv[2] * v0;
            const f32x4 cg1 = wg[0] * gp1 + wg[1] * g0 + wg[2] * g1, cv1 = wv[0] * vp1 + wv[1] * v0 + wv[2] * v1;
            float y0[4], y1[4];
#pragma unroll
            for (int i = 0; i < 4; ++i) { y0[i] = cg0[i] * pg8::sigm(cg0[i]) * cv0[i]; y1[i] = cg1[i] * pg8::sigm(cg1[i]) * cv1[i]; }
            *(GAS unsigned long long*)(GB + (size_t)(pm * 256) * DFF + ch) = (unsigned long long)pkbf(y0[0], y0[1]) | ((unsigned long long)pkbf(y0[2], y0[3]) << 32);
            *(GAS unsigned long long*)(GB + (size_t)(pm * 256 + 1) * DFF + ch) = (unsigned long long)pkbf(y1[0], y1[1]) | ((unsigned long long)pkbf(y1[2], y1[3]) << 32);
        }
        if (BOTH(9)) GRID_BAR();
    }
    if (IN(10)) {
        unsigned char* const ws = KARG_WS(); float* const out = KARG_OUT(); bf16* const GB = (bf16*)(ws + WS_G); bf16* const Wdn_t = (bf16*)(ws + WS_WDN);
        pg8::Gemm g{GB, Wdn_t, M, DM, DFF}; Order4 S; S.init(M, DM, F.G, (int)blockIdx.x);
        pg8::EpiResidH<true> E{(const void*)out, (bf16*)(ws + WS_H1B)};
        pg8::gemm_phase<pg8::EpiResidH<true>, Order4, true, true>(F.lds + RING_OFF, g, S, E);
        if (BOTH(10)) GRID_BAR();
    }
    if (IN(11)) {
        const int lane = lane_id();
        float* const out = KARG_OUT();
        const bool poison = (!MK_PER_PHASE) && (__hip_atomic_load((gu32*)((unsigned*)(F.ctl + CW_BAR) + XB_TMO), RLX_AGENT) != 0u);
        const float* const g2 = KARG_F(16); const float* const b2 = KARG_F(17);
        bf16* const pre2 = (bf16*)(KARG_WS() + WS_H1B);
        for (int t = gw; t < M; t += NGW) ln_row_h<true>(pre2 + (size_t)t * DM, g2, b2, out + (size_t)t * DM, lane, poison);
    }
#undef IN
#undef BOTH
}

extern "C" void kernel_launch(void* const* d_in, const int* in_sizes, int n_in, void* d_out, int out_size, void* d_ws, size_t ws_size, hipStream_t stream) {
    static int grid = 0;
    if (grid == 0) {
        if (n_in != 18 || in_sizes[0] != M * DM || out_size != M * DM || ws_size < WS_END) { fprintf(stderr, "kernel_launch: unexpected shapes (n_in %d, in0 %d, out %d, ws %zu < %zu)\n", n_in, n_in > 0 ? in_sizes[0] : -1, out_size, ws_size, (size_t)WS_END); grid = -1; return; }
        int dev = 0, cus = 0, per_cu = 0;
        if (hipGetDevice(&dev) != hipSuccess || hipDeviceGetAttribute(&cus, hipDeviceAttributeMultiprocessorCount, dev) != hipSuccess) { grid = -1; return; }
        if (hipFuncSetAttribute((const void*)fwd, hipFuncAttributeMaxDynamicSharedMemorySize, LDS_BYTES) != hipSuccess) { fprintf(stderr, "kernel_launch: hipFuncSetAttribute failed\n"); grid = -1; return; }
        if (hipOccupancyMaxActiveBlocksPerMultiprocessor(&per_cu, (const void*)fwd, NWAVES * 64, LDS_BYTES) != hipSuccess || per_cu < 1) { fprintf(stderr, "kernel_launch: occupancy query reports %d\n", per_cu); }
        (void)hipGetLastError();
        grid = cus;
    }
    if (grid < 0) return;
    if (hipMemsetAsync((char*)d_ws + WS_CTL, 0, CTL_ZERO_BYTES, stream) != hipSuccess) return;
    Args a{};
    for (int i = 0; i < 18; ++i) a.in[i] = (const float*)d_in[i];
    a.out = (float*)d_out; a.ws = (unsigned char*)d_ws;
#if MK_PER_PHASE
    for (int p = 0; p < NPH; ++p) { a.ph_lo = p; a.ph_hi = p + 1; a.li = p; hipLaunchKernelGGL(fwd, dim3(grid), dim3(NWAVES * 64), LDS_BYTES, stream, a); }
#else
    a.ph_lo = 0; a.ph_hi = NPH; a.li = 0;
    hipLaunchKernelGGL(fwd, dim3(grid), dim3(NWAVES * 64), LDS_BYTES, stream, a);
#endif
}
```
